# Optimizing an MI355X kernel written in HIP

```python
import math
import jax, jax.numpy as jnp
from jax import lax
import numpy as np

D_MODEL = 1024
BATCH = 2
SEQ = 16384
DEPTH = 4

EPS = 1e-6
A_WIDTH = 256
A_GROUPS = 4
A_GROUP_DIM = A_WIDTH // A_GROUPS
A_CHUNK = 128
MLA_HEADS = 8
Q_LORA = 384
KV_LORA = 256
QK_NOPE = 64
QK_ROPE = 32
V_DIM = 64
QK_DIM = QK_NOPE + QK_ROPE
ROPE_THETA = 10000.0
Q_BLOCK = 128
POOL_WINDOWS = (2, 4, 8, 16)
C_WIDTH = 256
C_GROUP = C_WIDTH // len(POOL_WINDOWS)
N_BRANCH = 3
SPLITS = (A_WIDTH, 2 * A_WIDTH, 2 * A_WIDTH + Q_LORA, 2 * A_WIDTH + Q_LORA + KV_LORA,
          2 * A_WIDTH + Q_LORA + KV_LORA + QK_ROPE,
          2 * A_WIDTH + Q_LORA + KV_LORA + QK_ROPE + C_WIDTH)
IN_COLS = SPLITS[-1] + N_BRANCH * D_MODEL
PEER_HEADS = 8
N_KEYS = 128
N_EXPERTS = N_KEYS * N_KEYS
PEER_DKEY = 256
PEER_HALF = PEER_DKEY // 2
PEER_TOPK = 16
PEER_BLOCK = 128

kernel_name = "hybrid_gated_mixers_peer_trunk"


def _rmsnorm(x, gain=None):
    xf = x.astype(jnp.float32)
    y = xf * lax.rsqrt(jnp.mean(xf * xf, axis=-1, keepdims=True) + EPS)
    if gain is not None:
        y = y * gain.astype(jnp.float32)
    return y.astype(x.dtype)


def _layernorm(x):
    xf = x.astype(jnp.float32)
    mu = jnp.mean(xf, axis=-1, keepdims=True)
    d = xf - mu
    return (d * lax.rsqrt(jnp.mean(d * d, axis=-1, keepdims=True) + EPS)).astype(x.dtype)


def _modulate(h, shift, scale):
    return h * (1 + scale[:, None, :]) + shift[:, None, :]


def _rope(x, cos, sin):
    half = x.shape[-1] // 2
    x1, x2 = x[..., :half], x[..., half:]
    cos = cos.astype(x.dtype)
    sin = sin.astype(x.dtype)
    return jnp.concatenate([x1 * cos - x2 * sin, x2 * cos + x1 * sin], axis=-1)


def _spatial_gating(u, v, w_s, b_s):
    B, S, _ = u.shape
    vn = _layernorm(v).reshape(B, S // A_CHUNK, A_CHUNK, A_GROUPS, A_GROUP_DIM)
    mixed = jnp.einsum('gts,bnsgc->bntgc', jnp.tril(w_s).astype(vn.dtype), vn)
    mixed = mixed + b_s.T.astype(vn.dtype)[:, :, None]
    return u * mixed.reshape(B, S, A_WIDTH)


def _mla(cq, ckv, kr, q_norm, w_uq, kv_norm, w_ukv, cos, sin):
    B, S, _ = cq.shape
    q = (_rmsnorm(cq, q_norm) @ w_uq).reshape(B, S, MLA_HEADS, QK_DIM)
    q = jnp.concatenate([q[..., :QK_NOPE], _rope(q[..., QK_NOPE:], cos, sin)], axis=-1)
    kv = (_rmsnorm(ckv, kv_norm) @ w_ukv).reshape(B, S, MLA_HEADS, QK_NOPE + V_DIM)
    k_rope = _rope(kr[:, :, None, :], cos, sin)
    k = jnp.concatenate([kv[..., :QK_NOPE],
                         jnp.broadcast_to(k_rope, (B, S, MLA_HEADS, QK_ROPE))], axis=-1)
    v = kv[..., QK_NOPE:]
    q = q.transpose(0, 2, 1, 3) * (1.0 / math.sqrt(QK_DIM))
    k = k.transpose(0, 2, 1, 3)
    v = v.transpose(0, 2, 1, 3)
    nq = S // Q_BLOCK
    qb = q.reshape(B, MLA_HEADS, nq, Q_BLOCK, QK_DIM).transpose(2, 0, 1, 3, 4)
    key_pos = jnp.arange(S)

    def block(args):
        qi, bi = args
        s = jnp.einsum('bhqd,bhkd->bhqk', qi, k).astype(jnp.float32)
        q_pos = bi * Q_BLOCK + jnp.arange(Q_BLOCK)
        s = jnp.where(key_pos[None, :] <= q_pos[:, None], s, -jnp.inf)
        p = jax.nn.softmax(s, axis=-1)
        return jnp.einsum('bhqk,bhkd->bhqd', p.astype(v.dtype), v)

    o = lax.map(block, (qb, jnp.arange(nq)))
    o = o.transpose(1, 0, 3, 2, 4).reshape(B, S, MLA_HEADS * V_DIM)
    return o


def _multiscale_pool(z, w_pool, pool_scale):
    B, S, _ = z.shape
    zf = z.astype(jnp.float32)
    t = jnp.arange(S)
    outs = []
    for gi, w in enumerate(POOL_WINDOWS):
        zg = zf[..., gi * C_GROUP:(gi + 1) * C_GROUP]
        cs = jnp.cumsum(jnp.pad(zg, ((0, 0), (w, 0), (0, 0))), axis=1)
        win = cs[:, w:] - cs[:, :S]
        cnt = jnp.minimum(t + 1, w).astype(jnp.float32)[None, :, None]
        outs.append((win / cnt - zg) @ w_pool[gi].astype(jnp.float32))
    y = jnp.concatenate(outs, axis=-1) * pool_scale.astype(jnp.float32)
    return y.astype(z.dtype)


def _peer(h, w_pq, sub_keys, u_tab, v_tab):
    B, S, D = h.shape
    T = B * S
    xb = h.reshape(T // PEER_BLOCK, PEER_BLOCK, D)

    def block(xt):
        q = (xt @ w_pq).reshape(PEER_BLOCK, PEER_HEADS, 2, PEER_HALF)
        s = jnp.einsum('thpd,hpkd->thpk', q, sub_keys)
        v1, i1 = lax.top_k(s[:, :, 0], PEER_TOPK)
        v2, i2 = lax.top_k(s[:, :, 1], PEER_TOPK)
        cand = (v1[..., :, None] + v2[..., None, :]).reshape(PEER_BLOCK, PEER_HEADS, -1)
        cidx = (i1[..., :, None] * N_KEYS + i2[..., None, :]).reshape(PEER_BLOCK, PEER_HEADS, -1)
        top, pos = lax.top_k(cand, PEER_TOPK)
        eidx = jnp.take_along_axis(cidx, pos, axis=-1)
        g = jax.nn.softmax(top.astype(jnp.float32), axis=-1).astype(xt.dtype)
        ue = u_tab[eidx]
        a = jax.nn.gelu(jnp.einsum('thkd,td->thk', ue, xt))
        ve = v_tab[eidx]
        return jnp.einsum('thk,thkd->td', g * a, ve)

    return lax.map(block, xb).reshape(B, S, D)


def setup_inputs(seed: int = 0) -> dict:
    key = jax.random.key(seed)
    ks = jax.random.split(key, 24)
    f32 = jnp.float32
    nrm = lambda k, shape, s: jax.random.normal(k, shape, f32) * s
    L, D = DEPTH, D_MODEL
    x = nrm(ks[0], (BATCH, SEQ, D), 1.0)
    c = nrm(ks[1], (BATCH, D), 1.0)
    offs = jax.random.randint(ks[2], (BATCH, 1), 0, 4096, dtype=jnp.int32)
    positions = (offs + jnp.arange(SEQ, dtype=jnp.int32)[None, :]).astype(jnp.int32)
    return {
        "x": x,
        "c": c,
        "positions": positions,
        "w_mod": nrm(ks[3], (L, D, 6 * D), 0.5 * D ** -0.5),
        "b_mod": nrm(ks[4], (L, 6 * D), 0.02),
        "w_in": nrm(ks[5], (L, D, IN_COLS), D ** -0.5),
        "w_s": nrm(ks[6], (L, A_GROUPS, A_CHUNK, A_CHUNK), A_CHUNK ** -0.5),
        "b_s": 1.0 + nrm(ks[7], (L, A_GROUPS, A_CHUNK), 0.02),
        "q_norm": 1.0 + nrm(ks[8], (L, Q_LORA), 0.02),
        "w_uq": nrm(ks[9], (L, Q_LORA, MLA_HEADS * QK_DIM), Q_LORA ** -0.5),
        "kv_norm": 1.0 + nrm(ks[10], (L, KV_LORA), 0.02),
        "w_ukv": nrm(ks[11], (L, KV_LORA, MLA_HEADS * (QK_NOPE + V_DIM)), KV_LORA ** -0.5),
        "w_pool": nrm(ks[12], (L, len(POOL_WINDOWS), C_GROUP, C_GROUP), C_GROUP ** -0.5),
        "pool_scale": 1.0 + nrm(ks[13], (L, C_WIDTH), 0.02),
        "w_a": nrm(ks[14], (L, A_WIDTH, D), A_WIDTH ** -0.5),
        "w_b": nrm(ks[15], (L, MLA_HEADS * V_DIM, D), (MLA_HEADS * V_DIM) ** -0.5),
        "w_c": nrm(ks[16], (L, C_WIDTH, D), C_WIDTH ** -0.5),
        "w_o": nrm(ks[17], (L, D, D), D ** -0.5),
        "w_pq": nrm(ks[18], (L, D, PEER_HEADS * PEER_DKEY), D ** -0.5),
        "sub_keys": nrm(ks[19], (L, PEER_HEADS, 2, N_KEYS, PEER_HALF), PEER_HALF ** -0.5),
        "u_tab": nrm(ks[20], (L, N_EXPERTS, D), D ** -0.5),
        "v_tab": nrm(ks[21], (L, N_EXPERTS, D), 0.5),
        "final_norm": 1.0 + nrm(ks[22], (D,), 0.02),
    }


def reference(x, c, positions, w_mod, b_mod, w_in, w_s, b_s, q_norm, w_uq, kv_norm, w_ukv,
              w_pool, pool_scale, w_a, w_b, w_c, w_o, w_pq, sub_keys, u_tab, v_tab, final_norm):
    B, S, D = x.shape
    inv_freq = 1.0 / (ROPE_THETA ** (jnp.arange(0, QK_ROPE, 2, dtype=jnp.float32) / QK_ROPE))
    ang = positions.astype(jnp.float32)[..., None] * inv_freq
    cos = jnp.cos(ang)[:, :, None, :]
    sin = jnp.sin(ang)[:, :, None, :]
    c_act = jax.nn.silu(c)
    for l in range(DEPTH):
        mod = c_act @ w_mod[l] + b_mod[l]
        sh1, sc1, g1, sh2, sc2, g2 = jnp.split(mod, 6, axis=-1)
        h = _modulate(_rmsnorm(x), sh1, sc1)
        z = h @ w_in[l]
        zu, zv, cq, ckv, kr, zp, zg = jnp.split(z, SPLITS, axis=-1)
        ya = _spatial_gating(jax.nn.gelu(zu), jax.nn.gelu(zv), w_s[l], b_s[l])
        yb = _mla(cq, ckv, kr, q_norm[l], w_uq[l], kv_norm[l], w_ukv[l], cos, sin)
        yc = _multiscale_pool(zp, w_pool[l], pool_scale[l])
        gates = jax.nn.sigmoid(zg).reshape(B, S, N_BRANCH, D)
        merged = (gates[:, :, 0] * (ya @ w_a[l]) + gates[:, :, 1] * (yb @ w_b[l])
                  + gates[:, :, 2] * (yc @ w_c[l]))
        x = x + g1[:, None, :] * (merged @ w_o[l])
        h2 = _modulate(_rmsnorm(x), sh2, sc2)
        x = x + g2[:, None, :] * _peer(h2, w_pq[l], sub_keys[l], u_tab[l], v_tab[l])
    return _rmsnorm(x, final_norm)
```

```cpp
#include <hip/hip_runtime.h>
#include <stdint.h>
#include <math.h>

#define DEVI __device__ __forceinline__
typedef unsigned short bf16_t;
typedef short bf16x8 __attribute__((ext_vector_type(8)));
typedef short s16x4 __attribute__((ext_vector_type(4)));
typedef float f32x4 __attribute__((ext_vector_type(4)));
typedef float f32x2 __attribute__((ext_vector_type(2)));
typedef float f32x16 __attribute__((ext_vector_type(16)));
typedef unsigned u32x4 __attribute__((ext_vector_type(4)));
typedef unsigned u32x2 __attribute__((ext_vector_type(2)));
typedef __bf16 bf16x2_t __attribute__((ext_vector_type(2)));
#define LAS __attribute__((address_space(3)))

constexpr int T_ = 32768, S_ = 16384, DM = 1024, NL = 4;
constexpr int ZC = 4608;
constexpr int Z_U = 0, Z_V = 256, Z_CQ = 512, Z_CKV = 896, Z_P = 1152, Z_KR = 1408, Z_G = 1536;
constexpr int NTHR = 512;
constexpr int LDS_BYTES = 114688;
constexpr float C2F = 0.14724445f;

constexpr size_t al256(size_t x) { return (x + 255) & ~(size_t)255; }
constexpr size_t OFF_CTL = 0;
constexpr size_t OFF_MOD = 16384;
constexpr size_t OFF_ROPE = OFF_MOD + al256((size_t)NL * 2 * 6144 * 4);
constexpr size_t OFF_W = OFF_ROPE + al256((size_t)T_ * 32 * 4);
constexpr size_t W_INT = 0;
constexpr size_t W_UQ = W_INT + (size_t)ZC * 1024 * 2;
constexpr size_t W_UKV = W_UQ + (size_t)768 * 384 * 2;
constexpr size_t W_A = W_UKV + (size_t)1024 * 256 * 2;
constexpr size_t W_B = W_A + (size_t)1024 * 256 * 2;
constexpr size_t W_C = W_B + (size_t)1024 * 512 * 2;
constexpr size_t W_O = W_C + (size_t)1024 * 256 * 2;
constexpr size_t W_PQ = W_O + (size_t)1024 * 1024 * 2;
constexpr size_t W_SK = W_PQ + (size_t)2048 * 1024 * 2;
constexpr size_t W_S = W_SK + (size_t)16 * 128 * 128 * 2;
constexpr size_t W_LAYER = W_S + (size_t)4 * 128 * 128 * 2;
constexpr size_t OFF_U = OFF_W + NL * W_LAYER;
constexpr size_t OFF_V = OFF_U + (size_t)NL * 16384 * 1024 * 2;
constexpr size_t OFF_H = OFF_V + (size_t)NL * 16384 * 1024 * 2;
constexpr size_t OFF_Z = OFF_H + (size_t)T_ * 1024 * 2;
constexpr size_t OFF_VN = OFF_Z + (size_t)T_ * ZC * 2;
constexpr size_t OFF_PRE = OFF_VN + (size_t)T_ * 256 * 2;
constexpr size_t OFF_YA = OFF_PRE + (size_t)T_ * 256 * 2;
constexpr size_t OFF_YB = OFF_YA + (size_t)T_ * 256 * 2;
constexpr size_t OFF_RS = OFF_YB + (size_t)T_ * 512 * 2;
constexpr size_t OFF_Q = OFF_RS + (size_t)T_ * 2 * 4;
constexpr size_t OFF_K = OFF_Q + (size_t)T_ * 768 * 2;
constexpr size_t OFF_VV = OFF_K + (size_t)T_ * 768 * 2;
constexpr size_t OFF_END = OFF_VV + (size_t)T_ * 512 * 2;
static_assert(OFF_END <= ((size_t)1 << 30), "workspace map exceeds 1 GiB");

struct P {
    const float *x, *c; const int* pos;
    const float *w_mod, *b_mod, *w_in, *w_s, *b_s, *q_norm, *w_uq, *kv_norm, *w_ukv, *w_pool, *pool_scale, *w_a, *w_b, *w_c, *w_o, *w_pq, *sub_keys, *u_tab, *v_tab, *final_norm;
    float* xr;
    unsigned char* ws;
    double invf[16];
};

DEVI unsigned cvtpk(float lo, float hi) { f32x2 v = {lo, hi}; bf16x2_t b = __builtin_convertvector(v, bf16x2_t); return __builtin_bit_cast(unsigned, b); }
DEVI bf16_t f2bf(float f) { return (bf16_t)(cvtpk(f, 0.f) & 0xffffu); }
DEVI float bf2f(bf16_t b) { return __uint_as_float(((unsigned)b) << 16); }
DEVI float bflo(unsigned w) { return __uint_as_float(w << 16); }
DEVI float bfhi(unsigned w) { return __uint_as_float(w & 0xffff0000u); }
DEVI float fexp2(float x) { return __builtin_amdgcn_exp2f(x); }
DEVI float frcp(float x) { return __builtin_amdgcn_rcpf(x); }
DEVI float sigmoidf_(float x) { return frcp(1.f + fexp2(-1.4426950408889634f * x)); }
DEVI float gelu_tanh(float x) { const float u = 0.7978845608028654f * (x + 0.044715f * x * x * x); return x * frcp(1.f + fexp2(-2.8853900817779268f * u)); }
DEVI float wave_sum(float v) {
#pragma unroll
    for (int o = 32; o > 0; o >>= 1) v += __shfl_xor(v, o);
    return v;
}
#define MFMA16(a, b, c) __builtin_amdgcn_mfma_f32_16x16x32_bf16(a, b, c, 0, 0, 0)
#define MFMA32(a, b, c) __builtin_amdgcn_mfma_f32_32x32x16_bf16(a, b, c, 0, 0, 0)

constexpr int GP = 72;
DEVI void gemm_kloop(f32x4 (&acc)[4][4], const bf16_t* __restrict__ Ap, int lda, const bf16_t* __restrict__ Bp, int ldb, int K, char* lds) {
    const int tid = threadIdx.x, lane = tid & 63, wid = tid >> 6, wm = wid >> 1, wn = wid & 1, fr = lane & 15, fq = lane >> 4;
    bf16_t* const As0 = (bf16_t*)lds; bf16_t* const Bs0 = As0 + 256 * GP; bf16_t* const As1 = Bs0 + 128 * GP; bf16_t* const Bs1 = As1 + 256 * GP;
    const int nt = K >> 6;
    const int sr = tid >> 3, sc = (tid & 7) * 8;
    const bf16_t* ag = Ap + (size_t)sr * lda + sc; const bf16_t* bg = Bp + (size_t)sr * ldb + sc;
    u32x4 ra[4], rb[2];
#define G_LOAD(kt) do { _Pragma("unroll") for (int i_ = 0; i_ < 4; ++i_) ra[i_] = *(const u32x4*)(ag + (size_t)(i_ * 64) * lda + (kt) * 64); \
                        _Pragma("unroll") for (int i_ = 0; i_ < 2; ++i_) rb[i_] = *(const u32x4*)(bg + (size_t)(i_ * 64) * ldb + (kt) * 64); } while (0)
#define G_WRITE(As, Bs) do { _Pragma("unroll") for (int i_ = 0; i_ < 4; ++i_) *(u32x4*)((As) + (sr + i_ * 64) * GP + sc) = ra[i_]; \
                             _Pragma("unroll") for (int i_ = 0; i_ < 2; ++i_) *(u32x4*)((Bs) + (sr + i_ * 64) * GP + sc) = rb[i_]; } while (0)
    __syncthreads();
    G_LOAD(0); G_WRITE(As0, Bs0);
    __syncthreads();
    for (int kt = 0; kt < nt; ++kt) {
        const bf16_t* As = (kt & 1) ? As1 : As0; const bf16_t* Bs = (kt & 1) ? Bs1 : Bs0;
        if (kt + 1 < nt) G_LOAD(kt + 1);
#pragma unroll
        for (int kk = 0; kk < 2; ++kk) {
            bf16x8 af[4], bfr[4];
#pragma unroll
            for (int m = 0; m < 4; ++m) af[m] = *(const bf16x8*)(As + (wm * 64 + m * 16 + fr) * GP + kk * 32 + fq * 8);
#pragma unroll
            for (int n = 0; n < 4; ++n) bfr[n] = *(const bf16x8*)(Bs + (wn * 64 + n * 16 + fr) * GP + kk * 32 + fq * 8);
#pragma unroll
            for (int m = 0; m < 4; ++m)
#pragma unroll
                for (int n = 0; n < 4; ++n) acc[m][n] = MFMA16(bfr[n], af[m], acc[m][n]);
        }
        if (kt + 1 < nt) { if (kt & 1) G_WRITE(As0, Bs0); else G_WRITE(As1, Bs1); }
        __syncthreads();
    }
#undef G_LOAD
#undef G_WRITE
}
DEVI void acc_zero(f32x4 (&acc)[4][4]) {
#pragma unroll
    for (int m = 0; m < 4; ++m)
#pragma unroll
        for (int n = 0; n < 4; ++n) acc[m][n] = (f32x4){0.f, 0.f, 0.f, 0.f};
}
template <class Epi>
DEVI void gemm_phase(const bf16_t* A, int lda, int a_pn_stride, const bf16_t* Bt, int ldb, int M, int N, int K, char* lds, const Epi& epi) {
    const int nn = N >> 7, nu = (M >> 8) * nn;
    const int lane = threadIdx.x & 63, wid = threadIdx.x >> 6, wm = wid >> 1, wn = wid & 1, fr = lane & 15, fq = lane >> 4;
    for (int u = blockIdx.x; u < nu; u += gridDim.x) {
        const int pm = u / nn, pn = u - pm * nn;
        f32x4 acc[4][4]; acc_zero(acc);
        gemm_kloop(acc, A + (size_t)pm * 256 * lda + (size_t)pn * a_pn_stride, lda, Bt + (size_t)pn * 128 * ldb, ldb, K, lds);
#pragma unroll
        for (int m = 0; m < 4; ++m)
#pragma unroll
            for (int n = 0; n < 4; ++n) epi(pm * 256 + wm * 64 + m * 16 + fr, pn * 128 + wn * 64 + n * 16 + 4 * fq, acc[m][n]);
    }
}
DEVI void st_bf4(bf16_t* p, f32x4 v) { u32x2 w; w.x = cvtpk(v[0], v[1]); w.y = cvtpk(v[2], v[3]); *(u32x2*)p = w; }
DEVI f32x4 ld_bf4(const bf16_t* p) { const u32x2 w = *(const u32x2*)p; return (f32x4){bflo(w.x), bfhi(w.x), bflo(w.y), bfhi(w.y)}; }

struct EpiZ { bf16_t* z;
    DEVI void operator()(int row, int col, f32x4 v) const {
        if (col < Z_CQ) { v[0] = gelu_tanh(v[0]); v[1] = gelu_tanh(v[1]); v[2] = gelu_tanh(v[2]); v[3] = gelu_tanh(v[3]); }
        else if (col >= Z_G) { v[0] = sigmoidf_(v[0]); v[1] = sigmoidf_(v[1]); v[2] = sigmoidf_(v[2]); v[3] = sigmoidf_(v[3]); }
        st_bf4(z + (size_t)row * ZC + col, v); } };
struct EpiBf { bf16_t* o; int ldo;
    DEVI void operator()(int row, int col, f32x4 v) const { st_bf4(o + (size_t)row * ldo + col, v); } };
struct EpiKV { bf16_t* k; bf16_t* v_; const float* rs;
    DEVI void operator()(int row, int col, f32x4 v) const {
        const float s = rs[row]; v = v * s; const int h = col >> 7, c = col & 127;
        if (c < 64) st_bf4(k + (size_t)row * 768 + h * 96 + c, v); else st_bf4(v_ + (size_t)row * 512 + h * 64 + (c - 64), v); } };
struct EpiWo { float* x; const float* g;
    DEVI void operator()(int row, int col, f32x4 v) const {
        const float* gp = g + (row >= S_ ? 6144 : 0) + col; float* xp = x + (size_t)row * DM + col;
        f32x4 xv = *(const f32x4*)xp; const f32x4 gv = *(const f32x4*)gp; xv = xv + gv * v; *(f32x4*)xp = xv; } };
struct EpiScT { float* s;
    DEVI void operator()(int row, int col, f32x4 v) const {
#pragma unroll
        for (int i = 0; i < 4; ++i) s[(size_t)(col + i) * T_ + row] = v[i]; } };

DEVI void job_transpose(const float* __restrict__ src, int K, int N, bf16_t* __restrict__ dst, int mapmode, const float* __restrict__ kscale, char* lds) {
    float* tile = (float*)lds;
    const int tid = threadIdx.x, nkt = K >> 6, nnt = N >> 5, ntile = nkt * nnt;
    for (int t = blockIdx.x; t < ntile; t += gridDim.x) {
        const int kt = t / nnt, ntl = t - kt * nnt, k0 = kt * 64, n0 = ntl * 32;
        __syncthreads();
        { const int r = tid >> 3, c4 = (tid & 7) * 4; f32x4 v = *(const f32x4*)(src + (size_t)(k0 + r) * N + n0 + c4);
          if (kscale) { const float s = kscale[k0 + r]; v = v * s; }
          tile[r * 33 + c4] = v[0]; tile[r * 33 + c4 + 1] = v[1]; tile[r * 33 + c4 + 2] = v[2]; tile[r * 33 + c4 + 3] = v[3]; }
        __syncthreads();
        if (tid < 256) { const int nl = tid >> 3, kc = (tid & 7) * 8; int n = n0 + nl;
            if (mapmode == 1) { n = (n < 1152) ? n : (n < 1184) ? n + 256 : (n < 1440) ? n - 32 : n + 96; }
            u32x4 w; w.x = cvtpk(tile[(kc + 0) * 33 + nl], tile[(kc + 1) * 33 + nl]); w.y = cvtpk(tile[(kc + 2) * 33 + nl], tile[(kc + 3) * 33 + nl]);
            w.z = cvtpk(tile[(kc + 4) * 33 + nl], tile[(kc + 5) * 33 + nl]); w.w = cvtpk(tile[(kc + 6) * 33 + nl], tile[(kc + 7) * 33 + nl]);
            *(u32x4*)(dst + (size_t)n * K + k0 + kc) = w; }
    }
}
DEVI void job_convert(const float* __restrict__ src, bf16_t* __restrict__ dst, size_t n4, int tril) {
    const size_t stride = (size_t)gridDim.x * NTHR;
    for (size_t i = (size_t)blockIdx.x * NTHR + threadIdx.x; i < n4; i += stride) {
        f32x4 v = *(const f32x4*)(src + i * 4);
        if (tril) { const int e = (int)((i * 4) & 16383), t = e >> 7, s = e & 127;
#pragma unroll
            for (int j = 0; j < 4; ++j) if (s + j > t) v[j] = 0.f; }
        st_bf4(dst + i * 4, v);
    }
}
DEVI void phase_prologue(const P& p, char* lds) {
    const int tid = threadIdx.x;
    const size_t gtid = (size_t)blockIdx.x * NTHR + tid, gstride = (size_t)gridDim.x * NTHR;
    for (size_t i = gtid; i < (size_t)T_ * DM / 4; i += gstride) ((f32x4*)p.xr)[i] = ((const f32x4*)p.x)[i];
    { float* rope = (float*)(p.ws + OFF_ROPE);
      for (size_t i = gtid; i < (size_t)T_ * 16; i += gstride) { const int t = (int)(i >> 4), f = (int)(i & 15);
          const float angf = (float)p.pos[t] * (float)p.invf[f];
          const double rev = (double)angf * 0.15915494309189535; const double fr = rev - rint(rev);
          rope[(size_t)t * 32 + f] = __builtin_amdgcn_cosf((float)fr); rope[(size_t)t * 32 + 16 + f] = __builtin_amdgcn_sinf((float)fr); } }
    { float* ca = (float*)lds; float* red = ca + 2048;
      float* mod = (float*)(p.ws + OFF_MOD);
      __syncthreads();
      for (int i = tid; i < 2048; i += NTHR) { const float cv = p.c[i]; ca[i] = cv * sigmoidf_(cv); }
      __syncthreads();
      for (int wi = blockIdx.x; wi < NL * 48; wi += gridDim.x) {
          const int l = wi / 48, j0 = (wi - l * 48) * 128, kg = tid >> 7, jc = tid & 127;
          const float* w = p.w_mod + (size_t)l * 1024 * 6144 + j0 + jc; float a0 = 0.f, a1 = 0.f;
          for (int k = kg * 256; k < kg * 256 + 256; ++k) { const float wv = w[(size_t)k * 6144]; a0 += ca[k] * wv; a1 += ca[1024 + k] * wv; }
          red[(kg * 2 + 0) * 128 + jc] = a0; red[(kg * 2 + 1) * 128 + jc] = a1;
          __syncthreads();
          if (tid < 256) { const int b = tid >> 7; const float s = red[(0 + b) * 128 + jc] + red[(2 + b) * 128 + jc] + red[(4 + b) * 128 + jc] + red[(6 + b) * 128 + jc];
              mod[((size_t)l * 2 + b) * 6144 + j0 + jc] = s + p.b_mod[(size_t)l * 6144 + j0 + jc]; }
          __syncthreads();
      } }
    for (int l = 0; l < NL; ++l) {
        unsigned char* wl = p.ws + OFF_W + (size_t)l * W_LAYER;
        job_transpose(p.w_in + (size_t)l * 1024 * 4512, 1024, 4512, (bf16_t*)(wl + W_INT), 1, nullptr, lds);
        for (size_t i = gtid; i < (size_t)96 * 1024 / 8; i += gstride) ((u32x4*)(wl + W_INT + (size_t)1440 * 1024 * 2))[i] = (u32x4){0u, 0u, 0u, 0u};
        job_transpose(p.w_uq + (size_t)l * 384 * 768, 384, 768, (bf16_t*)(wl + W_UQ), 0, p.q_norm + l * 384, lds);
        job_transpose(p.w_ukv + (size_t)l * 256 * 1024, 256, 1024, (bf16_t*)(wl + W_UKV), 0, p.kv_norm + l * 256, lds);
        job_transpose(p.w_a + (size_t)l * 256 * 1024, 256, 1024, (bf16_t*)(wl + W_A), 0, nullptr, lds);
        job_transpose(p.w_b + (size_t)l * 512 * 1024, 512, 1024, (bf16_t*)(wl + W_B), 0, nullptr, lds);
        job_transpose(p.w_o + (size_t)l * 1024 * 1024, 1024, 1024, (bf16_t*)(wl + W_O), 0, nullptr, lds);
        job_transpose(p.w_pq + (size_t)l * 1024 * 2048, 1024, 2048, (bf16_t*)(wl + W_PQ), 0, nullptr, lds);
        job_convert(p.sub_keys + (size_t)l * 16 * 128 * 128, (bf16_t*)(wl + W_SK), (size_t)16 * 128 * 128 / 4, 0);
        job_convert(p.w_s + (size_t)l * 4 * 128 * 128, (bf16_t*)(wl + W_S), (size_t)4 * 128 * 128 / 4, 1);
        { bf16_t* wc = (bf16_t*)(wl + W_C); const float* wp = p.w_pool + (size_t)l * 4 * 64 * 64; const float* ps = p.pool_scale + l * 256; const float* wcs = p.w_c + (size_t)l * 256 * 1024;
          for (size_t i = gtid; i < (size_t)256 * 1024; i += gstride) { const int k = (int)(i >> 10), n = (int)(i & 1023), g = k >> 6, c = k & 63; float a = 0.f;
              for (int j = 0; j < 64; ++j) a += wp[(g * 64 + c) * 64 + j] * ps[g * 64 + j] * wcs[(size_t)(g * 64 + j) * 1024 + n];
              wc[(size_t)n * 256 + k] = f2bf(a); } }
    }
    job_convert(p.u_tab, (bf16_t*)(p.ws + OFF_U), (size_t)NL * 16384 * 1024 / 4, 0);
    job_convert(p.v_tab, (bf16_t*)(p.ws + OFF_V), (size_t)NL * 16384 * 1024 / 4, 0);
}

DEVI void phase_norm(const P& p, const float* sh, const float* sc) {
    const int lane = threadIdx.x & 63, wid = threadIdx.x >> 6; bf16_t* h = (bf16_t*)(p.ws + OFF_H);
    for (int t = blockIdx.x * 8 + wid; t < T_; t += gridDim.x * 8) {
        const float* xp = p.xr + (size_t)t * DM; f32x4 v[4]; float ss = 0.f;
#pragma unroll
        for (int i = 0; i < 4; ++i) { v[i] = *(const f32x4*)(xp + i * 256 + lane * 4); ss += v[i][0] * v[i][0] + v[i][1] * v[i][1] + v[i][2] * v[i][2] + v[i][3] * v[i][3]; }
        ss = wave_sum(ss); const float rs = rsqrtf(ss * (1.f / 1024.f) + 1e-6f); const int bo = (t >= S_) ? 6144 : 0;
#pragma unroll
        for (int i = 0; i < 4; ++i) { const int col = i * 256 + lane * 4; const f32x4 a = *(const f32x4*)(sc + bo + col), b = *(const f32x4*)(sh + bo + col);
            f32x4 o = v[i] * rs * (a + 1.f) + b; st_bf4(h + (size_t)t * DM + col, o); }
    }
}
DEVI void phase_final(const P& p) {
    const int lane = threadIdx.x & 63, wid = threadIdx.x >> 6;
    for (int t = blockIdx.x * 8 + wid; t < T_; t += gridDim.x * 8) {
        float* xp = p.xr + (size_t)t * DM; f32x4 v[4]; float ss = 0.f;
#pragma unroll
        for (int i = 0; i < 4; ++i) { v[i] = *(const f32x4*)(xp + i * 256 + lane * 4); ss += v[i][0] * v[i][0] + v[i][1] * v[i][1] + v[i][2] * v[i][2] + v[i][3] * v[i][3]; }
        ss = wave_sum(ss); const float rs = rsqrtf(ss * (1.f / 1024.f) + 1e-6f);
#pragma unroll
        for (int i = 0; i < 4; ++i) { const int col = i * 256 + lane * 4; const f32x4 g = *(const f32x4*)(p.final_norm + col); *(f32x4*)(xp + col) = v[i] * rs * g; }
    }
}
DEVI void phase_post(const P& p) {
    const int lane = threadIdx.x & 63, wid = threadIdx.x >> 6;
    const bf16_t* z = (const bf16_t*)(p.ws + OFF_Z); bf16_t* vn = (bf16_t*)(p.ws + OFF_VN); bf16_t* pre = (bf16_t*)(p.ws + OFF_PRE); bf16_t* Kb = (bf16_t*)(p.ws + OFF_K);
    float* rsq = (float*)(p.ws + OFF_RS); float* rskv = rsq + T_; const float* rope = (const float*)(p.ws + OFF_ROPE);
    for (int t = blockIdx.x * 8 + wid; t < T_; t += gridDim.x * 8) {
        const bf16_t* zr = z + (size_t)t * ZC;
        { f32x4 v = ld_bf4(zr + Z_V + lane * 4); const float mu = wave_sum(v[0] + v[1] + v[2] + v[3]) * (1.f / 256.f); v = v - mu;
          const float var = wave_sum(v[0] * v[0] + v[1] * v[1] + v[2] * v[2] + v[3] * v[3]) * (1.f / 256.f); v = v * rsqrtf(var + 1e-6f); st_bf4(vn + (size_t)t * 256 + lane * 4, v); }
        { float ss = 0.f;
#pragma unroll
          for (int i = 0; i < 3; ++i) { const unsigned w = *(const unsigned*)(zr + Z_CQ + i * 128 + lane * 2); const float a = bflo(w), b = bfhi(w); ss += a * a + b * b; }
          ss = wave_sum(ss); if (lane == 0) rsq[t] = rsqrtf(ss * (1.f / 384.f) + 1e-6f); }
        { const f32x4 v = ld_bf4(zr + Z_CKV + lane * 4); const float ss = wave_sum(v[0] * v[0] + v[1] * v[1] + v[2] * v[2] + v[3] * v[3]); if (lane == 0) rskv[t] = rsqrtf(ss * (1.f / 256.f) + 1e-6f); }
        if (lane < 16) { const float x1 = bf2f(zr[Z_KR + lane]), x2 = bf2f(zr[Z_KR + 16 + lane]); const float cs = rope[(size_t)t * 32 + lane], sn = rope[(size_t)t * 32 + 16 + lane];
            const bf16_t o1 = f2bf(x1 * cs - x2 * sn), o2 = f2bf(x2 * cs + x1 * sn); bf16_t* kr = Kb + (size_t)t * 768 + 64 + lane;
#pragma unroll
            for (int h = 0; h < 8; ++h) { kr[h * 96] = o1; kr[h * 96 + 16] = o2; } }
        { const int tt = t & (S_ - 1), w = 2 << (lane >> 4), n = (tt + 1 < w) ? tt + 1 : w; f32x4 sum = (f32x4){0.f, 0.f, 0.f, 0.f};
          const bf16_t* zp = zr + Z_P + lane * 4; const f32x4 self = ld_bf4(zp);
          for (int s = 0; s < 16; ++s) if (s < n) sum = sum + ld_bf4(zp - (size_t)s * ZC);
          const f32x4 o = sum * (1.f / (float)n) - self; st_bf4(pre + (size_t)t * 256 + lane * 4, o); }
    }
}
DEVI void phase_mixa(const P& p, int l, char* lds) {
    const int tid = threadIdx.x, lane = tid & 63, wid = tid >> 6, fr = lane & 15, fq = lane >> 4, g = wid >> 1, th = (wid & 1) * 64;
    constexpr int VP = 136;
    bf16_t* vnT = (bf16_t*)lds;
    const bf16_t* vn = (const bf16_t*)(p.ws + OFF_VN); const bf16_t* z = (const bf16_t*)(p.ws + OFF_Z); bf16_t* ya = (bf16_t*)(p.ws + OFF_YA);
    const bf16_t* Wg = (const bf16_t*)(p.ws + OFF_W + (size_t)l * W_LAYER + W_S) + (size_t)g * 128 * 128; const float* bs = p.b_s + (size_t)l * 512 + g * 128;
    for (int ch = blockIdx.x; ch < T_ / 128; ch += gridDim.x) {
        const size_t t0 = (size_t)ch * 128;
        __syncthreads();
#pragma unroll
        for (int i = 0; i < 8; ++i) { const int id = tid + i * NTHR, s = id >> 5, c8 = (id & 31) * 8; const u32x4 w = *(const u32x4*)(vn + (t0 + s) * 256 + c8);
            bf16_t* d = vnT + c8 * VP + s; d[0] = (bf16_t)(w.x & 0xffff); d[VP] = (bf16_t)(w.x >> 16); d[2 * VP] = (bf16_t)(w.y & 0xffff); d[3 * VP] = (bf16_t)(w.y >> 16);
            d[4 * VP] = (bf16_t)(w.z & 0xffff); d[5 * VP] = (bf16_t)(w.z >> 16); d[6 * VP] = (bf16_t)(w.w & 0xffff); d[7 * VP] = (bf16_t)(w.w >> 16); }
        __syncthreads();
        f32x4 acc[4][4]; acc_zero(acc);
#pragma unroll
        for (int kk = 0; kk < 4; ++kk) {
            bf16x8 af[4], bfr[4];
#pragma unroll
            for (int m = 0; m < 4; ++m) af[m] = *(const bf16x8*)(Wg + (size_t)(th + m * 16 + fr) * 128 + kk * 32 + fq * 8);
#pragma unroll
            for (int n = 0; n < 4; ++n) bfr[n] = *(const bf16x8*)(vnT + (g * 64 + n * 16 + fr) * VP + kk * 32 + fq * 8);
#pragma unroll
            for (int m = 0; m < 4; ++m)
#pragma unroll
                for (int n = 0; n < 4; ++n) acc[m][n] = MFMA16(bfr[n], af[m], acc[m][n]);
        }
#pragma unroll
        for (int m = 0; m < 4; ++m) { const int tl = th + m * 16 + fr; const float bias = bs[tl];
#pragma unroll
            for (int n = 0; n < 4; ++n) { const int c = g * 64 + n * 16 + 4 * fq; const f32x4 u = ld_bf4(z + (t0 + tl) * ZC + Z_U + c); f32x4 o = (acc[m][n] + bias) * u; st_bf4(ya + (t0 + tl) * 256 + c, o); } }
    }
}
DEVI int crow(int r, int hi) { return (r & 3) + 8 * (r >> 2) + 4 * hi; }
DEVI s16x4 vtr(const char* p) { typedef short v4i16_t __attribute__((ext_vector_type(4))); return __builtin_bit_cast(s16x4, __builtin_amdgcn_ds_read_tr16_b64_v4i16((LAS v4i16_t*)p)); }
DEVI float hswap_max(float v) { return fmaxf(v, __shfl_xor(v, 32)); }
DEVI void attn_unit(const P& p, int b, int h, int qb, char* lds) {
    const int tid = threadIdx.x, lane = tid & 63, r32 = lane & 31, hi = lane >> 5, wid = tid >> 6;
    char* Ks = lds; char* Vs = lds + 12288; float* wsf = (float*)(lds + 20480) + wid * 64;
    const bf16_t* Qb = (const bf16_t*)(p.ws + OFF_Q); const bf16_t* Kb = (const bf16_t*)(p.ws + OFF_K); const bf16_t* Vb = (const bf16_t*)(p.ws + OFF_VV); bf16_t* Yb = (bf16_t*)(p.ws + OFF_YB);
    const size_t rowbase = (size_t)b * S_; const int q0 = qb * 256, NT = 4 * qb + 4;
    bf16x8 qr[6];
    { const size_t tq = rowbase + q0 + wid * 32 + r32; const bf16_t* qp = Qb + tq * 768 + h * 96 + hi * 8; const float rs = ((const float*)(p.ws + OFF_RS))[tq]; const float sc = rs * C2F;
      const float* rp = (const float*)(p.ws + OFF_ROPE) + tq * 32 + hi * 8;
      u32x4 raw[6];
#pragma unroll
      for (int d0 = 0; d0 < 6; ++d0) raw[d0] = *(const u32x4*)(qp + d0 * 16);
#pragma unroll
      for (int d0 = 0; d0 < 4; ++d0) { u32x4 w;
#pragma unroll
          for (int j = 0; j < 4; ++j) w[j] = cvtpk(bflo(raw[d0][j]) * sc, bfhi(raw[d0][j]) * sc);
          qr[d0] = __builtin_bit_cast(bf16x8, w); }
      u32x4 w1, w2;
#pragma unroll
      for (int j = 0; j < 4; ++j) { const float a0 = bflo(raw[4][j]), a1 = bfhi(raw[4][j]), b0 = bflo(raw[5][j]), b1 = bfhi(raw[5][j]);
          const float c0 = rp[2 * j], c1 = rp[2 * j + 1], s0 = rp[16 + 2 * j], s1 = rp[16 + 2 * j + 1];
          w1[j] = cvtpk((a0 * c0 - b0 * s0) * sc, (a1 * c1 - b1 * s1) * sc); w2[j] = cvtpk((b0 * c0 + a0 * s0) * sc, (b1 * c1 + a1 * s1) * sc); }
      qr[4] = __builtin_bit_cast(bf16x8, w1); qr[5] = __builtin_bit_cast(bf16x8, w2); }
    const bf16_t* Kg = Kb + rowbase * 768 + h * 96; const bf16_t* Vg = Vb + rowbase * 512 + h * 64;
    const int kc0 = tid >> 6, kk0 = tid & 63;
    const int vw = tid >> 6, vl = tid & 63, vrow = 16 * (vw & 3) + (vl >> 2), vcol = (vw >> 2) * 32 + (vl & 3) * 8;
    u32x4 rk0, rk1 = (u32x4){0u, 0u, 0u, 0u}, rv;
#define A_LOAD(t) do { rk0 = *(const u32x4*)(Kg + (size_t)((t) * 64 + kk0) * 768 + kc0 * 8); if (tid < 256) rk1 = *(const u32x4*)(Kg + (size_t)((t) * 64 + kk0) * 768 + (kc0 + 8) * 8); \
                       rv = *(const u32x4*)(Vg + (size_t)((t) * 64 + vrow) * 512 + vcol); } while (0)
    A_LOAD(0);
    f32x16 o0, o1;
#pragma unroll
    for (int r = 0; r < 16; ++r) { o0[r] = 0.f; o1[r] = 0.f; }
    float mrun = -1e30f, lrun = 0.f;
    const int qrel = wid * 32 + r32;
    const char* vp0 = Vs + ((lane >> 4) & 1) * 32 + (lane & 3) * 8 + (4 * hi + ((lane & 15) >> 2)) * 64;
    for (int t = 0; t < NT; ++t) {
        __syncthreads();
        *(u32x4*)(Ks + kc0 * 1024 + kk0 * 16) = rk0; if (tid < 256) *(u32x4*)(Ks + (kc0 + 8) * 1024 + kk0 * 16) = rk1;
        *(u32x4*)(Vs + vw * 1024 + vl * 16) = rv;
        __syncthreads();
        if (t + 1 < NT) A_LOAD(t + 1);
        f32x16 p0, p1;
#pragma unroll
        for (int r = 0; r < 16; ++r) { p0[r] = 0.f; p1[r] = 0.f; }
#pragma unroll
        for (int d0 = 0; d0 < 6; ++d0) { const bf16x8 k0 = *(const bf16x8*)(Ks + (2 * d0 + hi) * 1024 + r32 * 16), k1 = *(const bf16x8*)(Ks + (2 * d0 + hi) * 1024 + 512 + r32 * 16);
            p0 = MFMA32(k0, qr[d0], p0); p1 = MFMA32(k1, qr[d0], p1); }
        if (t >= NT - 4) { const int kb = 64 * (t - (NT - 4)) + 4 * hi;
#pragma unroll
            for (int r = 0; r < 16; ++r) { const int kv = kb + (r & 3) + 8 * (r >> 2); if (kv > qrel) p0[r] = -INFINITY; if (kv + 32 > qrel) p1[r] = -INFINITY; } }
        float rm = fmaxf(p0[0], p1[0]);
#pragma unroll
        for (int r = 1; r < 16; ++r) rm = fmaxf(rm, fmaxf(p0[r], p1[r]));
        rm = hswap_max(rm);
        const float mnew = fmaxf(mrun, rm), alpha = fexp2(mrun - mnew); mrun = mnew;
        float ls = 0.f;
#pragma unroll
        for (int r = 0; r < 16; ++r) { p0[r] = fexp2(p0[r] - mnew); p1[r] = fexp2(p1[r] - mnew); ls += p0[r] + p1[r]; }
        lrun = lrun * alpha + ls;
        if (__any(alpha != 1.f)) {
            if (hi == 0) wsf[r32] = alpha;
            asm volatile("s_waitcnt lgkmcnt(0)" ::: "memory");
#pragma unroll
            for (int r = 0; r < 16; ++r) { const float f = wsf[crow(r, hi)]; o0[r] *= f; o1[r] *= f; }
            asm volatile("s_waitcnt lgkmcnt(0)" ::: "memory");
        }
        u32x4 pw[4];
#pragma unroll
        for (int j = 0; j < 4; ++j) { pw[0][j] = cvtpk(p0[2 * j], p0[2 * j + 1]); pw[1][j] = cvtpk(p0[8 + 2 * j], p0[8 + 2 * j + 1]); pw[2][j] = cvtpk(p1[2 * j], p1[2 * j + 1]); pw[3][j] = cvtpk(p1[8 + 2 * j], p1[8 + 2 * j + 1]); }
#pragma unroll
        for (int ks = 0; ks < 4; ++ks) {
            const s16x4 a0 = vtr(vp0 + ks * 1024), a1 = vtr(vp0 + ks * 1024 + 512), b0 = vtr(vp0 + 4096 + ks * 1024), b1 = vtr(vp0 + 4096 + ks * 1024 + 512);
            const bf16x8 v0 = (bf16x8){a0[0], a0[1], a0[2], a0[3], a1[0], a1[1], a1[2], a1[3]}, v1 = (bf16x8){b0[0], b0[1], b0[2], b0[3], b1[0], b1[1], b1[2], b1[3]};
            const bf16x8 pa = __builtin_bit_cast(bf16x8, pw[ks]);
            o0 = MFMA32(pa, v0, o0); o1 = MFMA32(pa, v1, o1);
        }
    }
#undef A_LOAD
    lrun += __shfl_xor(lrun, 32);
    if (hi == 0) wsf[32 + r32] = lrun;
    asm volatile("s_waitcnt lgkmcnt(0)" ::: "memory");
    bf16_t* yo = Yb + (rowbase + q0 + wid * 32) * 512 + h * 64 + r32;
#pragma unroll
    for (int r = 0; r < 16; ++r) { const int row = crow(r, hi); const float rl = frcp(wsf[32 + row]); yo[(size_t)row * 512] = f2bf(o0[r] * rl); yo[(size_t)row * 512 + 32] = f2bf(o1[r] * rl); }
    asm volatile("s_waitcnt lgkmcnt(0)" ::: "memory");
}
DEVI void phase_attn(const P& p, char* lds) {
    for (int v = blockIdx.x; v < 256; v += gridDim.x) {
        const int bh = v >> 4, s = v & 15;
#pragma unroll 1
        for (int i = 0; i < 4; ++i) { const int qb = (i == 0) ? s : (i == 1) ? 31 - s : (i == 2) ? 32 + s : 63 - s; attn_unit(p, bh >> 3, bh & 7, qb, lds); }
    }
}
DEVI void phase_merge(const P& p, int l, char* lds) {
    const int lane = threadIdx.x & 63, wid = threadIdx.x >> 6, wm = wid >> 1, wn = wid & 1, fr = lane & 15, fq = lane >> 4;
    const unsigned char* wl = p.ws + OFF_W + (size_t)l * W_LAYER; const bf16_t* z = (const bf16_t*)(p.ws + OFF_Z); bf16_t* mg = (bf16_t*)(p.ws + OFF_H);
    for (int u = blockIdx.x; u < 128 * 8; u += gridDim.x) {
        const int pm = u >> 3, pn = u & 7;
        f32x4 tot[4][4]; acc_zero(tot);
#pragma unroll 1
        for (int seg = 0; seg < 3; ++seg) {
            const bf16_t* A = (seg == 0) ? (const bf16_t*)(p.ws + OFF_YA) : (seg == 1) ? (const bf16_t*)(p.ws + OFF_YB) : (const bf16_t*)(p.ws + OFF_PRE);
            const int K = (seg == 1) ? 512 : 256; const bf16_t* Bt = (const bf16_t*)(wl + ((seg == 0) ? W_A : (seg == 1) ? W_B : W_C));
            f32x4 acc[4][4]; acc_zero(acc);
            gemm_kloop(acc, A + (size_t)pm * 256 * K, K, Bt + (size_t)pn * 128 * K, K, K, lds);
#pragma unroll
            for (int m = 0; m < 4; ++m)
#pragma unroll
                for (int n = 0; n < 4; ++n) { const int row = pm * 256 + wm * 64 + m * 16 + fr, col = pn * 128 + wn * 64 + n * 16 + 4 * fq;
                    const f32x4 gt = ld_bf4(z + (size_t)row * ZC + Z_G + seg * 1024 + col); tot[m][n] = tot[m][n] + gt * acc[m][n]; }
        }
#pragma unroll
        for (int m = 0; m < 4; ++m)
#pragma unroll
            for (int n = 0; n < 4; ++n) { const int row = pm * 256 + wm * 64 + m * 16 + fr, col = pn * 128 + wn * 64 + n * 16 + 4 * fq; st_bf4(mg + (size_t)row * DM + col, tot[m][n]); }
    }
}
DEVI int f2key(float f) { const int b = __float_as_int(f); return b ^ ((b >> 31) & 0x7fffffff); }
DEVI float key2f(int k) { return __int_as_float(k ^ ((k >> 31) & 0x7fffffff)); }
#define INS16(L, xin) do { int x_ = (xin); _Pragma("unroll") for (int i_ = 0; i_ < 16; ++i_) { const int hi_ = max(L[i_], x_); x_ = min(L[i_], x_); L[i_] = hi_; } } while (0)
DEVI void phase_topk(const P& p) {
    const float* sT = (const float*)(p.ws + OFF_Z); int* eidx = (int*)(p.ws + OFF_YA); float* gw = (float*)(p.ws + OFF_VN);
    for (int wi = blockIdx.x * NTHR + threadIdx.x; wi < 8 * T_; wi += gridDim.x * NTHR) {
        const int h = wi >> 15, t = wi & (T_ - 1);
        int L1[16], L2[16];
#pragma unroll
        for (int i = 0; i < 16; ++i) { L1[i] = (int)0x80000000; L2[i] = (int)0x80000000; }
        const float* s1 = sT + (size_t)(h * 256) * T_ + t; const float* s2 = s1 + (size_t)128 * T_;
#pragma unroll 4
        for (int k = 0; k < 128; ++k) { const int a = (f2key(s1[(size_t)k * T_]) & ~127) | (127 - k); INS16(L1, a); }
#pragma unroll 4
        for (int k = 0; k < 128; ++k) { const int a = (f2key(s2[(size_t)k * T_]) & ~127) | (127 - k); INS16(L2, a); }
        float v1[16], v2[16];
#pragma unroll
        for (int i = 0; i < 16; ++i) { v1[i] = key2f(L1[i] & ~127); v2[i] = key2f(L2[i] & ~127); }
        int C[16];
#pragma unroll
        for (int i = 0; i < 16; ++i) C[i] = (int)0x80000000;
#pragma unroll
        for (int a = 0; a < 16; ++a)
#pragma unroll
            for (int b = 0; b < 16; ++b) if ((a + 1) * (b + 1) <= 16) { const int kx = (f2key(v1[a] + v2[b]) & ~255) | (255 - (a * 16 + b)); INS16(C, kx); }
        float tv[16]; int te[16];
#pragma unroll
        for (int i = 0; i < 16; ++i) { const int pos = 255 - (C[i] & 255), a = pos >> 4, b = pos & 15; int ka = 0, kb = 0;
#pragma unroll
            for (int j = 0; j < 16; ++j) { ka = (a == j) ? L1[j] : ka; kb = (b == j) ? L2[j] : kb; }
            te[i] = (127 - (ka & 127)) * 128 + (127 - (kb & 127)); tv[i] = key2f(ka & ~127) + key2f(kb & ~127); }
        float sum = 0.f; const float tmax = tv[0];
#pragma unroll
        for (int i = 0; i < 16; ++i) { tv[i] = fexp2((tv[i] - tmax) * 1.4426950408889634f); sum += tv[i]; }
        const float inv = 1.f / sum;
        int* eo = eidx + (size_t)t * 128 + h * 16; float* go = gw + (size_t)t * 128 + h * 16;
#pragma unroll
        for (int i = 0; i < 16; i += 4) { *(int4*)(eo + i) = make_int4(te[i], te[i + 1], te[i + 2], te[i + 3]); *(f32x4*)(go + i) = (f32x4){tv[i] * inv, tv[i + 1] * inv, tv[i + 2] * inv, tv[i + 3] * inv}; }
    }
}
DEVI void phase_gather(const P& p, int l) {
    const int lane = threadIdx.x & 63, wid = threadIdx.x >> 6;
    const bf16_t* h2 = (const bf16_t*)(p.ws + OFF_H); const int* eidx = (const int*)(p.ws + OFF_YA); const float* gw = (const float*)(p.ws + OFF_VN);
    const bf16_t* U = (const bf16_t*)(p.ws + OFF_U) + (size_t)l * 16384 * 1024; const bf16_t* V = (const bf16_t*)(p.ws + OFF_V) + (size_t)l * 16384 * 1024;
    const float* g2 = (const float*)(p.ws + OFF_MOD) + (size_t)l * 2 * 6144 + 5120;
    for (int t = blockIdx.x * 8 + wid; t < T_; t += gridDim.x * 8) {
        float xf[16];
        { const u32x4 a = *(const u32x4*)(h2 + (size_t)t * DM + lane * 8), b = *(const u32x4*)(h2 + (size_t)t * DM + 512 + lane * 8);
#pragma unroll
          for (int j = 0; j < 4; ++j) { xf[2 * j] = bflo(a[j]); xf[2 * j + 1] = bfhi(a[j]); xf[8 + 2 * j] = bflo(b[j]); xf[8 + 2 * j + 1] = bfhi(b[j]); } }
        const int ev0 = eidx[(size_t)t * 128 + lane], ev1 = eidx[(size_t)t * 128 + 64 + lane]; const float gv0 = gw[(size_t)t * 128 + lane], gv1 = gw[(size_t)t * 128 + 64 + lane];
        float acc[16];
#pragma unroll
        for (int i = 0; i < 16; ++i) acc[i] = 0.f;
#pragma unroll 1
        for (int jb = 0; jb < 128; jb += 4) {
            u32x4 ua[4], ub[4], va[4], vb[4]; float gg[4];
#pragma unroll
            for (int q = 0; q < 4; ++q) { const int j = jb + q; const int e = (j < 64) ? __shfl(ev0, j) : __shfl(ev1, j - 64); gg[q] = (j < 64) ? __shfl(gv0, j) : __shfl(gv1, j - 64);
                const bf16_t* ur = U + (size_t)e * 1024 + lane * 8; const bf16_t* vr = V + (size_t)e * 1024 + lane * 8;
                ua[q] = *(const u32x4*)ur; ub[q] = *(const u32x4*)(ur + 512); va[q] = *(const u32x4*)vr; vb[q] = *(const u32x4*)(vr + 512); }
#pragma unroll
            for (int q = 0; q < 4; ++q) { float d = 0.f;
#pragma unroll
                for (int j = 0; j < 4; ++j) { d += bflo(ua[q][j]) * xf[2 * j] + bfhi(ua[q][j]) * xf[2 * j + 1] + bflo(ub[q][j]) * xf[8 + 2 * j] + bfhi(ub[q][j]) * xf[8 + 2 * j + 1]; }
                d = wave_sum(d); const float w = gg[q] * gelu_tanh(d);
#pragma unroll
                for (int j = 0; j < 4; ++j) { acc[2 * j] += w * bflo(va[q][j]); acc[2 * j + 1] += w * bfhi(va[q][j]); acc[8 + 2 * j] += w * bflo(vb[q][j]); acc[8 + 2 * j + 1] += w * bfhi(vb[q][j]); } }
        }
        float* xp = p.xr + (size_t)t * DM; const float* gp = g2 + ((t >= S_) ? 6144 : 0);
#pragma unroll
        for (int hlf = 0; hlf < 2; ++hlf)
#pragma unroll
            for (int q = 0; q < 2; ++q) { const int col = hlf * 512 + lane * 8 + q * 4; f32x4 xv = *(const f32x4*)(xp + col); const f32x4 gv = *(const f32x4*)(gp + col);
                xv[0] += gv[0] * acc[hlf * 8 + q * 4 + 0]; xv[1] += gv[1] * acc[hlf * 8 + q * 4 + 1]; xv[2] += gv[2] * acc[hlf * 8 + q * 4 + 2]; xv[3] += gv[3] * acc[hlf * 8 + q * 4 + 3]; *(f32x4*)(xp + col) = xv; }
    }
}

enum { PH_PRO = 0, PH_NORM1, PH_GIN, PH_POST, PH_MIX_QKV, PH_ATTN, PH_MERGE, PH_WO, PH_NORM2, PH_PQ, PH_SC, PH_TOPK, PH_GATHER, PH_FINAL };
template <int PH> DEVI void run_phase(const P& p, int l, char* lds) {
    const unsigned char* wl = p.ws + OFF_W + (size_t)l * W_LAYER; const float* mod = (const float*)(p.ws + OFF_MOD) + (size_t)l * 2 * 6144;
    if constexpr (PH == PH_PRO) phase_prologue(p, lds);
    if constexpr (PH == PH_NORM1) phase_norm(p, mod + 0, mod + 1024);
    if constexpr (PH == PH_GIN) { EpiZ e{(bf16_t*)(p.ws + OFF_Z)}; gemm_phase(( const bf16_t*)(p.ws + OFF_H), DM, 0, (const bf16_t*)(wl + W_INT), 1024, T_, ZC, 1024, lds, e); }
    if constexpr (PH == PH_POST) phase_post(p);
    if constexpr (PH == PH_MIX_QKV) {
        phase_mixa(p, l, lds);
        { EpiBf e{(bf16_t*)(p.ws + OFF_Q), 768}; gemm_phase((const bf16_t*)(p.ws + OFF_Z) + Z_CQ, ZC, 0, (const bf16_t*)(wl + W_UQ), 384, T_, 768, 384, lds, e); }
        { EpiKV e{(bf16_t*)(p.ws + OFF_K), (bf16_t*)(p.ws + OFF_VV), (const float*)(p.ws + OFF_RS) + T_}; gemm_phase((const bf16_t*)(p.ws + OFF_Z) + Z_CKV, ZC, 0, (const bf16_t*)(wl + W_UKV), 256, T_, 1024, 256, lds, e); }
    }
    if constexpr (PH == PH_ATTN) phase_attn(p, lds);
    if constexpr (PH == PH_MERGE) phase_merge(p, l, lds);
    if constexpr (PH == PH_WO) { EpiWo e{p.xr, mod + 2048}; gemm_phase((const bf16_t*)(p.ws + OFF_H), DM, 0, (const bf16_t*)(wl + W_O), 1024, T_, 1024, 1024, lds, e); }
    if constexpr (PH == PH_NORM2) phase_norm(p, mod + 3072, mod + 4096);
    if constexpr (PH == PH_PQ) { EpiBf e{(bf16_t*)(p.ws + OFF_Q), 2048}; gemm_phase((const bf16_t*)(p.ws + OFF_H), DM, 0, (const bf16_t*)(wl + W_PQ), 1024, T_, 2048, 1024, lds, e); }
    if constexpr (PH == PH_SC) { EpiScT e{(float*)(p.ws + OFF_Z)}; gemm_phase((const bf16_t*)(p.ws + OFF_Q), 2048, 128, (const bf16_t*)(wl + W_SK), 128, T_, 2048, 128, lds, e); }
    if constexpr (PH == PH_TOPK) phase_topk(p);
    if constexpr (PH == PH_GATHER) phase_gather(p, l);
    if constexpr (PH == PH_FINAL) phase_final(p);
}
template <int PH> __global__ void __launch_bounds__(NTHR, 2) k_phase(P p, int l) {
    extern __shared__ __attribute__((aligned(16))) char lds[];
    run_phase<PH>(p, l, lds);
}
template <int PH> static void launch_phase(const P& p, int l, hipStream_t stream) {
    static bool attr = false;
    if (!attr) { (void)hipFuncSetAttribute((const void*)k_phase<PH>, hipFuncAttributeMaxDynamicSharedMemorySize, LDS_BYTES); attr = true; }
    hipLaunchKernelGGL(k_phase<PH>, dim3(256), dim3(NTHR), LDS_BYTES, stream, p, l);
}

extern "C" void kernel_launch(void* const* d_in, const int* in_sizes, int n_in, void* d_out, int out_size, void* d_ws, size_t ws_size, hipStream_t stream) {
    P p{};
    p.x = (const float*)d_in[0]; p.c = (const float*)d_in[1]; p.pos = (const int*)d_in[2];
    p.w_mod = (const float*)d_in[3]; p.b_mod = (const float*)d_in[4]; p.w_in = (const float*)d_in[5]; p.w_s = (const float*)d_in[6]; p.b_s = (const float*)d_in[7];
    p.q_norm = (const float*)d_in[8]; p.w_uq = (const float*)d_in[9]; p.kv_norm = (const float*)d_in[10]; p.w_ukv = (const float*)d_in[11]; p.w_pool = (const float*)d_in[12];
    p.pool_scale = (const float*)d_in[13]; p.w_a = (const float*)d_in[14]; p.w_b = (const float*)d_in[15]; p.w_c = (const float*)d_in[16]; p.w_o = (const float*)d_in[17];
    p.w_pq = (const float*)d_in[18]; p.sub_keys = (const float*)d_in[19]; p.u_tab = (const float*)d_in[20]; p.v_tab = (const float*)d_in[21]; p.final_norm = (const float*)d_in[22];
    p.xr = (float*)d_out; p.ws = (unsigned char*)d_ws;
    for (int i = 0; i < 16; ++i) p.invf[i] = (double)(float)(1.0 / pow(10000.0, (double)(2 * i) / 32.0));
    launch_phase<PH_PRO>(p, 0, stream);
    for (int l = 0; l < NL; ++l) {
        launch_phase<PH_NORM1>(p, l, stream); launch_phase<PH_GIN>(p, l, stream); launch_phase<PH_POST>(p, l, stream); launch_phase<PH_MIX_QKV>(p, l, stream);
        launch_phase<PH_ATTN>(p, l, stream); launch_phase<PH_MERGE>(p, l, stream); launch_phase<PH_WO>(p, l, stream); launch_phase<PH_NORM2>(p, l, stream);
        launch_phase<PH_PQ>(p, l, stream); launch_phase<PH_SC>(p, l, stream); launch_phase<PH_TOPK>(p, l, stream); launch_phase<PH_GATHER>(p, l, stream);
    }
    launch_phase<PH_FINAL>(p, 0, stream);
}
```

```cpp
#include <hip/hip_runtime.h>
#include <stdint.h>
#include <math.h>

#ifndef PROBE_ATTN
#define PROBE_ATTN 0
#endif
#ifndef DUP_MASK
#define DUP_MASK 0
#endif
#ifndef FUSE_PQK
#define FUSE_PQK 1
#endif
#ifndef PEERK_NET
#define PEERK_NET 1
#endif
#ifndef PROBE_UM
#define PROBE_UM 0
#endif
#ifndef GATHER_UMFMA
#define GATHER_UMFMA 1
#endif
#ifndef PQ_FOLD
#define PQ_FOLD 1
#endif
#ifndef XRES_BF16
#define XRES_BF16 1
#endif
#ifndef GATES_FP8
#define GATES_FP8 1
#endif
#ifndef DRY_EMASK
#define DRY_EMASK 0x3fff
#endif
#ifndef EPI_PERM
#define EPI_PERM 1
#endif
#define DEVI __device__ __forceinline__
typedef unsigned short bf16_t;
typedef short bf16x8 __attribute__((ext_vector_type(8)));
typedef short s16x4 __attribute__((ext_vector_type(4)));
typedef float f32x4 __attribute__((ext_vector_type(4)));
typedef float f32x2 __attribute__((ext_vector_type(2)));
typedef float f32x16 __attribute__((ext_vector_type(16)));
typedef unsigned u32x4 __attribute__((ext_vector_type(4)));
typedef unsigned u32x2 __attribute__((ext_vector_type(2)));
typedef __bf16 bf16x2_t __attribute__((ext_vector_type(2)));
typedef float f32x32 __attribute__((ext_vector_type(32)));
typedef unsigned u32x6 __attribute__((ext_vector_type(6)));
#define LAS __attribute__((address_space(3)))

constexpr int T_ = 32768, S_ = 16384, DM = 1024, NL = 4;
constexpr int ZC = 4608;
constexpr int Z_U = 0, Z_V = 256, Z_CQ = 512, Z_CKV = 896, Z_P = 1152, Z_KR = 1408, Z_G = 1536;
constexpr int NTHR = 512;
constexpr int LDS_BYTES = 147456;
constexpr float C2F = 0.14724445f;

constexpr size_t al256(size_t x) { return (x + 255) & ~(size_t)255; }
constexpr size_t OFF_CTL = 0;
constexpr size_t OFF_MOD = 16384;
constexpr size_t OFF_ROPE = OFF_MOD + al256((size_t)NL * 2 * 6144 * 4);
constexpr size_t OFF_W = OFF_ROPE + al256((size_t)T_ * 32 * 4);
constexpr size_t W_INT = 0;
constexpr size_t W_UQ = W_INT + (size_t)ZC * 1024 * 2;
constexpr size_t W_UKV = W_UQ + (size_t)768 * 384 * 2;
constexpr size_t W_A = W_UKV + (size_t)1024 * 256 * 2;
constexpr size_t W_B = W_A + (size_t)1024 * 256 * 2;
constexpr size_t W_C = W_B + (size_t)1024 * 512 * 2;
constexpr size_t W_O = W_C + (size_t)1024 * 256 * 2;
constexpr size_t W_PQ = W_O + (size_t)1024 * 1024 * 2;
constexpr size_t W_SK = W_PQ + (size_t)2048 * 1024 * 2;
constexpr size_t W_S = W_SK + (size_t)16 * 128 * 128 * 2;
constexpr size_t W_G8 = W_S + (size_t)4 * 128 * 128 * 2;
constexpr size_t W_LAYER = W_G8 + (size_t)3072 * 1024;
#ifndef TAB_FMT
#define TAB_FMT 45
#endif
#define TAB_FP4 (TAB_FMT == 4)
constexpr int ROWB = (TAB_FMT == 4 || TAB_FMT == 45) ? 512 : TAB_FMT == 5 ? 576 : (TAB_FMT == 6 || TAB_FMT == 65) ? 768 : 1024;
constexpr int ROWB_V = TAB_FMT == 65 ? 576 : ROWB;
#define CHUNK_COL(l32, m4) ((TAB_FMT == 5 || TAB_FMT == 45) ? ((m4) * 128 + 4 * (l32)) : ((l32) * 32 + 4 * (m4)))
constexpr size_t OFF_U = OFF_W + NL * W_LAYER;
constexpr size_t OFF_V = OFF_U + (size_t)NL * 16384 * ROWB;
constexpr size_t OFF_SU = OFF_V + (size_t)NL * 16384 * ROWB;
constexpr size_t OFF_SV = OFF_SU + (size_t)NL * 16384 * 4;
constexpr size_t OFF_H = OFF_SV + (size_t)NL * 16384 * 4;
constexpr size_t OFF_Z = OFF_H + (size_t)T_ * 1024 * 2;
constexpr size_t OFF_VN = OFF_Z + (size_t)T_ * ZC * 2;
constexpr size_t OFF_PRE = OFF_VN + (size_t)T_ * 256 * 2;
constexpr size_t OFF_YA = OFF_PRE + (size_t)T_ * 256 * 2;
constexpr size_t OFF_YB = OFF_YA + (size_t)T_ * 256 * 2;
constexpr size_t OFF_CAT = OFF_PRE;
constexpr int CAT_YA = 0, CAT_YB = 256, CAT_PRE = 768;
constexpr size_t OFF_EIDX = OFF_YA;
constexpr size_t OFF_RS = OFF_YB + (size_t)T_ * 512 * 2;
constexpr size_t OFF_Q = OFF_RS + (size_t)T_ * 2 * 4;
constexpr size_t OFF_K = OFF_Q + (size_t)T_ * 768 * 2;
constexpr size_t OFF_VV = OFF_K + (size_t)T_ * 768 * 2;
constexpr size_t OFF_H8 = OFF_VV + (size_t)T_ * 512 * 2;
constexpr size_t OFF_XB = OFF_H8 + (size_t)T_ * 1024;
constexpr size_t OFF_H4P = OFF_XB + (size_t)T_ * 1024 * 2;
constexpr size_t OFF_HSC = OFF_H4P + (size_t)2 * T_ * 512;
constexpr size_t OFF_END = OFF_HSC + (size_t)T_ * 4;
static_assert(OFF_END <= ((size_t)1 << 30), "workspace map exceeds 1 GiB");

struct P {
    const float *x, *c; const int* pos;
    const float *w_mod, *b_mod, *w_in, *w_s, *b_s, *q_norm, *w_uq, *kv_norm, *w_ukv, *w_pool, *pool_scale, *w_a, *w_b, *w_c, *w_o, *w_pq, *sub_keys, *u_tab, *v_tab, *final_norm;
    float* xr;
    unsigned char* ws;
    double invf[16];
};

DEVI unsigned cvtpk(float lo, float hi) { f32x2 v = {lo, hi}; bf16x2_t b = __builtin_convertvector(v, bf16x2_t); return __builtin_bit_cast(unsigned, b); }
DEVI bf16_t f2bf(float f) { return (bf16_t)(cvtpk(f, 0.f) & 0xffffu); }
DEVI float bf2f(bf16_t b) { return __uint_as_float(((unsigned)b) << 16); }
DEVI float bflo(unsigned w) { return __uint_as_float(w << 16); }
DEVI float bfhi(unsigned w) { return __uint_as_float(w & 0xffff0000u); }
DEVI unsigned pk4_fp8(f32x4 v) { int pk = 0; pk = __builtin_amdgcn_cvt_pk_fp8_f32(v[0], v[1], pk, false); pk = __builtin_amdgcn_cvt_pk_fp8_f32(v[2], v[3], pk, true); return (unsigned)pk; }
DEVI float fexp2(float x) { return __builtin_amdgcn_exp2f(x); }
DEVI float frcp(float x) { return __builtin_amdgcn_rcpf(x); }
DEVI float sigmoidf_(float x) { return frcp(1.f + fexp2(-1.4426950408889634f * x)); }
DEVI float gelu_tanh(float x) { const float u = 0.7978845608028654f * (x + 0.044715f * x * x * x); return x * frcp(1.f + fexp2(-2.8853900817779268f * u)); }
#define DPPF(v, ctrl) __int_as_float(__builtin_amdgcn_update_dpp(0, __float_as_int(v), (ctrl), 0xf, 0xf, true))
#define DPP_QX1 0xB1
#define DPP_QX2 0x4E
#define DPP_HMIR 0x141
#define DPP_MIR 0x140
#define DPP_ROR8 0x128
DEVI float swap16_sum(float a, float b) { auto r = __builtin_amdgcn_permlane16_swap(__float_as_uint(a), __float_as_uint(b), false, false); return __uint_as_float(r[0]) + __uint_as_float(r[1]); }
DEVI float swap32_sum(float a, float b) { auto r = __builtin_amdgcn_permlane32_swap(__float_as_uint(a), __float_as_uint(b), false, false); return __uint_as_float(r[0]) + __uint_as_float(r[1]); }
DEVI float wave_sum(float v) {
    v += DPPF(v, DPP_QX1); v += DPPF(v, DPP_QX2); v += DPPF(v, DPP_HMIR); v += DPPF(v, DPP_MIR);
    v = swap16_sum(v, v); return swap32_sum(v, v);
}
DEVI int xchg32(int v, bool hi) { auto r = __builtin_amdgcn_permlane32_swap((unsigned)v, (unsigned)v, false, false); return (int)(hi ? r[0] : r[1]); }
DEVI int tid_() { int t = threadIdx.x; asm volatile("" : "+v"(t)); return t; }
DEVI unsigned long long opaque_u64(unsigned long long v) { unsigned lo = (unsigned)v, hi = (unsigned)(v >> 32); asm volatile("" : "+v"(lo), "+v"(hi));
    lo = __builtin_amdgcn_readfirstlane(lo); hi = __builtin_amdgcn_readfirstlane(hi); return ((unsigned long long)hi << 32) | lo; }
DEVI int opaque_i32(int v) { asm volatile("" : "+v"(v)); return __builtin_amdgcn_readfirstlane(v); }
DEVI unsigned long long ctx_u64(int slot) { extern __shared__ __attribute__((aligned(16))) char lds_ctx_[]; volatile LAS unsigned* q = (volatile LAS unsigned*)(lds_ctx_ + LDS_BYTES - 48 + slot * 8);
    const unsigned lo = q[0], hi = q[1]; return ((unsigned long long)(unsigned)__builtin_amdgcn_readfirstlane((int)hi) << 32) | (unsigned)__builtin_amdgcn_readfirstlane((int)lo); }
DEVI void ctx_init(const P& p, char* lds) { if (threadIdx.x == 0) { *(unsigned long long*)(lds + LDS_BYTES - 48) = (unsigned long long)p.ws; *(unsigned long long*)(lds + LDS_BYTES - 40) = (unsigned long long)p.xr; } }
typedef __attribute__((address_space(1))) unsigned char* g_u8p;
DEVI unsigned char* WS(const P&) { return (unsigned char*)(g_u8p)ctx_u64(0); }
DEVI float* XR(const P&) { return (float*)(g_u8p)ctx_u64(1); }
#define MFMA16(a, b, c) __builtin_amdgcn_mfma_f32_16x16x32_bf16(a, b, c, 0, 0, 0)
#define MFMA32(a, b, c) __builtin_amdgcn_mfma_f32_32x32x16_bf16(a, b, c, 0, 0, 0)

constexpr int GP = 64;
DEVI void gemm_kloop(f32x4 (&acc)[4][4], const bf16_t* __restrict__ Ap, int lda, const bf16_t* __restrict__ Bp, int ldb, int K, char* lds) {
    const int tid = tid_(), lane = tid & 63, wid = tid >> 6, wm = wid >> 1, wn = wid & 1, fr = lane & 15, fq = lane >> 4;
    bf16_t* const As0 = (bf16_t*)lds; bf16_t* const Bs0 = As0 + 256 * GP; bf16_t* const As1 = Bs0 + 128 * GP; bf16_t* const Bs1 = As1 + 256 * GP;
    const int nt = K >> 6;
    const int sr = tid >> 3, sc = (tid & 7) * 8, scw = ((tid & 7) ^ (sr & 7)) * 8;
    const bf16_t* ag = Ap + (size_t)sr * lda + sc; const bf16_t* bg = Bp + (size_t)sr * ldb + sc;
    const int fx = fr & 7;
    u32x4 ra[4], rb[2];
#define G_LOAD(kt) do { _Pragma("unroll") for (int i_ = 0; i_ < 4; ++i_) ra[i_] = *(const u32x4*)(ag + (size_t)(i_ * 64) * lda + (kt) * 64); \
                        _Pragma("unroll") for (int i_ = 0; i_ < 2; ++i_) rb[i_] = *(const u32x4*)(bg + (size_t)(i_ * 64) * ldb + (kt) * 64); } while (0)
#define G_WRITE(As, Bs) do { _Pragma("unroll") for (int i_ = 0; i_ < 4; ++i_) *(u32x4*)((As) + (sr + i_ * 64) * GP + scw) = ra[i_]; \
                             _Pragma("unroll") for (int i_ = 0; i_ < 2; ++i_) *(u32x4*)((Bs) + (sr + i_ * 64) * GP + scw) = rb[i_]; } while (0)
    __syncthreads();
    G_LOAD(0); G_WRITE(As0, Bs0);
    __syncthreads();
    for (int kt = 0; kt < nt; ++kt) {
        const bf16_t* As = (kt & 1) ? As1 : As0; const bf16_t* Bs = (kt & 1) ? Bs1 : Bs0;
        if (kt + 1 < nt) G_LOAD(kt + 1);
#pragma unroll
        for (int kk = 0; kk < 2; ++kk) {
            bf16x8 af[4], bfr[4]; const int ch = ((kk * 4 + fq) ^ fx) * 8;
#pragma unroll
            for (int m = 0; m < 4; ++m) af[m] = *(const bf16x8*)(As + (wm * 64 + m * 16 + fr) * GP + ch);
#pragma unroll
            for (int n = 0; n < 4; ++n) bfr[n] = *(const bf16x8*)(Bs + (wn * 64 + n * 16 + fr) * GP + ch);
#pragma unroll
            for (int m = 0; m < 4; ++m)
#pragma unroll
                for (int n = 0; n < 4; ++n) acc[m][n] = MFMA16(bfr[n], af[m], acc[m][n]);
        }
        if (kt + 1 < nt) { if (kt & 1) G_WRITE(As0, Bs0); else G_WRITE(As1, Bs1); }
        __syncthreads();
    }
#undef G_LOAD
#undef G_WRITE
}
DEVI void acc_zero(f32x4 (&acc)[4][4]) {
#pragma unroll
    for (int m = 0; m < 4; ++m)
#pragma unroll
        for (int n = 0; n < 4; ++n) acc[m][n] = (f32x4){0.f, 0.f, 0.f, 0.f};
}
template <class Epi>
DEVI void gemm_phase(const bf16_t* A, int lda, int a_pn_stride, const bf16_t* Bt, int ldb, int M, int N, int K, char* lds, const Epi& epi) {
    const int nn = N >> 7, nu = (M >> 8) * nn;
    const int lane = tid_() & 63, wid = tid_() >> 6, wm = wid >> 1, wn = wid & 1, fr = lane & 15, fq = lane >> 4;
    for (int u = blockIdx.x; u < nu; u += gridDim.x) {
        const int pm = u / nn, pn = u - pm * nn;
        f32x4 acc[4][4]; acc_zero(acc);
        gemm_kloop(acc, A + (size_t)pm * 256 * lda + (size_t)pn * a_pn_stride, lda, Bt + (size_t)pn * 128 * ldb, ldb, K, lds);
#pragma unroll
        for (int m = 0; m < 4; ++m)
#pragma unroll
            for (int n = 0; n < 4; ++n) epi(pm * 256 + wm * 64 + m * 16 + fr, pn * 128 + wn * 64 + n * 16 + 4 * fq, acc[m][n]);
    }
}
DEVI void st_bf4(bf16_t* p, f32x4 v) { u32x2 w; w.x = cvtpk(v[0], v[1]); w.y = cvtpk(v[2], v[3]); *(u32x2*)p = w; }
DEVI f32x4 ld_bf4(const bf16_t* p) { const u32x2 w = *(const u32x2*)p; return (f32x4){bflo(w.x), bfhi(w.x), bflo(w.y), bfhi(w.y)}; }
DEVI void st_bf8(bf16_t* p, f32x4 a, f32x4 b) { u32x4 w; w.x = cvtpk(a[0], a[1]); w.y = cvtpk(a[2], a[3]); w.z = cvtpk(b[0], b[1]); w.w = cvtpk(b[2], b[3]); *(u32x4*)p = w; }

struct EpiZ { bf16_t* z;
    DEVI void operator()(int row, int col, f32x4 v) const {
        if (col < Z_CQ) { v[0] = gelu_tanh(v[0]); v[1] = gelu_tanh(v[1]); v[2] = gelu_tanh(v[2]); v[3] = gelu_tanh(v[3]); }
        else if (col >= Z_G) { v[0] = sigmoidf_(v[0]); v[1] = sigmoidf_(v[1]); v[2] = sigmoidf_(v[2]); v[3] = sigmoidf_(v[3]); }
        st_bf4(z + (size_t)row * ZC + col, v); }
    DEVI void v8(int row, int col, f32x4 a, f32x4 b) const {
#pragma unroll
        for (int i = 0; i < 4; ++i) { if (col < Z_CQ) { a[i] = gelu_tanh(a[i]); b[i] = gelu_tanh(b[i]); } else if (col >= Z_G) { a[i] = sigmoidf_(a[i]); b[i] = sigmoidf_(b[i]); } }
        st_bf8(z + (size_t)row * ZC + col, a, b); } };
struct EpiZG { bf16_t* z;
    DEVI void operator()(int row, int col, f32x4 v) const {
#pragma unroll
        for (int i = 0; i < 4; ++i) v[i] = frcp(1.f + fexp2(-0.022542110013889f * v[i]));
        st_bf4(z + (size_t)row * ZC + Z_G + col, v); }
    DEVI void v8(int row, int col, f32x4 a, f32x4 b) const {
#pragma unroll
        for (int i = 0; i < 4; ++i) { a[i] = frcp(1.f + fexp2(-0.022542110013889f * a[i])); b[i] = frcp(1.f + fexp2(-0.022542110013889f * b[i])); }
        st_bf8(z + (size_t)row * ZC + Z_G + col, a, b); } };
struct EpiBf { bf16_t* o; int ldo;
    DEVI void operator()(int row, int col, f32x4 v) const { st_bf4(o + (size_t)row * ldo + col, v); }
    DEVI void v8(int row, int col, f32x4 a, f32x4 b) const { st_bf8(o + (size_t)row * ldo + col, a, b); } };
struct EpiKV { bf16_t* k; bf16_t* v_; const float* rs;
    DEVI void operator()(int row, int col, f32x4 v) const {
        const float s = rs[row]; v = v * s; const int h = col >> 7, c = col & 127;
        if (c < 64) st_bf4(k + (size_t)row * 768 + h * 96 + c, v); else st_bf4(v_ + (size_t)row * 512 + h * 64 + (c - 64), v); }
    DEVI void v8(int row, int col, f32x4 a, f32x4 b) const {
        const float s = rs[row]; a = a * s; b = b * s; const int h = col >> 7, c = col & 127;
        if (c < 64) st_bf8(k + (size_t)row * 768 + h * 96 + c, a, b); else st_bf8(v_ + (size_t)row * 512 + h * 64 + (c - 64), a, b); } };
struct EpiWo { const float* xin; float* x; const float* g;
    DEVI void operator()(int row, int col, f32x4 v) const {
        const float* gp = g + (row >= S_ ? 6144 : 0) + col; float* xp = x + (size_t)row * DM + col;
        f32x4 xv = *(const f32x4*)(xin + (size_t)row * DM + col); const f32x4 gv = *(const f32x4*)gp; xv = xv + gv * v; *(f32x4*)xp = xv; }
    DEVI void v8(int row, int col, f32x4 a, f32x4 b) const {
        const float* gp = g + (row >= S_ ? 6144 : 0) + col; float* xp = x + (size_t)row * DM + col; const float* xi = xin + (size_t)row * DM + col;
        f32x4 x0 = *(const f32x4*)xi, x1 = *(const f32x4*)(xi + 4); const f32x4 g0 = *(const f32x4*)gp, g1 = *(const f32x4*)(gp + 4);
        x0 = x0 + g0 * a; x1 = x1 + g1 * b; *(f32x4*)xp = x0; *(f32x4*)(xp + 4) = x1; } };
struct EpiWoB { const float* xin32; const bf16_t* xinb; bf16_t* xo; const float* g;
    DEVI void operator()(int row, int col, f32x4 v) const {
        const float* gp = g + (row >= S_ ? 6144 : 0) + col; const f32x4 gv = *(const f32x4*)gp;
        f32x4 xv = xin32 ? *(const f32x4*)(xin32 + (size_t)row * DM + col) : ld_bf4(xinb + (size_t)row * DM + col); st_bf4(xo + (size_t)row * DM + col, xv + gv * v); }
    DEVI void v8(int row, int col, f32x4 a, f32x4 b) const {
        const float* gp = g + (row >= S_ ? 6144 : 0) + col; const f32x4 g0 = *(const f32x4*)gp, g1 = *(const f32x4*)(gp + 4); f32x4 x0, x1;
        if (xin32) { const float* xi = xin32 + (size_t)row * DM + col; x0 = *(const f32x4*)xi; x1 = *(const f32x4*)(xi + 4); }
        else { const u32x4 w = *(const u32x4*)(xinb + (size_t)row * DM + col); x0 = (f32x4){bflo(w.x), bfhi(w.x), bflo(w.y), bfhi(w.y)}; x1 = (f32x4){bflo(w.z), bfhi(w.z), bflo(w.w), bfhi(w.w)}; }
        st_bf8(xo + (size_t)row * DM + col, x0 + g0 * a, x1 + g1 * b); } };
struct EpiMergeLast { bf16_t* mg; const bf16_t* gate;
    DEVI void operator()(int row, int col, f32x4 v) const { const f32x4 g = ld_bf4(gate + (size_t)row * ZC + col); st_bf4(mg + (size_t)row * DM + col, g * v); }
    DEVI void v8(int row, int col, f32x4 a, f32x4 b) const { const u32x4 w = *(const u32x4*)(gate + (size_t)row * ZC + col);
        const f32x4 g0 = (f32x4){bflo(w.x), bfhi(w.x), bflo(w.y), bfhi(w.y)}, g1 = (f32x4){bflo(w.z), bfhi(w.z), bflo(w.w), bfhi(w.w)}; st_bf8(mg + (size_t)row * DM + col, g0 * a, g1 * b); } };
struct EpiScT { float* s;
    DEVI void operator()(int row, int col, f32x4 v) const {
#pragma unroll
        for (int i = 0; i < 4; ++i) s[(size_t)(col + i) * T_ + row] = v[i]; } };

namespace pg8 {
#define PG8_LAS __attribute__((address_space(3)))
constexpr int BM = 256, BK = 64, HALF = 128, HTB = HALF * BK * 2  , STAGE_BYTES = 8 * HTB, NXCD = 8, WGM = 8;

__host__ __device__ __forceinline__ int lds_byte(int r, int c) { const int st = (r >> 4) * 2 + (c >> 5), rr = r & 15, cc = c & 31, ob = rr * 64 + cc * 2; return st * 1024 + (ob ^ (((ob >> 9) & 1) << 5)); }
__host__ __device__ __forceinline__ void stage_rc(int b, int& R, int& C) { const int st = b / 1024, sb = b % 1024, swz = sb ^ (((sb >> 9) & 1) << 5); R = (st >> 1) * 16 + swz / 64; C = (st & 1) * 32 + (swz % 64) / 2; }
__host__ __device__ __forceinline__ int perm32(int rho) { const int n = rho >> 4, i = rho & 15; return 8 * (i >> 2) + 4 * n + (i & 3); }
struct Unit { int pm, pn; };
struct Gemm { const bf16_t* A; const bf16_t* Bt; int M, N, K, lda, ldb; };
struct StaticOrder {
    int nM, nN, nwg, G, c;
    __host__ __device__ void init(int M, int N, int G_, int c_) { nM = M / BM; nN = N / BM; nwg = nM * nN; G = G_; c = c_; }
    __host__ __device__ bool next(int i, Unit& u) const {
        const long L = (long)i * G + c; if (L >= nwg) return false;
        int wgid = (int)L; { const int q = nwg / NXCD, r = nwg % NXCD, xcd = wgid % NXCD, off = wgid / NXCD; wgid = (xcd < r ? xcd * (q + 1) : r * (q + 1) + (xcd - r) * q) + off; }
        const int nig = WGM * nN, gid = wgid / nig, fm = gid * WGM, gsz = (nM - fm) < WGM ? (nM - fm) : WGM;
        u.pm = fm + ((wgid % nig) % gsz); u.pn = (wgid % nig) / gsz; return true;
    }
    __device__ __forceinline__ void a_ready(const Unit&) const {}
    __device__ __forceinline__ void done(const Unit&) const {}
};
struct PairOrder { int v;
    __host__ __device__ static void item(int v, int i, int& h, int& j) { const int idx = (v >> 3) * 2 + i; h = idx & 7; j = (v & 7) + 8 * (idx >> 3); }
    __host__ __device__ bool next(int i, Unit& u) const { if (i >= 4) return false; int h, j; item(v, i >> 1, h, j); u.pm = 2 * j + (i & 1); u.pn = h; return true; }
    __device__ __forceinline__ void a_ready(const Unit&) const {}
    __device__ __forceinline__ void done(const Unit&) const {}
};
template <class F> struct EpiAd { static constexpr bool PERM = (EPI_PERM != 0), AFTER_DRAIN = false; F f;
    __device__ __forceinline__ void operator()(const f32x4 (&acc)[2][2][4][2], const Unit& u, int wr, int wc, int fr, int fq) const {
#pragma unroll
        for (int ai = 0; ai < 2; ++ai)
#pragma unroll
            for (int m = 0; m < 4; ++m)
#pragma unroll
                for (int bj = 0; bj < 2; ++bj) {
                    if constexpr (PERM) f.v8(u.pm * BM + ai * HALF + wr * 64 + m * 16 + fr, u.pn * BM + bj * HALF + wc * 32 + 8 * fq, acc[ai][bj][m][0], acc[ai][bj][m][1]);
                    else {
#pragma unroll
                        for (int n = 0; n < 2; ++n) f(u.pm * BM + ai * HALF + wr * 64 + m * 16 + fr, u.pn * BM + bj * HALF + wc * 32 + n * 16 + 4 * fq, acc[ai][bj][m][n]); }
                }
    } };
struct NoSeg { static constexpr bool ON = false; };
struct GateSeg { static constexpr bool ON = true; const bf16_t* gate; int ldg, gstride, t0, t1;
#if EPI_PERM
    __device__ __forceinline__ void rescale(f32x4 (&acc)[2][2][4][2], const Unit& u, int s, int wr, int wc, int fr, int fq) const {
        const bf16_t* g0 = gate + (size_t)(u.pm * BM + wr * 64 + fr) * ldg + (size_t)s * gstride + u.pn * BM + wc * 32 + 8 * fq;
        u32x4 ga[2][2][2], gb[2][2][2];
#define PG8_GLOAD(bf, ai, mh) do { _Pragma("unroll") for (int mm = 0; mm < 2; ++mm) _Pragma("unroll") for (int bj = 0; bj < 2; ++bj) { \
            const bf16_t* gp = g0 + (size_t)((ai) * HALF + (2 * (mh) + mm) * 16) * ldg + bj * HALF; ga[bf][mm][bj] = *(const u32x4*)gp; gb[bf][mm][bj] = *(const u32x4*)(gp + gstride); } } while (0)
#define PG8_GR(x, y) ((x) * __builtin_amdgcn_rcpf(__builtin_fmaxf((y), 1e-20f)))
#define PG8_GMUL(bf, ai, mh) do { _Pragma("unroll") for (int mm = 0; mm < 2; ++mm) _Pragma("unroll") for (int bj = 0; bj < 2; ++bj) { \
            const u32x4 a_ = ga[bf][mm][bj], b_ = gb[bf][mm][bj]; f32x4& c0 = acc[ai][bj][2 * (mh) + mm][0]; f32x4& c1 = acc[ai][bj][2 * (mh) + mm][1]; \
            c0[0] *= PG8_GR(bflo(a_.x), bflo(b_.x)); c0[1] *= PG8_GR(bfhi(a_.x), bfhi(b_.x)); c0[2] *= PG8_GR(bflo(a_.y), bflo(b_.y)); c0[3] *= PG8_GR(bfhi(a_.y), bfhi(b_.y)); \
            c1[0] *= PG8_GR(bflo(a_.z), bflo(b_.z)); c1[1] *= PG8_GR(bfhi(a_.z), bfhi(b_.z)); c1[2] *= PG8_GR(bflo(a_.w), bflo(b_.w)); c1[3] *= PG8_GR(bfhi(a_.w), bfhi(b_.w)); } } while (0)
        PG8_GLOAD(0, 0, 0); __builtin_amdgcn_sched_barrier(0);
        PG8_GLOAD(1, 0, 1); __builtin_amdgcn_sched_barrier(0); PG8_GMUL(0, 0, 0); __builtin_amdgcn_sched_barrier(0);
        PG8_GLOAD(0, 1, 0); __builtin_amdgcn_sched_barrier(0); PG8_GMUL(1, 0, 1); __builtin_amdgcn_sched_barrier(0);
        PG8_GLOAD(1, 1, 1); __builtin_amdgcn_sched_barrier(0); PG8_GMUL(0, 1, 0); __builtin_amdgcn_sched_barrier(0);
        PG8_GMUL(1, 1, 1); __builtin_amdgcn_sched_barrier(0);
#undef PG8_GLOAD
#undef PG8_GR
#undef PG8_GMUL
    }
#else
    __device__ __forceinline__ void rescale(f32x4 (&acc)[2][2][4][2], const Unit& u, int s, int wr, int wc, int fr, int fq) const {
        const bf16_t* g0 = gate + (size_t)(u.pm * BM + wr * 64 + fr) * ldg + (size_t)s * gstride + u.pn * BM + wc * 32 + 4 * fq;
#pragma unroll
        for (int ai = 0; ai < 2; ++ai)
#pragma unroll
            for (int mh = 0; mh < 2; ++mh) {
                u32x2 ga[2][4], gb[2][4];
#pragma unroll
                for (int mm = 0; mm < 2; ++mm)
#pragma unroll
                    for (int q = 0; q < 4; ++q) { const bf16_t* gp = g0 + (size_t)(ai * HALF + (2 * mh + mm) * 16) * ldg + (q >> 1) * HALF + (q & 1) * 16;
                        ga[mm][q] = *(const u32x2*)gp; gb[mm][q] = *(const u32x2*)(gp + gstride); }
                __builtin_amdgcn_sched_barrier(0);
#pragma unroll
                for (int mm = 0; mm < 2; ++mm)
#pragma unroll
                    for (int q = 0; q < 4; ++q) { f32x4& a = acc[ai][q >> 1][2 * mh + mm][q & 1];
                        a[0] *= bflo(ga[mm][q].x) * __builtin_amdgcn_rcpf(__builtin_fmaxf(bflo(gb[mm][q].x), 1e-20f)); a[1] *= bfhi(ga[mm][q].x) * __builtin_amdgcn_rcpf(__builtin_fmaxf(bfhi(gb[mm][q].x), 1e-20f));
                        a[2] *= bflo(ga[mm][q].y) * __builtin_amdgcn_rcpf(__builtin_fmaxf(bflo(gb[mm][q].y), 1e-20f)); a[3] *= bfhi(ga[mm][q].y) * __builtin_amdgcn_rcpf(__builtin_fmaxf(bfhi(gb[mm][q].y), 1e-20f)); }
                __builtin_amdgcn_sched_barrier(0);
            }
    }
#endif
};
template <class Epi, class Sched, bool ALIGN_EPI = false, bool SP2 = false, class Seg = NoSeg, bool F8 = false>
__device__ __forceinline__ void gemm_phase(PG8_LAS unsigned char* lds, const Gemm g, const Sched& S, const Epi& E, const Seg& SG = Seg()) {
    const int tid = tid_(), wid = __builtin_amdgcn_readfirstlane(tid >> 6), lane = tid & 63, wr = wid >> 2, wc = wid & 3, fr = lane & 15, fq = lane >> 4;
    const int K = g.K, nt = K / BK, lda = g.lda, ldb = g.ldb;
    unsigned voffA[2], voffB[2];
#pragma unroll
    for (int i = 0; i < 2; ++i) { int R, C; stage_rc(tid * 16 + i * 8192, R, C); const int Rb = Epi::PERM ? ((R & ~31) + perm32(R & 31)) : R;
        voffA[i] = (unsigned)(R * lda + C) * 2u; voffB[i] = (unsigned)(Rb * ldb + C) * 2u; }
    const size_t kstep = (size_t)(BK * 2);
    const size_t hstepA = (size_t)HALF * lda * 2, hstepB = (size_t)HALF * ldb * 2;
    const size_t tstepA = 2 * hstepA, tstepB = 2 * hstepB;
    const unsigned ldsw = (unsigned)wid * 1024u;
    const int aoff = lds_byte(wr * 64 + fr, fq * 8), boff = lds_byte(wc * 32 + fr, fq * 8);
    const int a8o0 = lds_byte(wr * 64 + fr, (fq & 1) * 16) + (fq >> 1) * 1024, a8o1 = lds_byte(wr * 64 + fr, (fq & 1) * 16 + 8) + (fq >> 1) * 1024;
    const int b8o0 = lds_byte(wc * 32 + fr, (fq & 1) * 16) + (fq >> 1) * 1024, b8o1 = lds_byte(wc * 32 + fr, (fq & 1) * 16 + 8) + (fq >> 1) * 1024;
    typedef int i32x8 __attribute__((ext_vector_type(8))); typedef int i32x4 __attribute__((ext_vector_type(4)));
    int sc1_ = 127; asm volatile("" : "+v"(sc1_));
#define PG8_SA(b, h) (((b) * 2 + (h)) * HTB)
#define PG8_SB(b, h) ((4 + (b) * 2 + (h)) * HTB)
#define PG8_STAGE(bufoff, gbase, voff) do { _Pragma("unroll") for (int _i = 0; _i < 2; ++_i) \
        __builtin_amdgcn_global_load_lds((const unsigned*)((const char*)(gbase) + (voff)[_i]), (PG8_LAS unsigned*)(lds + (bufoff) + ldsw + _i * 8192), 16, 0, 0); } while (0)
#define PG8_LD8(off) (*(const PG8_LAS i32x4*)(lds + (off)))
#define PG8_LDA(dst, b, h) do { if constexpr (F8) { _Pragma("unroll") for (int m = 0; m < 4; ++m) dst##8[m] = __builtin_shufflevector(PG8_LD8(PG8_SA(b, h) + a8o0 + m * 2048), PG8_LD8(PG8_SA(b, h) + a8o1 + m * 2048), 0, 1, 2, 3, 4, 5, 6, 7); } \
        else { _Pragma("unroll") for (int m = 0; m < 4; ++m) _Pragma("unroll") for (int k = 0; k < 2; ++k) dst[m][k] = *(const PG8_LAS bf16x8*)(lds + PG8_SA(b, h) + aoff + m * 2048 + k * 1024); } } while (0)
#define PG8_LDB(dst, b, h) do { if constexpr (F8) { _Pragma("unroll") for (int n = 0; n < 2; ++n) dst##8[n] = __builtin_shufflevector(PG8_LD8(PG8_SB(b, h) + b8o0 + n * 2048), PG8_LD8(PG8_SB(b, h) + b8o1 + n * 2048), 0, 1, 2, 3, 4, 5, 6, 7); } \
        else { _Pragma("unroll") for (int n = 0; n < 2; ++n) _Pragma("unroll") for (int k = 0; k < 2; ++k) dst[n][k] = *(const PG8_LAS bf16x8*)(lds + PG8_SB(b, h) + boff + n * 2048 + k * 1024); } } while (0)
#define PG8_MMA(ai, bj, At, Bt) do { __builtin_amdgcn_s_setprio(1); \
        if constexpr (F8) { _Pragma("unroll") for (int m = 0; m < 4; ++m) _Pragma("unroll") for (int n = 0; n < 2; ++n) \
            asm volatile("v_mfma_scale_f32_16x16x128_f8f6f4 %0, %1, %2, %0, %3, %3 op_sel_hi:[0,0,0]" : "+v"(acc[ai][bj][m][n]) : "v"(Bt##8[n]), "v"(At##8[m]), "v"(sc1_)); } \
        else { _Pragma("unroll") for (int m = 0; m < 4; ++m) _Pragma("unroll") for (int n = 0; n < 2; ++n) _Pragma("unroll") for (int k = 0; k < 2; ++k) \
            acc[ai][bj][m][n] = __builtin_amdgcn_mfma_f32_16x16x32_bf16(Bt[n][k], At[m][k], acc[ai][bj][m][n], 0, 0, 0); } \
        __builtin_amdgcn_s_setprio(0); } while (0)
#define PG8_WAIT_V(n) asm volatile("s_waitcnt vmcnt(" #n ")" ::: "memory")
#define PG8_WAIT_L(n) asm volatile("s_waitcnt lgkmcnt(" #n ")" ::: "memory")
#define PG8_BAR __builtin_amdgcn_s_barrier()
#define PG8_SCHED __builtin_amdgcn_sched_barrier(0)
    Unit cur, nxt; int ui = 0;
    if (!S.next(0, cur)) return;
    f32x4 acc[2][2][4][2];
#pragma unroll
    for (int a = 0; a < 2; ++a)
#pragma unroll
        for (int b = 0; b < 2; ++b)
#pragma unroll
            for (int m = 0; m < 4; ++m)
#pragma unroll
                for (int n = 0; n < 2; ++n) acc[a][b][m][n] = (f32x4){0.f, 0.f, 0.f, 0.f};
    bf16x8 At[4][2], B0[2][2], B1[2][2];
    i32x8 At8[4], B08[2], B18[2];
    const char* cA = (const char*)g.A + (size_t)cur.pm * tstepA; const char* cB = (const char*)g.Bt + (size_t)cur.pn * tstepB;
    S.a_ready(cur);
    if constexpr (SP2) {
        PG8_STAGE(PG8_SB(0, 0), cB, voffB); PG8_STAGE(PG8_SB(0, 1), cB + hstepB, voffB); PG8_STAGE(PG8_SA(0, 0), cA, voffA); PG8_STAGE(PG8_SA(0, 1), cA + hstepA, voffA);
        if (wr == 1) PG8_BAR;
        PG8_WAIT_V(2); PG8_BAR;
        PG8_STAGE(PG8_SB(1, 0), cB + kstep, voffB); PG8_STAGE(PG8_SA(1, 0), cA + kstep, voffA); PG8_STAGE(PG8_SB(1, 1), cB + hstepB + kstep, voffB);
        PG8_WAIT_V(6); PG8_BAR;
    } else {
        PG8_STAGE(PG8_SB(0, 0), cB, voffB); PG8_STAGE(PG8_SA(0, 0), cA, voffA); PG8_STAGE(PG8_SB(0, 1), cB + hstepB, voffB); PG8_STAGE(PG8_SA(0, 1), cA + hstepA, voffA);
        if (wr == 1) PG8_BAR;
        PG8_WAIT_V(4); PG8_BAR;
        PG8_STAGE(PG8_SB(1, 0), cB + kstep, voffB); PG8_STAGE(PG8_SA(1, 0), cA + kstep, voffA); PG8_STAGE(PG8_SB(1, 1), cB + hstepB + kstep, voffB);
        PG8_WAIT_V(6); PG8_BAR;
    }
    for (;;) {
        const bool has_next = S.next(ui + 1, nxt);
        const char* nA = has_next ? (const char*)g.A + (size_t)nxt.pm * tstepA : cA; const char* nB = has_next ? (const char*)g.Bt + (size_t)nxt.pn * tstepB : cB;
#pragma unroll 1
        for (int t = 0; t < nt; t += 2) {
            if constexpr (Seg::ON) { if (t == SG.t0 || t == SG.t1) SG.rescale(acc, cur, (t == SG.t0) ? 0 : 1, wr, wc, fr, fq); }
            const bool last = (t == nt - 2);
            const char* a1 = cA + (size_t)(t + 1) * kstep;
            const char* a2 = last ? nA : cA + (size_t)(t + 2) * kstep; const char* b2 = last ? nB : cB + (size_t)(t + 2) * kstep;
            const char* a3 = a2 + kstep; const char* b3 = b2 + kstep;
            if (last && has_next) S.a_ready(nxt);
            if constexpr (SP2) {
            PG8_LDB(B0, 0, 0); PG8_LDB(B1, 0, 1); PG8_SCHED; PG8_LDA(At, 0, 0); PG8_STAGE(PG8_SA(1, 1), a1 + hstepA, voffA);
            PG8_WAIT_V(8); PG8_WAIT_L(0); PG8_BAR; PG8_MMA(0, 0, At, B0); PG8_MMA(0, 1, At, B1); PG8_BAR; PG8_SCHED;
            PG8_LDA(At, 0, 1); PG8_STAGE(PG8_SB(0, 0), b2, voffB); PG8_STAGE(PG8_SB(0, 1), b2 + hstepB, voffB); PG8_STAGE(PG8_SA(0, 0), a2, voffA);
            PG8_WAIT_V(8); PG8_WAIT_L(0); PG8_BAR; PG8_MMA(1, 0, At, B0); PG8_MMA(1, 1, At, B1); PG8_BAR; PG8_SCHED;
            PG8_LDB(B0, 1, 0); PG8_LDB(B1, 1, 1); PG8_SCHED; PG8_LDA(At, 1, 0); PG8_STAGE(PG8_SA(0, 1), a2 + hstepA, voffA);
            PG8_WAIT_V(8); PG8_WAIT_L(0); PG8_BAR; PG8_MMA(0, 0, At, B0); PG8_MMA(0, 1, At, B1); PG8_BAR; PG8_SCHED;
            PG8_LDA(At, 1, 1); PG8_STAGE(PG8_SB(1, 0), b3, voffB); PG8_STAGE(PG8_SB(1, 1), b3 + hstepB, voffB); PG8_STAGE(PG8_SA(1, 0), a3, voffA);
            PG8_WAIT_V(8); PG8_WAIT_L(0); PG8_BAR; PG8_MMA(1, 0, At, B0); PG8_MMA(1, 1, At, B1); PG8_BAR; PG8_SCHED;
            } else {
            PG8_LDB(B0, 0, 0); PG8_SCHED; PG8_LDA(At, 0, 0); PG8_STAGE(PG8_SA(1, 1), a1 + hstepA, voffA);
            PG8_WAIT_L(8); PG8_BAR; PG8_WAIT_L(0); PG8_MMA(0, 0, At, B0); PG8_BAR; PG8_SCHED;
            PG8_LDB(B1, 0, 1); PG8_STAGE(PG8_SB(0, 0), b2, voffB);
            PG8_BAR; PG8_WAIT_L(0); PG8_MMA(0, 1, At, B1); PG8_BAR;
            PG8_LDA(At, 0, 1); PG8_STAGE(PG8_SA(0, 0), a2, voffA);
            PG8_BAR; PG8_WAIT_L(0); PG8_MMA(1, 0, At, B0); PG8_BAR; PG8_SCHED;
            PG8_STAGE(PG8_SB(0, 1), b2 + hstepB, voffB);
            PG8_WAIT_V(6); PG8_BAR; PG8_MMA(1, 1, At, B1); PG8_BAR;
            PG8_LDB(B0, 1, 0); PG8_SCHED; PG8_LDA(At, 1, 0); PG8_STAGE(PG8_SA(0, 1), a2 + hstepA, voffA);
            PG8_WAIT_L(8); PG8_BAR; PG8_WAIT_L(0); PG8_MMA(0, 0, At, B0); PG8_BAR; PG8_SCHED;
            PG8_LDB(B1, 1, 1); PG8_STAGE(PG8_SB(1, 0), b3, voffB);
            PG8_BAR; PG8_WAIT_L(0); PG8_MMA(0, 1, At, B1); PG8_BAR;
            PG8_LDA(At, 1, 1); PG8_STAGE(PG8_SA(1, 0), a3, voffA);
            PG8_BAR; PG8_WAIT_L(0); PG8_MMA(1, 0, At, B0); PG8_BAR; PG8_SCHED;
            PG8_STAGE(PG8_SB(1, 1), b3 + hstepB, voffB);
            PG8_WAIT_V(6); PG8_BAR; PG8_MMA(1, 1, At, B1); PG8_BAR;
            }
        }
        if constexpr (ALIGN_EPI) { if (wr == 0) PG8_BAR; }
        if constexpr (F8) asm volatile("s_nop 15\n\ts_nop 15" ::: "memory");
        if constexpr (!Epi::AFTER_DRAIN) { E(acc, cur, wr, wc, fr, fq); S.done(cur); }
        if (!has_next) break;
#pragma unroll
        for (int a = 0; a < 2; ++a)
#pragma unroll
            for (int b = 0; b < 2; ++b)
#pragma unroll
                for (int m = 0; m < 4; ++m)
#pragma unroll
                    for (int n = 0; n < 2; ++n) acc[a][b][m][n] = (f32x4){0.f, 0.f, 0.f, 0.f};
        cur = nxt; cA = nA; cB = nB; ++ui;
        if constexpr (ALIGN_EPI) { if (wr == 1) PG8_BAR; }
    }
    PG8_WAIT_V(0);
    if constexpr (!ALIGN_EPI) { if (wr == 0) PG8_BAR; }
    PG8_BAR;
    if constexpr (Epi::AFTER_DRAIN) { E.fused(acc, cur, wr, wc, fr, fq, lds, wid, lane); S.done(cur); }
#undef PG8_SA
#undef PG8_SB
#undef PG8_STAGE
#undef PG8_LDA
#undef PG8_LDB
#undef PG8_MMA
#undef PG8_LD8
#undef PG8_WAIT_V
#undef PG8_WAIT_L
#undef PG8_BAR
#undef PG8_SCHED
}
}
template <class F> DEVI void gemm256_phase_f8(const unsigned char* A, int lda_bytes, const unsigned char* Bt, int ldb_bytes, int M, int N, int K, char* lds, const F& f) {
    pg8::Gemm g{(const bf16_t*)A, (const bf16_t*)Bt, M, N, opaque_i32(K >> 1), opaque_i32(lda_bytes >> 1), opaque_i32(ldb_bytes >> 1)}; pg8::StaticOrder S; S.init(M, N, (int)gridDim.x, (int)blockIdx.x); pg8::EpiAd<F> E{f};
    __syncthreads();
    pg8::gemm_phase<pg8::EpiAd<F>, pg8::StaticOrder, true, true, pg8::NoSeg, true>((PG8_LAS unsigned char*)lds, g, S, E);
}
template <class F> DEVI void gemm256_phase_seg(const bf16_t* A, int lda, const bf16_t* Bt, int ldb, int M, int N, int K, char* lds, const F& f, const pg8::GateSeg& sg) {
    pg8::Gemm g{A, Bt, M, N, opaque_i32(K), opaque_i32(lda), opaque_i32(ldb)}; pg8::StaticOrder S; S.init(M, N, (int)gridDim.x, (int)blockIdx.x); pg8::EpiAd<F> E{f};
    __syncthreads();
    pg8::gemm_phase<pg8::EpiAd<F>, pg8::StaticOrder, true, true, pg8::GateSeg>((PG8_LAS unsigned char*)lds, g, S, E, sg);
}
template <class F> DEVI void gemm256_pair(const bf16_t* A, int lda, const bf16_t* Bt, int ldb, int M, int N, int K, char* lds, const F& f, int v) {
    pg8::Gemm g{A, Bt, M, N, opaque_i32(K), opaque_i32(lda), opaque_i32(ldb)}; pg8::PairOrder S{v}; pg8::EpiAd<F> E{f};
    __syncthreads();
    pg8::gemm_phase<pg8::EpiAd<F>, pg8::PairOrder, true, true>((PG8_LAS unsigned char*)lds, g, S, E);
}
template <class F> DEVI void gemm256_phase(const bf16_t* A, int lda, const bf16_t* Bt, int ldb, int M, int N, int K, char* lds, const F& f) {
    pg8::Gemm g{A, Bt, M, N, opaque_i32(K), opaque_i32(lda), opaque_i32(ldb)}; pg8::StaticOrder S; S.init(M, N, (int)gridDim.x, (int)blockIdx.x); pg8::EpiAd<F> E{f};
    __syncthreads();
    pg8::gemm_phase<pg8::EpiAd<F>, pg8::StaticOrder, true, true>((PG8_LAS unsigned char*)lds, g, S, E);
}

DEVI void job_transpose(const float* __restrict__ src, int K, int N, bf16_t* __restrict__ dst, int mapmode, const float* __restrict__ kscale, char* lds, int& rot, int ldd = 0) {
    if (ldd == 0) ldd = K;
    float* tile = (float*)lds;
    const int tid = tid_(), nkt = K >> 6, nnt = (N + 127) >> 7, ntile = nkt * nnt;
    const int bfirst = (int)((blockIdx.x + gridDim.x - (unsigned)rot % gridDim.x) % gridDim.x); rot += ntile;
    for (int t = bfirst; t < ntile; t += gridDim.x) {
        const int kt = t / nnt, ntl = t - kt * nnt, k0 = kt * 64, n0 = ntl * 128, ncols = (N - n0 < 128) ? (N - n0) : 128;
        __syncthreads();
#pragma unroll
        for (int i = 0; i < 4; ++i) { const int id = tid + i * NTHR, r = id >> 5, c4 = (id & 31) * 4;
            if (c4 < ncols) { f32x4 v = *(const f32x4*)(src + (size_t)(k0 + r) * N + n0 + c4);
                if (kscale) { const float s = kscale[k0 + r]; v = v * s; }
                tile[r * 129 + c4] = v[0]; tile[r * 129 + c4 + 1] = v[1]; tile[r * 129 + c4 + 2] = v[2]; tile[r * 129 + c4 + 3] = v[3]; } }
        __syncthreads();
#pragma unroll
        for (int i = 0; i < 2; ++i) { const int id = tid + i * NTHR, nl = id >> 3, kc = (id & 7) * 8;
            if (nl < ncols) { int n = n0 + nl;
                if (mapmode == 1) { n = (n < 1152) ? n : (n < 1184) ? n + 256 : (n < 1440) ? n - 32 : n + 96; }
                u32x4 w; w.x = cvtpk(tile[(kc + 0) * 129 + nl], tile[(kc + 1) * 129 + nl]); w.y = cvtpk(tile[(kc + 2) * 129 + nl], tile[(kc + 3) * 129 + nl]);
                w.z = cvtpk(tile[(kc + 4) * 129 + nl], tile[(kc + 5) * 129 + nl]); w.w = cvtpk(tile[(kc + 6) * 129 + nl], tile[(kc + 7) * 129 + nl]);
                *(u32x4*)(dst + (size_t)n * ldd + k0 + kc) = w; } }
    }
}
DEVI void job_transpose8(const float* __restrict__ src, int lds_src, int K, int N, unsigned char* __restrict__ dst, float mul, char* lds, int& rot) {
    float* tile = (float*)lds;
    const int tid = tid_(), nkt = K >> 6, nnt = N >> 7, ntile = nkt * nnt;
    const int bfirst = (int)((blockIdx.x + gridDim.x - (unsigned)rot % gridDim.x) % gridDim.x); rot += ntile;
    for (int t = bfirst; t < ntile; t += gridDim.x) {
        const int kt = t / nnt, ntl = t - kt * nnt, k0 = kt * 64, n0 = ntl * 128;
        __syncthreads();
#pragma unroll
        for (int i = 0; i < 4; ++i) { const int id = tid + i * NTHR, r = id >> 5, c4 = (id & 31) * 4; const f32x4 v = *(const f32x4*)(src + (size_t)(k0 + r) * lds_src + n0 + c4) * mul;
            tile[r * 129 + c4] = v[0]; tile[r * 129 + c4 + 1] = v[1]; tile[r * 129 + c4 + 2] = v[2]; tile[r * 129 + c4 + 3] = v[3]; }
        __syncthreads();
#pragma unroll
        for (int i = 0; i < 2; ++i) { const int id = tid + i * NTHR, nl = id >> 3, kc = (id & 7) * 8; u32x2 w;
            w.x = pk4_fp8((f32x4){tile[(kc + 0) * 129 + nl], tile[(kc + 1) * 129 + nl], tile[(kc + 2) * 129 + nl], tile[(kc + 3) * 129 + nl]});
            w.y = pk4_fp8((f32x4){tile[(kc + 4) * 129 + nl], tile[(kc + 5) * 129 + nl], tile[(kc + 6) * 129 + nl], tile[(kc + 7) * 129 + nl]});
            *(u32x2*)(dst + (size_t)(n0 + nl) * K + k0 + kc) = w; }
    }
}
DEVI void job_convert(const float* __restrict__ src, bf16_t* __restrict__ dst, size_t n4, int tril) {
    const size_t stride = (size_t)gridDim.x * NTHR;
    for (size_t i = (size_t)blockIdx.x * NTHR + tid_(); i < n4; i += stride) {
        f32x4 v = *(const f32x4*)(src + i * 4);
        if (tril) { const int e = (int)((i * 4) & 16383), t = e >> 7, s = e & 127;
#pragma unroll
            for (int j = 0; j < 4; ++j) if (s + j > t) v[j] = 0.f; }
        st_bf4(dst + i * 4, v);
    }
}
DEVI void job_quant_rows(const float* __restrict__ src, unsigned char* __restrict__ dst, float* __restrict__ scale, int nrows) {
    const int lane = tid_() & 63, wid = tid_() >> 6;
    for (int r = blockIdx.x * 8 + wid; r < nrows; r += gridDim.x * 8) {
        const float* sp = src + (size_t)r * 1024 + lane * 16; f32x4 v[4]; float am = 0.f;
#pragma unroll
        for (int i = 0; i < 4; ++i) { v[i] = *(const f32x4*)(sp + i * 4); am = fmaxf(am, fmaxf(fmaxf(fabsf(v[i][0]), fabsf(v[i][1])), fmaxf(fabsf(v[i][2]), fabsf(v[i][3])))); }
#pragma unroll
        for (int o = 32; o > 0; o >>= 1) am = fmaxf(am, __shfl_xor(am, o));
        am = fmaxf(am, 1e-30f);
#if TAB_FP4
        const float q = 6.f / am; u32x2 w;
#pragma unroll
        for (int d = 0; d < 2; ++d) { unsigned pk = 0u;
            pk = __builtin_amdgcn_cvt_scalef32_pk_fp4_f32(pk, v[2 * d][0] * q, v[2 * d][1] * q, 1.0f, 0); pk = __builtin_amdgcn_cvt_scalef32_pk_fp4_f32(pk, v[2 * d][2] * q, v[2 * d][3] * q, 1.0f, 1);
            pk = __builtin_amdgcn_cvt_scalef32_pk_fp4_f32(pk, v[2 * d + 1][0] * q, v[2 * d + 1][1] * q, 1.0f, 2); pk = __builtin_amdgcn_cvt_scalef32_pk_fp4_f32(pk, v[2 * d + 1][2] * q, v[2 * d + 1][3] * q, 1.0f, 3); w[d] = pk; }
        *(u32x2*)(dst + (size_t)r * ROWB + lane * 8) = w;
        if (lane == 0) scale[r] = am * (1.f / 6.f);
#else
        const float q = 256.f / am;
        u32x4 w;
#pragma unroll
        for (int i = 0; i < 4; ++i) { int pk = 0; pk = __builtin_amdgcn_cvt_pk_fp8_f32(v[i][0] * q, v[i][1] * q, pk, false); pk = __builtin_amdgcn_cvt_pk_fp8_f32(v[i][2] * q, v[i][3] * q, pk, true); w[i] = (unsigned)pk; }
        *(u32x4*)(dst + (size_t)r * ROWB + lane * 16) = w;
        if (lane == 0) scale[r] = am * (1.f / 256.f);
#endif
    }
}
#if TAB_FMT == 5 || TAB_FMT == 65
DEVI void job_quant_rows5(const float* __restrict__ src, unsigned char* __restrict__ dst, int nrows) {
    const int lane = tid_() & 63, wid = tid_() >> 6, l32 = lane & 31, hi = lane >> 5;
    for (int r0 = (blockIdx.x * 8 + wid) * 2; r0 < nrows; r0 += gridDim.x * 16) {
        const int r = r0 + hi; const float* sp = src + (size_t)r * 1024; f32x4 v[8]; float am = 0.f;
#pragma unroll
        for (int i = 0; i < 8; ++i) { v[i] = *(const f32x4*)(sp + CHUNK_COL(l32, i)); am = fmaxf(am, fmaxf(fmaxf(fabsf(v[i][0]), fabsf(v[i][1])), fmaxf(fabsf(v[i][2]), fabsf(v[i][3])))); }
        const bf16_t sb = f2bf(fmaxf(am, 1e-30f) * (1.f / 6.f)); const float q = 1.f / bf2f(sb);
        u32x4 w;
#pragma unroll
        for (int d = 0; d < 4; ++d) { unsigned pk = 0u;
            pk = __builtin_amdgcn_cvt_scalef32_pk_fp4_f32(pk, v[2 * d][0] * q, v[2 * d][1] * q, 1.0f, 0); pk = __builtin_amdgcn_cvt_scalef32_pk_fp4_f32(pk, v[2 * d][2] * q, v[2 * d][3] * q, 1.0f, 1);
            pk = __builtin_amdgcn_cvt_scalef32_pk_fp4_f32(pk, v[2 * d + 1][0] * q, v[2 * d + 1][1] * q, 1.0f, 2); pk = __builtin_amdgcn_cvt_scalef32_pk_fp4_f32(pk, v[2 * d + 1][2] * q, v[2 * d + 1][3] * q, 1.0f, 3); w[d] = pk; }
        unsigned char* dp = dst + (size_t)r * ROWB_V; *(u32x4*)(dp + l32 * 16) = w; *(bf16_t*)(dp + 512 + l32 * 2) = sb;
    }
}
#endif
#if TAB_FMT == 45
DEVI void job_quant_rows45(const float* __restrict__ src, unsigned char* __restrict__ dst, float* __restrict__ scale, int nrows) {
    const int lane = tid_() & 63, wid = tid_() >> 6, l32 = lane & 31, hi = lane >> 5;
    for (int r0 = (blockIdx.x * 8 + wid) * 2; r0 < nrows; r0 += gridDim.x * 16) {
        const int r = r0 + hi; const float* sp = src + (size_t)r * 1024; f32x4 v[8]; float am = 0.f;
#pragma unroll
        for (int i = 0; i < 8; ++i) { v[i] = *(const f32x4*)(sp + CHUNK_COL(l32, i)); am = fmaxf(am, fmaxf(fmaxf(fabsf(v[i][0]), fabsf(v[i][1])), fmaxf(fabsf(v[i][2]), fabsf(v[i][3])))); }
        am = fmaxf(am, DPPF(am, DPP_QX1)); am = fmaxf(am, DPPF(am, DPP_QX2)); am = fmaxf(am, DPPF(am, DPP_HMIR)); am = fmaxf(am, DPPF(am, DPP_MIR));
        { auto rr = __builtin_amdgcn_permlane16_swap(__float_as_uint(am), __float_as_uint(am), false, false); am = fmaxf(__uint_as_float(rr[0]), __uint_as_float(rr[1])); }
        am = fmaxf(am, 1e-30f); const float q = 6.f / am; u32x4 w;
#pragma unroll
        for (int d = 0; d < 4; ++d) { unsigned pk = 0u;
            pk = __builtin_amdgcn_cvt_scalef32_pk_fp4_f32(pk, v[2 * d][0] * q, v[2 * d][1] * q, 1.0f, 0); pk = __builtin_amdgcn_cvt_scalef32_pk_fp4_f32(pk, v[2 * d][2] * q, v[2 * d][3] * q, 1.0f, 1);
            pk = __builtin_amdgcn_cvt_scalef32_pk_fp4_f32(pk, v[2 * d + 1][0] * q, v[2 * d + 1][1] * q, 1.0f, 2); pk = __builtin_amdgcn_cvt_scalef32_pk_fp4_f32(pk, v[2 * d + 1][2] * q, v[2 * d + 1][3] * q, 1.0f, 3); w[d] = pk; }
        *(u32x4*)(dst + (size_t)r * ROWB + l32 * 16) = w; if (l32 == 0) scale[r] = am * (1.f / 6.f);
    }
}
#endif
#if TAB_FMT == 6 || TAB_FMT == 65
DEVI float fp6_val(int k) { return k < 16 ? 0.125f * (float)k : k < 24 ? 2.f + 0.25f * (float)(k - 16) : 4.f + 0.5f * (float)(k - 24); }
DEVI int fp6_idx(float w) { return w < 2.f ? (int)(w * 8.f + 0.5f) : w < 4.f ? 16 + (int)((w - 2.f) * 4.f + 0.5f) : 24 + (int)((w - 4.f) * 2.f + 0.5f); }
DEVI void job_quant_rows6(const float* __restrict__ src, unsigned char* __restrict__ dst, float* __restrict__ scale, int nrows, char* lds) {
    const int lane = tid_() & 63, wid = tid_() >> 6, l32 = lane & 31, hi = lane >> 5;
    float* stage = (float*)(lds + wid * 8448) + lane * 32; int* ptab = (int*)(lds + wid * 8448 + 8192);
    int pinv[32];
    { f32x16 ca, cb;
#pragma unroll
      for (int i = 0; i < 16; ++i) { ca[i] = fp6_val(i); cb[i] = fp6_val(16 + i); }
      const u32x6 pk = __builtin_amdgcn_cvt_scalef32_2xpk16_fp6_f32(ca, cb, 1.0f); const f32x32 w = __builtin_amdgcn_cvt_scalef32_pk32_f32_fp6(pk, 1.0f);
#pragma unroll
      for (int k = 0; k < 32; ++k) { const int m = fp6_idx(w[k]) & 31; if (lane == 0) ptab[m] = k; }
      asm volatile("s_waitcnt lgkmcnt(0)" ::: "memory");
#pragma unroll
      for (int m = 0; m < 32; ++m) pinv[m] = ptab[m];
      asm volatile("s_waitcnt lgkmcnt(0)" ::: "memory"); }
    f32x4 vn[8];
    { const int rf = (blockIdx.x * 8 + wid) * 2 + hi; const float* sp = src + (size_t)(rf < nrows ? rf : 0) * 1024 + l32 * 32;
#pragma unroll
      for (int i = 0; i < 8; ++i) vn[i] = *(const f32x4*)(sp + i * 4); }
    for (int r0 = (blockIdx.x * 8 + wid) * 2; r0 < nrows; r0 += gridDim.x * 16) {
        const int r = r0 + hi; f32x4 v[8]; float am = 0.f;
#pragma unroll
        for (int i = 0; i < 8; ++i) v[i] = vn[i];
        { const int rn = r + gridDim.x * 16; const float* sp = src + (size_t)(rn < nrows ? rn : r) * 1024 + l32 * 32;
#pragma unroll
          for (int i = 0; i < 8; ++i) vn[i] = *(const f32x4*)(sp + i * 4); }
#pragma unroll
        for (int i = 0; i < 8; ++i) am = fmaxf(am, fmaxf(fmaxf(fabsf(v[i][0]), fabsf(v[i][1])), fmaxf(fabsf(v[i][2]), fabsf(v[i][3]))));
        am = fmaxf(am, DPPF(am, DPP_QX1)); am = fmaxf(am, DPPF(am, DPP_QX2)); am = fmaxf(am, DPPF(am, DPP_HMIR)); am = fmaxf(am, DPPF(am, DPP_MIR));
        { auto rr = __builtin_amdgcn_permlane16_swap(__float_as_uint(am), __float_as_uint(am), false, false); am = fmaxf(__uint_as_float(rr[0]), __uint_as_float(rr[1])); }
        am = fmaxf(am, 1e-30f); const float q = 7.5f / am;
#pragma unroll
        for (int i = 0; i < 8; ++i) *(f32x4*)(stage + i * 4) = v[i] * q;
        asm volatile("s_waitcnt lgkmcnt(0)" ::: "memory");
        f32x16 a, b;
#pragma unroll
        for (int m = 0; m < 16; ++m) { a[m] = stage[pinv[m]]; b[m] = stage[pinv[16 + m]]; }
        asm volatile("s_waitcnt lgkmcnt(0)" ::: "memory");
        const u32x6 pk = __builtin_amdgcn_cvt_scalef32_2xpk16_fp6_f32(a, b, 1.0f);
        unsigned char* dp = dst + (size_t)r * ROWB + l32 * 24;
        *(u32x2*)(dp) = (u32x2){pk[0], pk[1]}; *(u32x2*)(dp + 8) = (u32x2){pk[2], pk[3]}; *(u32x2*)(dp + 16) = (u32x2){pk[4], pk[5]};
        if (l32 == 0) scale[r] = am * (1.f / 7.5f);
    }
}
#endif
DEVI bf16x8 ld8_f32_bf(const float* p) { const f32x4 a = *(const f32x4*)p, b = *(const f32x4*)(p + 4); u32x4 w; w.x = cvtpk(a[0], a[1]); w.y = cvtpk(a[2], a[3]); w.z = cvtpk(b[0], b[1]); w.w = cvtpk(b[2], b[3]); return __builtin_bit_cast(bf16x8, w); }
DEVI void job_fold_pq(const P& p) {
    const int lane = tid_() & 63, wid = tid_() >> 6, fr = lane & 15, fq = lane >> 4;
    for (int item = blockIdx.x; item < NL * 64; item += gridDim.x) {
        const int l = item >> 6, hh = (item >> 2) & 15, k00 = (item & 3) * 256;
        const float* sk = p.sub_keys + ((size_t)l * 16 + hh) * 128 * 128 + (size_t)(wid * 16 + fr) * 128 + fq * 8;
        const float* wq = p.w_pq + (size_t)l * 1024 * 2048 + hh * 128 + fq * 8;
        bf16_t* out = (bf16_t*)(WS(p) + OFF_W + (size_t)l * W_LAYER + W_PQ) + (size_t)(hh * 128 + wid * 16 + fr) * 1024;
        bf16x8 kf_[4];
#pragma unroll
        for (int ks = 0; ks < 4; ++ks) kf_[ks] = ld8_f32_bf(sk + ks * 32);
#pragma unroll 2
        for (int kt = 0; kt < 16; ++kt) { const int k0 = k00 + kt * 16; f32x4 acc = (f32x4){0.f, 0.f, 0.f, 0.f};
#pragma unroll
            for (int ks = 0; ks < 4; ++ks) acc = MFMA16(ld8_f32_bf(wq + (size_t)(k0 + fr) * 2048 + ks * 32), kf_[ks], acc);
            st_bf4(out + k0 + 4 * fq, acc); }
    }
}
DEVI void phase_prologue(const P& p, char* lds) {
    const int tid = tid_();
    const size_t gtid = (size_t)blockIdx.x * NTHR + tid, gstride = (size_t)gridDim.x * NTHR;
    { float* rope = (float*)(WS(p) + OFF_ROPE);
      for (size_t i = gtid; i < (size_t)T_ * 16; i += gstride) { const int t = (int)(i >> 4), f = (int)(i & 15);
          const float angf = (float)p.pos[t] * (float)p.invf[f];
          const double rev = (double)angf * 0.15915494309189535; const double fr = rev - rint(rev);
          rope[(size_t)t * 32 + f] = __builtin_amdgcn_cosf((float)fr); rope[(size_t)t * 32 + 16 + f] = __builtin_amdgcn_sinf((float)fr); } }
    { float* ca = (float*)lds; f32x4* red = (f32x4*)(ca + 2048);
      float* mod = (float*)(WS(p) + OFF_MOD);
      __syncthreads();
      for (int i = tid; i < 2048; i += NTHR) { const float cv = p.c[i]; ca[i] = cv * sigmoidf_(cv); }
      __syncthreads();
      for (int wi = blockIdx.x; wi < NL * 48; wi += gridDim.x) {
          const int l = wi / 48, j0 = (wi - l * 48) * 128, kq = tid >> 5, cq = tid & 31;
          const float* w = p.w_mod + (size_t)l * 1024 * 6144 + j0 + cq * 4; f32x4 a0 = (f32x4){0.f, 0.f, 0.f, 0.f}, a1 = a0;
#pragma unroll 8
          for (int k = kq * 64; k < kq * 64 + 64; ++k) { const f32x4 wv = *(const f32x4*)(w + (size_t)k * 6144); a0 = a0 + wv * ca[k]; a1 = a1 + wv * ca[1024 + k]; }
          red[(kq * 2 + 0) * 32 + cq] = a0; red[(kq * 2 + 1) * 32 + cq] = a1;
          __syncthreads();
          if (tid < 64) { const int b = tid >> 5; f32x4 s = red[b * 32 + cq];
#pragma unroll
              for (int q = 1; q < 16; ++q) s = s + red[(q * 2 + b) * 32 + cq];
              const f32x4 bb = *(const f32x4*)(p.b_mod + (size_t)l * 6144 + j0 + cq * 4); *(f32x4*)(mod + ((size_t)l * 2 + b) * 6144 + j0 + cq * 4) = s + bb; }
          __syncthreads();
      } }
    int rot = 192;
    for (int l = 0; l < NL; ++l) {
        unsigned char* wl = WS(p) + OFF_W + (size_t)l * W_LAYER;
        job_transpose(p.w_in + (size_t)l * 1024 * 4512, 1024, 4512, (bf16_t*)(wl + W_INT), 1, nullptr, lds, rot);
        for (size_t i = gtid; i < (size_t)96 * 1024 / 8; i += gstride) ((u32x4*)(wl + W_INT + (size_t)1440 * 1024 * 2))[i] = (u32x4){0u, 0u, 0u, 0u};
        if (GATES_FP8) job_transpose8(p.w_in + (size_t)l * 1024 * 4512 + 1440, 4512, 1024, 3072, wl + W_G8, 64.f, lds, rot);
        job_transpose(p.w_uq + (size_t)l * 384 * 768, 384, 768, (bf16_t*)(wl + W_UQ), 0, p.q_norm + l * 384, lds, rot);
        job_transpose(p.w_ukv + (size_t)l * 256 * 1024, 256, 1024, (bf16_t*)(wl + W_UKV), 0, p.kv_norm + l * 256, lds, rot);
        job_transpose(p.w_a + (size_t)l * 256 * 1024, 256, 1024, (bf16_t*)(wl + W_A) + CAT_YA, 0, nullptr, lds, rot, 1024);
        job_transpose(p.w_b + (size_t)l * 512 * 1024, 512, 1024, (bf16_t*)(wl + W_A) + CAT_YB, 0, nullptr, lds, rot, 1024);
        job_transpose(p.w_o + (size_t)l * 1024 * 1024, 1024, 1024, (bf16_t*)(wl + W_O), 0, nullptr, lds, rot);
        if (!PQ_FOLD) job_transpose(p.w_pq + (size_t)l * 1024 * 2048, 1024, 2048, (bf16_t*)(wl + W_PQ), 0, nullptr, lds, rot);
        job_convert(p.sub_keys + (size_t)l * 16 * 128 * 128, (bf16_t*)(wl + W_SK), (size_t)16 * 128 * 128 / 4, 0);
        job_convert(p.w_s + (size_t)l * 4 * 128 * 128, (bf16_t*)(wl + W_S), (size_t)4 * 128 * 128 / 4, 1);
    }
    if (PQ_FOLD) job_fold_pq(p);
    { float* Tt = (float*)lds; float* Wp = Tt + 64 * 65;
      for (int wi = (int)((blockIdx.x + gridDim.x - (unsigned)rot % gridDim.x) % gridDim.x); wi < NL * 4 * 16; wi += gridDim.x) {
          const int l = wi >> 6, g = (wi >> 4) & 3, n0 = (wi & 15) * 64;
          const float* wp = p.w_pool + (size_t)l * 4 * 64 * 64 + (size_t)g * 64 * 64; const float* ps = p.pool_scale + l * 256 + g * 64; const float* wcs = p.w_c + (size_t)l * 256 * 1024 + (size_t)g * 64 * 1024 + n0;
          __syncthreads();
#pragma unroll
          for (int i = 0; i < 8; ++i) { const int id = tid + i * NTHR, r = id >> 6, c = id & 63; Tt[r * 65 + c] = ps[r] * wcs[(size_t)r * 1024 + c]; Wp[r * 65 + c] = wp[r * 64 + c]; }
          __syncthreads();
          const int n = tid & 63, cg = tid >> 6; float a[8];
#pragma unroll
          for (int i = 0; i < 8; ++i) a[i] = 0.f;
          for (int jj = 0; jj < 64; ++jj) { const float tv = Tt[jj * 65 + n];
#pragma unroll
              for (int i = 0; i < 8; ++i) a[i] += Wp[(cg * 8 + i) * 65 + jj] * tv; }
          u32x4 w; w.x = cvtpk(a[0], a[1]); w.y = cvtpk(a[2], a[3]); w.z = cvtpk(a[4], a[5]); w.w = cvtpk(a[6], a[7]);
          *(u32x4*)((bf16_t*)(WS(p) + OFF_W + (size_t)l * W_LAYER + W_A) + (size_t)(n0 + n) * 1024 + CAT_PRE + g * 64 + cg * 8) = w;
      } }
#if TAB_FMT == 45
    job_quant_rows45(p.u_tab, WS(p) + OFF_U, (float*)(WS(p) + OFF_SU), NL * 16384);
    job_quant_rows45(p.v_tab, WS(p) + OFF_V, (float*)(WS(p) + OFF_SV), NL * 16384);
#elif TAB_FMT == 5
    job_quant_rows5(p.u_tab, WS(p) + OFF_U, NL * 16384);
    job_quant_rows5(p.v_tab, WS(p) + OFF_V, NL * 16384);
#elif TAB_FMT == 65
    __syncthreads();
    job_quant_rows6(p.u_tab, WS(p) + OFF_U, (float*)(WS(p) + OFF_SU), NL * 16384, lds);
    job_quant_rows5(p.v_tab, WS(p) + OFF_V, NL * 16384);
#elif TAB_FMT == 6
    __syncthreads();
    job_quant_rows6(p.u_tab, WS(p) + OFF_U, (float*)(WS(p) + OFF_SU), NL * 16384, lds);
    job_quant_rows6(p.v_tab, WS(p) + OFF_V, (float*)(WS(p) + OFF_SV), NL * 16384, lds);
#else
    job_quant_rows(p.u_tab, WS(p) + OFF_U, (float*)(WS(p) + OFF_SU), NL * 16384);
    job_quant_rows(p.v_tab, WS(p) + OFF_V, (float*)(WS(p) + OFF_SV), NL * 16384);
#endif
}

DEVI void phase_norm(const P& p, const float* xsrc, const float* sh, const float* sc, bool also8, const bf16_t* xsrcb = nullptr, bool alsop = false) {
    const int lane = tid_() & 63, wid = tid_() >> 6, j = lane & 15, tk = lane >> 4; bf16_t* h = (bf16_t*)(WS(p) + OFF_H);
    for (int t0 = (blockIdx.x * 8 + wid) * 4; t0 < T_; t0 += gridDim.x * 32) {
        const int t = t0 + tk; const float* xp = xsrc + (size_t)t * DM + j * 4; f32x4 v[16]; float ss = 0.f;
#pragma unroll
        for (int i = 0; i < 16; ++i) { v[i] = xsrcb ? ld_bf4(xsrcb + (size_t)t * DM + j * 4 + i * 64) : *(const f32x4*)(xp + i * 64); ss += v[i][0] * v[i][0] + v[i][1] * v[i][1] + v[i][2] * v[i][2] + v[i][3] * v[i][3]; }
        ss += DPPF(ss, DPP_QX1); ss += DPPF(ss, DPP_QX2); ss += DPPF(ss, DPP_HMIR); ss += DPPF(ss, DPP_MIR);
        const float rs = rsqrtf(ss * (1.f / 1024.f) + 1e-6f); const int bo = (t >= S_) ? 6144 : 0;
#pragma unroll
        for (int i = 0; i < 16; ++i) { const int col = j * 4 + i * 64; const f32x4 a = *(const f32x4*)(sc + bo + col), b = *(const f32x4*)(sh + bo + col);
            const f32x4 o = v[i] * rs * (a + 1.f) + b; st_bf4(h + (size_t)t * DM + col, o); if (GATES_FP8 && also8) *(unsigned*)(WS(p) + OFF_H8 + (size_t)t * DM + col) = pk4_fp8(o); v[i] = o; }
        if (alsop) {
            float am = 0.f;
#pragma unroll
            for (int i = 0; i < 16; ++i) am = fmaxf(am, fmaxf(fmaxf(fabsf(v[i][0]), fabsf(v[i][1])), fmaxf(fabsf(v[i][2]), fabsf(v[i][3]))));
            am = fmaxf(am, DPPF(am, DPP_QX1)); am = fmaxf(am, DPPF(am, DPP_QX2)); am = fmaxf(am, DPPF(am, DPP_HMIR)); am = fmaxf(am, DPPF(am, DPP_MIR));
            const int e0 = (int)((__float_as_uint(fmaxf(am, 1e-20f) * (1.f / 6.f)) >> 23) & 255u) - 126;
            const float inv0 = __uint_as_float((unsigned)(127 - e0) << 23), s0 = __uint_as_float((unsigned)(127 + e0) << 23), inv1 = inv0 * 4.f;
            unsigned char* p0 = WS(p) + OFF_H4P + (size_t)t * 512; unsigned char* p1 = p0 + (size_t)T_ * 512;
#pragma unroll
            for (int i = 0; i < 16; ++i) { const f32x4 o = v[i]; unsigned pk = 0u;
                pk = __builtin_amdgcn_cvt_scalef32_pk_fp4_f32(pk, o[0] * inv0, o[1] * inv0, 1.0f, 0); pk = __builtin_amdgcn_cvt_scalef32_pk_fp4_f32(pk, o[2] * inv0, o[3] * inv0, 1.0f, 1);
                const f32x2 d01 = __builtin_amdgcn_cvt_scalef32_pk_f32_fp4(pk, 1.0f, 0), d23 = __builtin_amdgcn_cvt_scalef32_pk_f32_fp4(pk, 1.0f, 1);
                unsigned pr = 0u;
                pr = __builtin_amdgcn_cvt_scalef32_pk_fp4_f32(pr, (o[0] - d01[0] * s0) * inv1, (o[1] - d01[1] * s0) * inv1, 1.0f, 0); pr = __builtin_amdgcn_cvt_scalef32_pk_fp4_f32(pr, (o[2] - d23[0] * s0) * inv1, (o[3] - d23[1] * s0) * inv1, 1.0f, 1);
                const int off = (16 * (i & 1) + j) * 16 + (i >> 1) * 2;
                *(unsigned short*)(p0 + off) = (unsigned short)(pk & 0xffffu); *(unsigned short*)(p1 + off) = (unsigned short)(pr & 0xffffu); }
            if (j == 0) ((int*)(WS(p) + OFF_HSC))[t] = (127 + e0) | ((127 + e0 - 2) << 8);
        }
    }
}
DEVI void phase_final(const P& p) {
    const int lane = tid_() & 63, wid = tid_() >> 6;
#if PROBE_ATTN
    const float pscale = 1.f + 10.f * __uint_as_float(((const unsigned*)(WS(p) + OFF_CTL))[4000]);
#else
    const float pscale = 1.f;
#endif
    for (int t = blockIdx.x * 8 + wid; t < T_; t += gridDim.x * 8) {
        float* xp = XR(p) + (size_t)t * DM; f32x4 v[4]; float ss = 0.f;
#pragma unroll
        for (int i = 0; i < 4; ++i) { v[i] = *(const f32x4*)(xp + i * 256 + lane * 4); ss += v[i][0] * v[i][0] + v[i][1] * v[i][1] + v[i][2] * v[i][2] + v[i][3] * v[i][3]; }
        ss = wave_sum(ss); const float rs = rsqrtf(ss * (1.f / 1024.f) + 1e-6f);
#pragma unroll
        for (int i = 0; i < 4; ++i) { const int col = i * 256 + lane * 4; const f32x4 g = *(const f32x4*)(p.final_norm + col); *(f32x4*)(xp + col) = v[i] * (rs * pscale) * g; }
    }
}
DEVI void ld8_bf(const bf16_t* p, float (&o)[8]) { const u32x4 w = *(const u32x4*)p;
#pragma unroll
    for (int k = 0; k < 4; ++k) { o[2 * k] = bflo(w[k]); o[2 * k + 1] = bfhi(w[k]); } }
DEVI void st8_bf(bf16_t* p, const float (&v)[8]) { u32x4 w;
#pragma unroll
    for (int k = 0; k < 4; ++k) w[k] = cvtpk(v[2 * k], v[2 * k + 1]);
    *(u32x4*)p = w; }
DEVI float sum8(float v) { v += DPPF(v, DPP_QX1); v += DPPF(v, DPP_QX2); v += DPPF(v, DPP_HMIR); return v; }
DEVI void phase_post(const P& p) {
    const int lane = tid_() & 63, wid = tid_() >> 6, j = lane & 7, tk = lane >> 3;
    const bf16_t* z = (const bf16_t*)(WS(p) + OFF_Z); bf16_t* vn = (bf16_t*)(WS(p) + OFF_VN); bf16_t* pre = (bf16_t*)(WS(p) + OFF_CAT) + CAT_PRE; bf16_t* Kb = (bf16_t*)(WS(p) + OFF_K);
    float* rsq = (float*)(WS(p) + OFF_RS); float* rskv = rsq + T_; const float* rope = (const float*)(WS(p) + OFF_ROPE);
    for (int t0 = (blockIdx.x * 8 + wid) * 8; t0 < T_; t0 += gridDim.x * 64) {
        const int t = t0 + tk; const bf16_t* zr = z + (size_t)t * ZC;
        { float v[32]; float s = 0.f;
#pragma unroll
          for (int q = 0; q < 4; ++q) { float u[8]; ld8_bf(zr + Z_V + j * 32 + q * 8, u);
#pragma unroll
              for (int k = 0; k < 8; ++k) { v[q * 8 + k] = u[k]; s += u[k]; } }
          const float mu = sum8(s) * (1.f / 256.f); float s2 = 0.f;
#pragma unroll
          for (int k = 0; k < 32; ++k) { v[k] -= mu; s2 += v[k] * v[k]; }
          const float rstd = rsqrtf(sum8(s2) * (1.f / 256.f) + 1e-6f);
#pragma unroll
          for (int q = 0; q < 4; ++q) { float u[8];
#pragma unroll
              for (int k = 0; k < 8; ++k) u[k] = v[q * 8 + k] * rstd;
              st8_bf(vn + (size_t)t * 256 + j * 32 + q * 8, u); } }
        { float sq = 0.f, sk = 0.f;
#pragma unroll
          for (int q = 0; q < 6; ++q) { float u[8]; ld8_bf(zr + Z_CQ + j * 48 + q * 8, u);
#pragma unroll
              for (int k = 0; k < 8; ++k) sq += u[k] * u[k]; }
#pragma unroll
          for (int q = 0; q < 4; ++q) { float u[8]; ld8_bf(zr + Z_CKV + j * 32 + q * 8, u);
#pragma unroll
              for (int k = 0; k < 8; ++k) sk += u[k] * u[k]; }
          sq = sum8(sq); sk = sum8(sk);
          if (j == 0) rsq[t] = rsqrtf(sq * (1.f / 384.f) + 1e-6f); if (j == 1) rskv[t] = rsqrtf(sk * (1.f / 256.f) + 1e-6f); }
        {
          float x1[16], x2[16]; { float u[8]; ld8_bf(zr + Z_KR, u);
#pragma unroll
              for (int k = 0; k < 8; ++k) x1[k] = u[k]; ld8_bf(zr + Z_KR + 8, u);
#pragma unroll
              for (int k = 0; k < 8; ++k) x1[8 + k] = u[k]; ld8_bf(zr + Z_KR + 16, u);
#pragma unroll
              for (int k = 0; k < 8; ++k) x2[k] = u[k]; ld8_bf(zr + Z_KR + 24, u);
#pragma unroll
              for (int k = 0; k < 8; ++k) x2[8 + k] = u[k]; }
          const float* rp = rope + (size_t)t * 32; bf16_t* kr = Kb + (size_t)t * 768 + j * 96 + 64;
#pragma unroll
          for (int q = 0; q < 2; ++q) { float o1[8], o2[8];
#pragma unroll
              for (int k4 = 0; k4 < 2; ++k4) { const f32x4 cs = *(const f32x4*)(rp + q * 8 + k4 * 4), sn = *(const f32x4*)(rp + 16 + q * 8 + k4 * 4);
#pragma unroll
                  for (int k = 0; k < 4; ++k) { const int i = q * 8 + k4 * 4 + k; o1[k4 * 4 + k] = x1[i] * cs[k] - x2[i] * sn[k]; o2[k4 * 4 + k] = x2[i] * cs[k] + x1[i] * sn[k]; } }
              st8_bf(kr + q * 8, o1); st8_bf(kr + 16 + q * 8, o2); } }
        {
          const int tt = t & (S_ - 1), w = 2 << (j >> 1), n = (tt + 1 < w) ? tt + 1 : w; const bf16_t* zp = zr + Z_P + j * 32; float sum[32], self[32];
#pragma unroll
          for (int q = 0; q < 4; ++q) { float u[8]; ld8_bf(zp + q * 8, u);
#pragma unroll
              for (int k = 0; k < 8; ++k) { self[q * 8 + k] = u[k]; sum[q * 8 + k] = u[k]; } }
          for (int s = 1; s < n; ++s) {
#pragma unroll
              for (int q = 0; q < 4; ++q) { float u[8]; ld8_bf(zp - (size_t)s * ZC + q * 8, u);
#pragma unroll
                  for (int k = 0; k < 8; ++k) sum[q * 8 + k] += u[k]; } }
          const float inv = 1.f / (float)n;
#pragma unroll
          for (int q = 0; q < 4; ++q) { float u[8];
#pragma unroll
              for (int k = 0; k < 8; ++k) u[k] = sum[q * 8 + k] * inv - self[q * 8 + k];
              st8_bf(pre + (size_t)t * 1024 + j * 32 + q * 8, u); } }
    }
}
DEVI void phase_mixa(const P& p, int l, char* lds) {
    const int tid = tid_(), lane = tid & 63, wid = tid >> 6, fr = lane & 15, fq = lane >> 4, g = wid >> 1, th = (wid & 1) * 64;
    constexpr int VP = 136;
    bf16_t* vnT = (bf16_t*)lds;
    const bf16_t* vn = (const bf16_t*)(WS(p) + OFF_VN); const bf16_t* z = (const bf16_t*)(WS(p) + OFF_Z); bf16_t* ya = (bf16_t*)(WS(p) + OFF_CAT) + CAT_YA;
    const bf16_t* Wg = (const bf16_t*)(WS(p) + OFF_W + (size_t)l * W_LAYER + W_S) + (size_t)g * 128 * 128; const float* bs = p.b_s + (size_t)l * 512 + g * 128;
    for (int ch = blockIdx.x; ch < T_ / 128; ch += gridDim.x) {
        const size_t t0 = (size_t)ch * 128;
        __syncthreads();
#pragma unroll
        for (int i = 0; i < 8; ++i) { const int id = tid + i * NTHR, s = id >> 5, c8 = (id & 31) * 8; const u32x4 w = *(const u32x4*)(vn + (t0 + s) * 256 + c8);
            bf16_t* d = vnT + c8 * VP + s; d[0] = (bf16_t)(w.x & 0xffff); d[VP] = (bf16_t)(w.x >> 16); d[2 * VP] = (bf16_t)(w.y & 0xffff); d[3 * VP] = (bf16_t)(w.y >> 16);
            d[4 * VP] = (bf16_t)(w.z & 0xffff); d[5 * VP] = (bf16_t)(w.z >> 16); d[6 * VP] = (bf16_t)(w.w & 0xffff); d[7 * VP] = (bf16_t)(w.w >> 16); }
        __syncthreads();
        f32x4 acc[4][4]; acc_zero(acc);
#pragma unroll
        for (int kk = 0; kk < 4; ++kk) {
            bf16x8 af[4], bfr[4];
#pragma unroll
            for (int m = 0; m < 4; ++m) af[m] = *(const bf16x8*)(Wg + (size_t)(th + m * 16 + fr) * 128 + kk * 32 + fq * 8);
#pragma unroll
            for (int n = 0; n < 4; ++n) bfr[n] = *(const bf16x8*)(vnT + (g * 64 + n * 16 + fr) * VP + kk * 32 + fq * 8);
#pragma unroll
            for (int m = 0; m < 4; ++m)
#pragma unroll
                for (int n = 0; n < 4; ++n) acc[m][n] = MFMA16(bfr[n], af[m], acc[m][n]);
        }
#pragma unroll
        for (int m = 0; m < 4; ++m) { const int tl = th + m * 16 + fr; const float bias = bs[tl];
#pragma unroll
            for (int n = 0; n < 4; ++n) { const int c = g * 64 + n * 16 + 4 * fq; const f32x4 u = ld_bf4(z + (t0 + tl) * ZC + Z_U + c); f32x4 o = (acc[m][n] + bias) * u; st_bf4(ya + (t0 + tl) * 1024 + c, o); } }
    }
}
DEVI int crow(int r, int hi) { return (r & 3) + 8 * (r >> 2) + 4 * hi; }
DEVI s16x4 vtr(const char* p) { typedef short v4i16_t __attribute__((ext_vector_type(4))); return __builtin_bit_cast(s16x4, __builtin_amdgcn_ds_read_tr16_b64_v4i16((LAS v4i16_t*)p)); }
DEVI float hswap_max(float v) { return fmaxf(v, __shfl_xor(v, 32)); }
DEVI void attn_unit(const P& p, int b, int h, int qb, char* lds) {
    const int tid = tid_(), lane = tid & 63, r32 = lane & 31, hi = lane >> 5, wid = tid >> 6;
    char* Ks = lds; char* Vs = lds + 12288; float* wsf = (float*)(lds + 20480) + wid * 64;
    const bf16_t* Qb = (const bf16_t*)(WS(p) + OFF_Q); const bf16_t* Kb = (const bf16_t*)(WS(p) + OFF_K); const bf16_t* Vb = (const bf16_t*)(WS(p) + OFF_VV); bf16_t* Yb = (bf16_t*)(WS(p) + OFF_CAT) + CAT_YB;
    const size_t rowbase = (size_t)b * S_; const int q0 = qb * 256, NT = 4 * qb + 4;
    bf16x8 qr[6];
    { const size_t tq = rowbase + q0 + wid * 32 + r32; const bf16_t* qp = Qb + tq * 768 + h * 96 + hi * 8; const float rs = ((const float*)(WS(p) + OFF_RS))[tq]; const float sc = rs * C2F;
      const float* rp = (const float*)(WS(p) + OFF_ROPE) + tq * 32 + hi * 8;
      u32x4 raw[6];
#pragma unroll
      for (int d0 = 0; d0 < 6; ++d0) raw[d0] = *(const u32x4*)(qp + d0 * 16);
#pragma unroll
      for (int d0 = 0; d0 < 4; ++d0) { u32x4 w;
#pragma unroll
          for (int j = 0; j < 4; ++j) w[j] = cvtpk(bflo(raw[d0][j]) * sc, bfhi(raw[d0][j]) * sc);
          qr[d0] = __builtin_bit_cast(bf16x8, w); }
      u32x4 w1, w2;
#pragma unroll
      for (int j = 0; j < 4; ++j) { const float a0 = bflo(raw[4][j]), a1 = bfhi(raw[4][j]), b0 = bflo(raw[5][j]), b1 = bfhi(raw[5][j]);
          const float c0 = rp[2 * j], c1 = rp[2 * j + 1], s0 = rp[16 + 2 * j], s1 = rp[16 + 2 * j + 1];
          w1[j] = cvtpk((a0 * c0 - b0 * s0) * sc, (a1 * c1 - b1 * s1) * sc); w2[j] = cvtpk((b0 * c0 + a0 * s0) * sc, (b1 * c1 + a1 * s1) * sc); }
      qr[4] = __builtin_bit_cast(bf16x8, w1); qr[5] = __builtin_bit_cast(bf16x8, w2); }
    const bf16_t* Kg = Kb + rowbase * 768 + h * 96; const bf16_t* Vg = Vb + rowbase * 512 + h * 64;
    const int kc0 = tid >> 6, kk0 = tid & 63;
    const int vw = tid >> 6, vl = tid & 63, vrow = 16 * (vw & 3) + (vl >> 2), vcol = (vw >> 2) * 32 + (vl & 3) * 8;
    u32x4 rk0, rk1 = (u32x4){0u, 0u, 0u, 0u}, rv;
#define A_LOAD(t) do { rk0 = *(const u32x4*)(Kg + (size_t)((t) * 64 + kk0) * 768 + kc0 * 8); if (tid < 256) rk1 = *(const u32x4*)(Kg + (size_t)((t) * 64 + kk0) * 768 + (kc0 + 8) * 8); \
                       rv = *(const u32x4*)(Vg + (size_t)((t) * 64 + vrow) * 512 + vcol); } while (0)
    A_LOAD(0);
    f32x16 o0, o1;
#pragma unroll
    for (int r = 0; r < 16; ++r) { o0[r] = 0.f; o1[r] = 0.f; }
    float mrun = -1e30f, lrun = 0.f;
    const int qrel = wid * 32 + r32;
    const char* vp0 = Vs + ((lane >> 4) & 1) * 32 + (lane & 3) * 8 + (4 * hi + ((lane & 15) >> 2)) * 64;
    for (int t = 0; t < NT; ++t) {
        __syncthreads();
        *(u32x4*)(Ks + kc0 * 1024 + kk0 * 16) = rk0; if (tid < 256) *(u32x4*)(Ks + (kc0 + 8) * 1024 + kk0 * 16) = rk1;
        *(u32x4*)(Vs + vw * 1024 + vl * 16) = rv;
        __syncthreads();
        if (t + 1 < NT) A_LOAD(t + 1);
        f32x16 p0, p1;
#pragma unroll
        for (int r = 0; r < 16; ++r) { p0[r] = 0.f; p1[r] = 0.f; }
#pragma unroll
        for (int d0 = 0; d0 < 6; ++d0) { const bf16x8 k0 = *(const bf16x8*)(Ks + (2 * d0 + hi) * 1024 + r32 * 16), k1 = *(const bf16x8*)(Ks + (2 * d0 + hi) * 1024 + 512 + r32 * 16);
            p0 = MFMA32(k0, qr[d0], p0); p1 = MFMA32(k1, qr[d0], p1); }
        if (t >= NT - 4) { const int kb = 64 * (t - (NT - 4)) + 4 * hi;
#pragma unroll
            for (int r = 0; r < 16; ++r) { const int kv = kb + (r & 3) + 8 * (r >> 2); if (kv > qrel) p0[r] = -INFINITY; if (kv + 32 > qrel) p1[r] = -INFINITY; } }
        float rm = fmaxf(p0[0], p1[0]);
#pragma unroll
        for (int r = 1; r < 16; ++r) rm = fmaxf(rm, fmaxf(p0[r], p1[r]));
        rm = hswap_max(rm);
        const float mnew = fmaxf(mrun, rm), alpha = fexp2(mrun - mnew); mrun = mnew;
        float ls = 0.f;
#pragma unroll
        for (int r = 0; r < 16; ++r) { p0[r] = fexp2(p0[r] - mnew); p1[r] = fexp2(p1[r] - mnew); ls += p0[r] + p1[r]; }
        lrun = lrun * alpha + ls;
        if (__any(alpha != 1.f)) {
            if (hi == 0) wsf[r32] = alpha;
            asm volatile("s_waitcnt lgkmcnt(0)" ::: "memory");
#pragma unroll
            for (int r = 0; r < 16; ++r) { const float f = wsf[crow(r, hi)]; o0[r] *= f; o1[r] *= f; }
            asm volatile("s_waitcnt lgkmcnt(0)" ::: "memory");
        }
        u32x4 pw[4];
#pragma unroll
        for (int j = 0; j < 4; ++j) { pw[0][j] = cvtpk(p0[2 * j], p0[2 * j + 1]); pw[1][j] = cvtpk(p0[8 + 2 * j], p0[8 + 2 * j + 1]); pw[2][j] = cvtpk(p1[2 * j], p1[2 * j + 1]); pw[3][j] = cvtpk(p1[8 + 2 * j], p1[8 + 2 * j + 1]); }
#pragma unroll
        for (int ks = 0; ks < 4; ++ks) {
            const s16x4 a0 = vtr(vp0 + ks * 1024), a1 = vtr(vp0 + ks * 1024 + 512), b0 = vtr(vp0 + 4096 + ks * 1024), b1 = vtr(vp0 + 4096 + ks * 1024 + 512);
            const bf16x8 v0 = (bf16x8){a0[0], a0[1], a0[2], a0[3], a1[0], a1[1], a1[2], a1[3]}, v1 = (bf16x8){b0[0], b0[1], b0[2], b0[3], b1[0], b1[1], b1[2], b1[3]};
            const bf16x8 pa = __builtin_bit_cast(bf16x8, pw[ks]);
            o0 = MFMA32(pa, v0, o0); o1 = MFMA32(pa, v1, o1);
        }
    }
#undef A_LOAD
    lrun += __shfl_xor(lrun, 32);
    if (hi == 0) wsf[32 + r32] = lrun;
    asm volatile("s_waitcnt lgkmcnt(0)" ::: "memory");
    bf16_t* yo = Yb + (rowbase + q0 + wid * 32) * 1024 + h * 64 + r32;
#pragma unroll
    for (int r = 0; r < 16; ++r) { const int row = crow(r, hi); const float rl = frcp(wsf[32 + row]); yo[(size_t)row * 1024] = f2bf(o0[r] * rl); yo[(size_t)row * 1024 + 32] = f2bf(o1[r] * rl); }
    asm volatile("s_waitcnt lgkmcnt(0)" ::: "memory");
}

namespace at96 {
constexpr int KSLOT = 12288, VSLOT = 8192, LDS_K = 0, LDS_V = 3 * KSLOT, LDS_WS = LDS_V + 3 * VSLOT, LDS_OST = LDS_WS + 8 * 256, LDS_NEED = LDS_OST + 8 * 4096;
#define A9_THR 8
#define SBAR() __builtin_amdgcn_sched_barrier(0)
#define PIN(x) asm volatile("" : "+v"(x))
#define WAIT_BAR(N) asm volatile("s_waitcnt vmcnt(" #N ") lgkmcnt(0)\n\ts_barrier" ::: "memory")
#define WAIT_BAR2(NA, NB) do { if (w03) { WAIT_BAR(NA); } else { WAIT_BAR(NB); } } while (0)
typedef __attribute__((address_space(3))) const char* lds_cptr;
DEVI unsigned cvtpk_a(float lo, float hi) { unsigned r; asm("v_cvt_pk_bf16_f32 %0, %1, %2" : "=v"(r) : "v"(lo), "v"(hi)); return r; }
DEVI void glds16(const void* g, unsigned lds_base) {
    unsigned sv; asm volatile("s_mov_b32 %0, m0\n\ts_mov_b32 m0, %2\n\ts_nop 0\n\tglobal_load_lds_dwordx4 %1, off\n\ts_mov_b32 m0, %0" : "=&s"(sv) : "v"(g), "s"(lds_base) : "memory"); }
DEVI void kload2(bf16x8* kf, lds_cptr kp, int d0) { kf[2 * d0] = *(const LAS bf16x8*)(kp + d0 * 2048); kf[2 * d0 + 1] = *(const LAS bf16x8*)(kp + d0 * 2048 + 512); }
DEVI s16x4 vtr3(lds_cptr p) { typedef short v4i16_t __attribute__((ext_vector_type(4))); return __builtin_bit_cast(s16x4, __builtin_amdgcn_ds_read_tr16_b64_v4i16((LAS v4i16_t*)p)); }
#define MX3(a, b, c) __builtin_fmaxf(__builtin_fmaxf((a), (b)), (c))
DEVI float rowmax(const f32x16& p0, const f32x16& p1) {
    float a = MX3(p0[0], p0[1], p1[0]), b = MX3(p0[2], p0[3], p1[1]); a = MX3(a, p1[2], p1[3]);
#pragma unroll
    for (int r = 4; r < 16; r += 4) { a = MX3(a, p0[r], p0[r + 1]); b = MX3(b, p0[r + 2], p0[r + 3]); a = MX3(a, p1[r], p1[r + 1]); b = MX3(b, p1[r + 2], p1[r + 3]); }
    float m = __builtin_fmaxf(a, b); auto rr = __builtin_amdgcn_permlane32_swap(__float_as_uint(m), __float_as_uint(m), false, false);
    return __builtin_fmaxf(__uint_as_float(rr[0]), __uint_as_float(rr[1])); }
DEVI void cmask(f32x16& p0, f32x16& p1, int jb, int qrel, int hi) {
    const int kb = 64 * jb + 4 * hi;
#pragma unroll
    for (int r = 0; r < 16; ++r) { const int kv = kb + (r & 3) + 8 * (r >> 2); if (kv > qrel) p0[r] = -INFINITY; if (kv + 32 > qrel) p1[r] = -INFINITY; } }

DEVI void attn_unit(const P& p, int b, int h, int qb, char* lds) {
    const int tid = tid_(), lane = tid & 63, r32 = lane & 31, hi = lane >> 5; const int wid = __builtin_amdgcn_readfirstlane(tid >> 6);
    const bf16_t* Qb = (const bf16_t*)(WS(p) + OFF_Q); const bf16_t* Kb = (const bf16_t*)(WS(p) + OFF_K); const bf16_t* Vb = (const bf16_t*)(WS(p) + OFF_VV); bf16_t* Yb = (bf16_t*)(WS(p) + OFF_CAT) + CAT_YB;
    const size_t rowbase = (size_t)b * S_; const int q0 = qb * 256, NT = 4 * qb + 4;
    bf16x8 qr[6];
    { const size_t tq = rowbase + q0 + wid * 32 + r32; const bf16_t* qp = Qb + tq * 768 + h * 96 + hi * 8; const float rs = ((const float*)(WS(p) + OFF_RS))[tq]; const float sc = rs * C2F;
      const float* rp = (const float*)(WS(p) + OFF_ROPE) + tq * 32 + hi * 8;
      u32x4 raw[6];
#pragma unroll
      for (int d0 = 0; d0 < 6; ++d0) raw[d0] = *(const u32x4*)(qp + d0 * 16);
#pragma unroll
      for (int d0 = 0; d0 < 4; ++d0) { u32x4 w;
#pragma unroll
          for (int j = 0; j < 4; ++j) w[j] = cvtpk(bflo(raw[d0][j]) * sc, bfhi(raw[d0][j]) * sc);
          qr[d0] = __builtin_bit_cast(bf16x8, w); }
      u32x4 w1, w2;
#pragma unroll
      for (int j = 0; j < 4; ++j) { const float a0 = bflo(raw[4][j]), a1 = bfhi(raw[4][j]), b0 = bflo(raw[5][j]), b1 = bfhi(raw[5][j]);
          const float c0 = rp[2 * j], c1 = rp[2 * j + 1], s0 = rp[16 + 2 * j], s1 = rp[16 + 2 * j + 1];
          w1[j] = cvtpk((a0 * c0 - b0 * s0) * sc, (a1 * c1 - b1 * s1) * sc); w2[j] = cvtpk((b0 * c0 + a0 * s0) * sc, (b1 * c1 + a1 * s1) * sc); }
      qr[4] = __builtin_bit_cast(bf16x8, w1); qr[5] = __builtin_bit_cast(bf16x8, w2); }
    const unsigned lds0 = (unsigned)(uintptr_t)lds; float* wsf = (float*)(lds + LDS_WS) + wid * 64;
    const bf16_t* Kg = Kb + rowbase * 768 + h * 96; const bf16_t* Vg = Vb + rowbase * 512 + h * 64;
    const bf16_t* ksrc1 = Kg + (size_t)lane * 768 + wid * 8; const bf16_t* ksrc2 = Kg + (size_t)lane * 768 + (8 + (wid & 3)) * 8;
    const bf16_t* vsrc = Vg + (size_t)(16 * (wid & 3) + (lane >> 2)) * 512 + (wid >> 2) * 32 + (lane & 3) * 8;
    const bool w03 = wid < 4;
    const unsigned kdst1 = lds0 + LDS_K + wid * 1024, kdst2 = lds0 + LDS_K + (8 + (wid & 3)) * 1024, vdst = lds0 + LDS_V + wid * 1024;
#define RFL(x) ((unsigned)__builtin_amdgcn_readfirstlane((int)(x)))
#define DMA_K(t, sl) do { glds16(ksrc1 + (size_t)(t) * 64 * 768, RFL(kdst1 + (sl) * KSLOT)); if (w03) glds16(ksrc2 + (size_t)(t) * 64 * 768, RFL(kdst2 + (sl) * KSLOT)); } while (0)
#define DMA_V(t, sl) glds16(vsrc + (size_t)(t) * 64 * 512, RFL(vdst + (sl) * VSLOT))
    const lds_cptr vp0 = (lds_cptr)lds + LDS_V + ((lane >> 4) & 1) * 32 + (lane & 3) * 8 + (4 * hi + ((lane & 15) >> 2)) * 64;
    const lds_cptr kp0 = (lds_cptr)lds + LDS_K + hi * 1024 + r32 * 16;
    DMA_K(0, 0); DMA_V(0, 0); DMA_K(1, 1); DMA_K(2, 2);
    float mhat = 0.f, l_reg = 0.f; f32x16 o[2];
#pragma unroll
    for (int r = 0; r < 16; ++r) { o[0][r] = 0.f; o[1][r] = 0.f; }
    const f32x16 zero16 = o[0];
    f32x16 negm = o[0]; asm volatile("" : "+v"(negm));
    const int qrel = wid * 32 + r32; bool resc = false;
    f32x16 pA0, pA1, pB0, pB1; bf16x8 kf[12]; s16x4 vlo[8], vhi[8]; u32x4 pw0, pw1, pw2, pw3;
    int sl_prev = 0, sl_cur = 0, sl_next = 1;
#define ROT() do { sl_prev = sl_cur; sl_cur = sl_next; sl_next = (sl_next == 2) ? 0 : sl_next + 1; } while (0)
#define EX(v) __builtin_amdgcn_exp2f(v)
#define RESC() do { if (resc) { _Pragma("unroll") for (int d_ = 0; d_ < 2; ++d_) _Pragma("unroll") for (int r = 0; r < 16; ++r) o[d_][r] *= wsf[crow(r, hi)]; } } while (0)
    if (wid >= 4) __builtin_amdgcn_s_setprio(1);
    WAIT_BAR2(5, 3);
    _Pragma("unroll") for (int d0 = 0; d0 < 6; ++d0) kload2(kf, kp0, d0);
    pA0 = MFMA32(kf[0], qr[0], zero16); pA1 = MFMA32(kf[1], qr[0], zero16);
    _Pragma("unroll") for (int d0 = 1; d0 < 6; ++d0) { pA0 = MFMA32(kf[2 * d0], qr[d0], pA0); pA1 = MFMA32(kf[2 * d0 + 1], qr[d0], pA1); }
    if (NT == 4) cmask(pA0, pA1, 0, qrel, hi);
    { const float rm = rowmax(pA0, pA1); mhat = rm;
#pragma unroll
      for (int r = 0; r < 16; ++r) { pA0[r] = EX(pA0[r] - rm); pA1[r] = EX(pA1[r] - rm); negm[r] = -rm; }
      asm volatile("" : "+v"(negm)); }
    WAIT_BAR(0);
    DMA_K(3, 0); DMA_V(1, 1); ROT();
    _Pragma("unroll") for (int d0 = 0; d0 < 6; ++d0) kload2(kf, kp0 + sl_cur * KSLOT, d0);
    WAIT_BAR2(3, 2);
#define PKW(P, i) cvtpk_a(P[i], P[i + 1])
#define PAF(k) __builtin_bit_cast(bf16x8, pw##k)
#define VFR(i) (bf16x8){vlo[i][0], vlo[i][1], vlo[i][2], vlo[i][3], vhi[i][0], vhi[i][1], vhi[i][2], vhi[i][3]}
#define VRD(i) do { vlo[i] = vtr3(vp_ + (((i) >> 2) * 4096 + ((i) & 3) * 1024)); vhi[i] = vtr3(vp_ + (((i) >> 2) * 4096 + ((i) & 3) * 1024 + 512)); } while (0)
#define KRD(G, d0) do { if (G) { kload2(kf, kp0 + sl_next * KSLOT, d0); SBAR(); } } while (0)
#define GAPA(MF, a0, a1, a2, a3, W0, W1, PW) do { MF; sacc += a0; sacc += a1; sacc += a2; sacc += a3; W0; W1; PIN(PW); PIN(sacc); SBAR(); } while (0)
#define GAPB(MF, X, i) do { MF; X[i] = EX(X[i]); X[i + 1] = EX(X[i + 1]); X[i + 2] = EX(X[i + 2]); X[i + 3] = EX(X[i + 3]); PIN(X); SBAR(); } while (0)
#define STEP(C0, C1, P0, P1, t, MASK, GK, GV, GL) do { SBAR(); \
    const lds_cptr vp_ = vp0 + sl_prev * VSLOT; \
    VRD(0); SBAR(); float sacc = P0[0] + P0[1]; \
                    GAPA(C0 = MFMA32(kf[0], qr[0], negm), P0[2], P0[3], P0[4], P0[5],     pw0[0] = PKW(P0, 0),  pw0[1] = PKW(P0, 2),  pw0); \
    VRD(4); SBAR(); GAPA(C1 = MFMA32(kf[1], qr[0], negm), P0[6], P0[7], P0[8], P0[9],     pw0[2] = PKW(P0, 4),  pw0[3] = PKW(P0, 6),  pw0); \
    VRD(1); SBAR(); GAPA(C0 = MFMA32(kf[2], qr[1], C0),    P0[10], P0[11], P0[12], P0[13], pw1[0] = PKW(P0, 8),  pw1[1] = PKW(P0, 10), pw1); \
    VRD(5); SBAR(); GAPA(C1 = MFMA32(kf[3], qr[1], C1),    P0[14], P0[15], P1[0], P1[1],   pw1[2] = PKW(P0, 12), pw1[3] = PKW(P0, 14), pw1); \
                    GAPA(C0 = MFMA32(kf[4], qr[2], C0),    P1[2], P1[3], P1[4], P1[5],     pw2[0] = PKW(P1, 0),  pw2[1] = PKW(P1, 2),  pw2); \
                    GAPA(C1 = MFMA32(kf[5], qr[2], C1),    P1[6], P1[7], P1[8], P1[9],     pw2[2] = PKW(P1, 4),  pw2[3] = PKW(P1, 6),  pw2); \
                    GAPA(C0 = MFMA32(kf[6], qr[3], C0),    P1[10], P1[11], P1[12], P1[13], pw3[0] = PKW(P1, 8),  pw3[1] = PKW(P1, 10), pw3); \
                    GAPA(C1 = MFMA32(kf[7], qr[3], C1),    P1[14], P1[15], 0.f, 0.f,       pw3[2] = PKW(P1, 12), pw3[3] = PKW(P1, 14), pw3); \
    KRD(GL, 0); C0 = MFMA32(kf[8], qr[4], C0); SBAR(); KRD(GL, 1); C1 = MFMA32(kf[9], qr[4], C1); SBAR(); KRD(GL, 2); C0 = MFMA32(kf[10], qr[5], C0); SBAR(); KRD(GL, 3); C1 = MFMA32(kf[11], qr[5], C1); SBAR();     \
    l_reg += sacc; \
    if (GK) DMA_K((t) + 3, sl_cur); if (GV) DMA_V((t) + 1, sl_next);                                                       \
    if (MASK) cmask(C0, C1, (t) - (NT - 4), qrel, hi); \
    { const float rm = rowmax(C0, C1); resc = false;                                                                        \
      if (__builtin_expect(__any(rm > (float)A9_THR), 0)) { const float dl = __builtin_fmaxf(rm, 0.f); mhat += dl;          \
          _Pragma("unroll") for (int r = 0; r < 16; ++r) { C0[r] -= dl; C1[r] -= dl; negm[r] = -mhat; } asm volatile("" : "+v"(negm)); \
          const float f = __builtin_amdgcn_exp2f(-dl); l_reg *= f; if (hi == 0) wsf[r32] = f; resc = true; } } \
    SBAR(); \
    VRD(2); SBAR(); GAPB(o[0] = MFMA32(PAF(0), VFR(0), o[0]), C0, 0);              VRD(6); SBAR(); GAPB(o[1] = MFMA32(PAF(0), VFR(4), o[1]), C0, 4);                \
    VRD(3); SBAR(); GAPB(o[0] = MFMA32(PAF(1), VFR(1), o[0]), C0, 8);  VRD(7); SBAR(); GAPB(o[1] = MFMA32(PAF(1), VFR(5), o[1]), C0, 12); \
    GAPB(o[0] = MFMA32(PAF(2), VFR(2), o[0]), C1, 0);  GAPB(o[1] = MFMA32(PAF(2), VFR(6), o[1]), C1, 4); \
    KRD(GL, 4); GAPB(o[0] = MFMA32(PAF(3), VFR(3), o[0]), C1, 8);  KRD(GL, 5); GAPB(o[1] = MFMA32(PAF(3), VFR(7), o[1]), C1, 12); \
    } while (0)
    int t = 1;
    for (; t + 5 < NT; t += 2) {
        STEP(pB0, pB1, pA0, pA1, t, false, true, true, true);     WAIT_BAR2(3, 2); RESC(); ROT();
        STEP(pA0, pA1, pB0, pB1, t + 1, false, true, true, true); WAIT_BAR2(3, 2); RESC(); ROT();
    }
#define ENDW(tt) do { if ((tt) + 3 < NT) { WAIT_BAR2(3, 2); } else if ((tt) + 2 < NT) { WAIT_BAR(1); } else { WAIT_BAR(0); } } while (0)
    for (; t + 1 < NT; t += 2) {
        STEP(pB0, pB1, pA0, pA1, t, true, (t + 3 < NT), (t + 1 < NT), (t + 1 < NT));         ENDW(t);     RESC(); ROT();
        STEP(pA0, pA1, pB0, pB1, t + 1, true, (t + 4 < NT), (t + 2 < NT), (t + 2 < NT));     ENDW(t + 1); RESC(); ROT();
    }
    STEP(pB0, pB1, pA0, pA1, NT - 1, true, false, false, false); RESC();
    { float sacc = pB0[0] + pB0[1];
#pragma unroll
      for (int r = 2; r < 16; ++r) sacc += pB0[r];
#pragma unroll
      for (int r = 0; r < 16; ++r) sacc += pB1[r];
      l_reg += sacc;
      pw0 = (u32x4){PKW(pB0, 0), PKW(pB0, 2), PKW(pB0, 4), PKW(pB0, 6)}; pw1 = (u32x4){PKW(pB0, 8), PKW(pB0, 10), PKW(pB0, 12), PKW(pB0, 14)};
      pw2 = (u32x4){PKW(pB1, 0), PKW(pB1, 2), PKW(pB1, 4), PKW(pB1, 6)}; pw3 = (u32x4){PKW(pB1, 8), PKW(pB1, 10), PKW(pB1, 12), PKW(pB1, 14)};
      const lds_cptr vp_ = vp0 + sl_cur * VSLOT; _Pragma("unroll") for (int i = 0; i < 8; ++i) VRD(i);
      o[0] = MFMA32(PAF(0), VFR(0), o[0]); o[1] = MFMA32(PAF(0), VFR(4), o[1]); o[0] = MFMA32(PAF(1), VFR(1), o[0]); o[1] = MFMA32(PAF(1), VFR(5), o[1]);
      o[0] = MFMA32(PAF(2), VFR(2), o[0]); o[1] = MFMA32(PAF(2), VFR(6), o[1]); o[0] = MFMA32(PAF(3), VFR(3), o[0]); o[1] = MFMA32(PAF(3), VFR(7), o[1]); }
    { auto rr = __builtin_amdgcn_permlane32_swap(__float_as_uint(l_reg), __float_as_uint(l_reg), false, false); l_reg = __uint_as_float(rr[0]) + __uint_as_float(rr[1]); }
    if (hi == 0) wsf[32 + r32] = l_reg; asm volatile("s_waitcnt lgkmcnt(0)" ::: "memory");
    float rli[16];
#pragma unroll
    for (int r = 0; r < 16; ++r) rli[r] = __builtin_amdgcn_rcpf(wsf[32 + crow(r, hi)]);
    bf16_t* Ow = Yb + (rowbase + q0 + wid * 32) * 1024 + h * 64; bf16_t* stg = (bf16_t*)(lds + LDS_OST) + wid * 2048;
#pragma unroll
    for (int r = 0; r < 16; ++r) { const int orow = crow(r, hi);
#pragma unroll
        for (int d0 = 0; d0 < 2; ++d0) stg[orow * 64 + d0 * 32 + r32] = f2bf(o[d0][r] * rli[r]); }
    asm volatile("s_waitcnt lgkmcnt(0)" ::: "memory");
#pragma unroll
    for (int i = 0; i < 4; ++i) { const int row = i * 8 + (lane >> 3), ch = lane & 7; *(u32x4*)(Ow + (size_t)row * 1024 + ch * 8) = *(const u32x4*)(stg + row * 64 + ch * 8); }
    __builtin_amdgcn_s_setprio(0);
    asm volatile("s_waitcnt lgkmcnt(0)\n\ts_barrier" ::: "memory");
#undef RFL
#undef DMA_K
#undef DMA_V
#undef ROT
#undef EX
#undef RESC
#undef PKW
#undef PAF
#undef VFR
#undef VRD
#undef KRD
#undef ENDW
#undef GAPA
#undef GAPB
#undef STEP
}
#undef SBAR
#undef PIN
#undef WAIT_BAR
#undef WAIT_BAR2
#undef MX3
}
static_assert(at96::LDS_NEED <= LDS_BYTES - 16, "attention LDS");
#ifndef ATTN_SIMPLE
#define ATTN_SIMPLE 0
#endif
DEVI void phase_attn(const P& p, char* lds) {
    for (int v0 = blockIdx.x; v0 < 256; v0 += gridDim.x) {
        const int v = (gridDim.x == 256) ? ((v0 & 7) * 32 + (v0 >> 3)) : v0;
        const int bh = v >> 4, s = v & 15;
#pragma unroll 1
        for (int i = 0; i < 4; ++i) { const int qb = (i == 0) ? s : (i == 1) ? 31 - s : (i == 2) ? 32 + s : 63 - s; if (ATTN_SIMPLE) attn_unit(p, bh >> 3, bh & 7, qb, lds); else at96::attn_unit(p, bh >> 3, bh & 7, qb, lds); }
    }
}
DEVI void phase_merge(const P& p, int l, char* lds) {
    const int lane = tid_() & 63, wid = tid_() >> 6, wm = wid >> 1, wn = wid & 1, fr = lane & 15, fq = lane >> 4;
    const unsigned char* wl = WS(p) + OFF_W + (size_t)l * W_LAYER; const bf16_t* z = (const bf16_t*)(WS(p) + OFF_Z); bf16_t* mg = (bf16_t*)(WS(p) + OFF_H);
    for (int u = blockIdx.x; u < 128 * 8; u += gridDim.x) {
        const int pm = u >> 3, pn = u & 7;
        f32x4 tot[4][4]; acc_zero(tot);
#pragma unroll 1
        for (int seg = 0; seg < 3; ++seg) {
            const int koff = (seg == 0) ? CAT_YA : (seg == 1) ? CAT_YB : CAT_PRE, K = (seg == 1) ? 512 : 256;
            const bf16_t* A = (const bf16_t*)(WS(p) + OFF_CAT) + koff; const bf16_t* Bt = (const bf16_t*)(wl + W_A) + koff;
            f32x4 acc[4][4]; acc_zero(acc);
            gemm_kloop(acc, A + (size_t)pm * 256 * 1024, 1024, Bt + (size_t)pn * 128 * 1024, 1024, K, lds);
#pragma unroll
            for (int m = 0; m < 4; ++m)
#pragma unroll
                for (int n = 0; n < 4; ++n) { const int row = pm * 256 + wm * 64 + m * 16 + fr, col = pn * 128 + wn * 64 + n * 16 + 4 * fq;
                    const f32x4 gt = ld_bf4(z + (size_t)row * ZC + Z_G + seg * 1024 + col); tot[m][n] = tot[m][n] + gt * acc[m][n]; }
        }
#pragma unroll
        for (int m = 0; m < 4; ++m)
#pragma unroll
            for (int n = 0; n < 4; ++n) { const int row = pm * 256 + wm * 64 + m * 16 + fr, col = pn * 128 + wn * 64 + n * 16 + 4 * fq; st_bf4(mg + (size_t)row * DM + col, tot[m][n]); }
    }
}
DEVI int f2key(float f) { const int b = __float_as_int(f); return b ^ ((b >> 31) & 0x7fffffff); }
DEVI float key2f(int k) { return __int_as_float(k ^ ((k >> 31) & 0x7fffffff)); }
DEVI int med3i(int a, int b, int c) { int r; asm("v_med3_i32 %0, %1, %2, %3" : "=v"(r) : "v"(a), "v"(b), "v"(c)); return r; }
#define INS16(L, xin) do { const int x_ = (xin); _Pragma("unroll") for (int i_ = 15; i_ > 0; --i_) L[i_] = med3i(L[i_ - 1], L[i_], x_); L[0] = max(L[0], x_); } while (0)
#define CS(K, i, j) do { const int a_ = K[i], b_ = K[j]; K[i] = max(a_, b_); K[j] = min(a_, b_); } while (0)
#define SORT16(K) do { CS(K,0,1); CS(K,2,3); CS(K,0,2); CS(K,1,3); CS(K,1,2); CS(K,4,5); CS(K,6,7); CS(K,4,6); CS(K,5,7); CS(K,5,6); CS(K,0,4); CS(K,2,6); CS(K,2,4); CS(K,1,5); CS(K,3,7); CS(K,3,5); CS(K,1,2); CS(K,3,4); CS(K,5,6); CS(K,8,9); CS(K,10,11); CS(K,8,10); CS(K,9,11); CS(K,9,10); CS(K,12,13); CS(K,14,15); CS(K,12,14); CS(K,13,15); CS(K,13,14); CS(K,8,12); CS(K,10,14); CS(K,10,12); CS(K,9,13); CS(K,11,15); CS(K,11,13); CS(K,9,10); CS(K,11,12); CS(K,13,14); CS(K,0,8); CS(K,4,12); CS(K,4,8); CS(K,2,10); CS(K,6,14); CS(K,6,10); CS(K,2,4); CS(K,6,8); CS(K,10,12); CS(K,1,9); CS(K,5,13); CS(K,5,9); CS(K,3,11); CS(K,7,15); CS(K,7,11); CS(K,3,5); CS(K,7,9); CS(K,11,13); CS(K,1,2); CS(K,3,4); CS(K,5,6); CS(K,7,8); CS(K,9,10); CS(K,11,12); CS(K,13,14); } while (0)
#define BM16(K) do { CS(K,0,8); CS(K,1,9); CS(K,2,10); CS(K,3,11); CS(K,4,12); CS(K,5,13); CS(K,6,14); CS(K,7,15); CS(K,0,4); CS(K,1,5); CS(K,2,6); CS(K,3,7); CS(K,8,12); CS(K,9,13); CS(K,10,14); CS(K,11,15); CS(K,0,2); CS(K,1,3); CS(K,4,6); CS(K,5,7); CS(K,8,10); CS(K,9,11); CS(K,12,14); CS(K,13,15); CS(K,0,1); CS(K,2,3); CS(K,4,5); CS(K,6,7); CS(K,8,9); CS(K,10,11); CS(K,12,13); CS(K,14,15); } while (0)
#define MERGE16(A, B) do { _Pragma("unroll") for (int i_ = 0; i_ < 16; ++i_) A[i_] = max(A[i_], B[15 - i_]); BM16(A); } while (0)
DEVI void phase_topk(const P& p) {
    const float* sT = (const float*)(WS(p) + OFF_Z); int* eidx = (int*)(WS(p) + OFF_EIDX); float* gw = (float*)(WS(p) + OFF_VN);
    for (int wi = blockIdx.x * NTHR + tid_(); wi < 8 * T_; wi += gridDim.x * NTHR) {
        const int h = wi >> 15, t = wi & (T_ - 1);
        int L1[16], L2[16];
#pragma unroll
        for (int i = 0; i < 16; ++i) { L1[i] = (int)0x80000000; L2[i] = (int)0x80000000; }
        const float* s1 = sT + (size_t)(h * 256) * T_ + t; const float* s2 = s1 + (size_t)128 * T_;
        float ca[16], cb[16];
#pragma unroll
        for (int i = 0; i < 16; ++i) { ca[i] = s1[(size_t)i * T_]; cb[i] = s2[(size_t)i * T_]; }
#pragma unroll 1
        for (int kc = 0; kc < 8; ++kc) {
            float na[16], nb[16]; const int kn = (kc < 7) ? (kc + 1) * 16 : 0;
#pragma unroll
            for (int i = 0; i < 16; ++i) { na[i] = s1[(size_t)(kn + i) * T_]; nb[i] = s2[(size_t)(kn + i) * T_]; }
#pragma unroll
            for (int i = 0; i < 16; ++i) { const int k = kc * 16 + i; const int a = (f2key(ca[i]) & ~127) | (127 - k), b = (f2key(cb[i]) & ~127) | (127 - k); INS16(L1, a); INS16(L2, b); }
#pragma unroll
            for (int i = 0; i < 16; ++i) { ca[i] = na[i]; cb[i] = nb[i]; }
        }
        float v1[16], v2[16];
#pragma unroll
        for (int i = 0; i < 16; ++i) { v1[i] = key2f(L1[i] & ~127); v2[i] = key2f(L2[i] & ~127); }
        int C[16];
#pragma unroll
        for (int i = 0; i < 16; ++i) C[i] = (int)0x80000000;
#pragma unroll
        for (int a = 0; a < 16; ++a)
#pragma unroll
            for (int b = 0; b < 16; ++b) if ((a + 1) * (b + 1) <= 16) { const int kx = (f2key(v1[a] + v2[b]) & ~255) | (255 - (a * 16 + b)); INS16(C, kx); }
        float tv[16]; int te[16];
#pragma unroll
        for (int i = 0; i < 16; ++i) { const int pos = 255 - (C[i] & 255), a = pos >> 4, b = pos & 15; int ka = 0, kb = 0;
#pragma unroll
            for (int j = 0; j < 16; ++j) { ka = (a == j) ? L1[j] : ka; kb = (b == j) ? L2[j] : kb; }
            te[i] = (127 - (ka & 127)) * 128 + (127 - (kb & 127)); tv[i] = key2f(ka & ~127) + key2f(kb & ~127); }
        float sum = 0.f; const float tmax = tv[0];
#pragma unroll
        for (int i = 0; i < 16; ++i) { tv[i] = fexp2((tv[i] - tmax) * 1.4426950408889634f); sum += tv[i]; }
        const float inv = 1.f / sum;
        int* eo = eidx + (size_t)t * 128 + h * 16; float* go = gw + (size_t)t * 128 + h * 16;
#pragma unroll
        for (int i = 0; i < 16; i += 4) { *(int4*)(eo + i) = make_int4(te[i], te[i + 1], te[i + 2], te[i + 3]); *(f32x4*)(go + i) = (f32x4){tv[i] * inv, tv[i + 1] * inv, tv[i + 2] * inv, tv[i + 3] * inv}; }
    }
}
DEVI void topk_finish(const int (&L1)[16], const int (&L2)[16], int t, int h, int* eidx, float* gw, LAS int* sm = nullptr) {
    float v1[16], v2[16];
#pragma unroll
    for (int i = 0; i < 16; ++i) { v1[i] = key2f(L1[i] & ~127); v2[i] = key2f(L2[i] & ~127); }
#define TK_KX(a, b) ((f2key(v1[a] + v2[b]) & ~255) | (255 - ((a) * 16 + (b))))
    int C[16]; float tv[16]; int te[16];
    if (PEERK_NET && sm) {
        int Y1[16], Y2[16];
#pragma unroll
        for (int b = 0; b < 16; ++b) C[b] = TK_KX(0, b);
#pragma unroll
        for (int b = 0; b < 8; ++b) { Y1[b] = TK_KX(1, b); Y1[8 + b] = TK_KX(15 - b, 0); }
        BM16(Y1);
        Y2[0] = TK_KX(2, 0); Y2[1] = TK_KX(2, 1); Y2[2] = TK_KX(2, 2); Y2[3] = TK_KX(2, 3); Y2[4] = TK_KX(2, 4); Y2[5] = TK_KX(3, 0); Y2[6] = TK_KX(3, 1); Y2[7] = TK_KX(3, 2); Y2[8] = TK_KX(3, 3);
        Y2[9] = TK_KX(4, 0); Y2[10] = TK_KX(4, 1); Y2[11] = TK_KX(4, 2); Y2[12] = TK_KX(5, 0); Y2[13] = TK_KX(5, 1); Y2[14] = TK_KX(6, 0); Y2[15] = TK_KX(6, 1);
        SORT16(Y2);
        MERGE16(C, Y1); MERGE16(C, Y2);
        { const int k0 = TK_KX(7, 0), k1 = TK_KX(7, 1); INS16(C, k0); INS16(C, k1); }
#pragma unroll
        for (int j = 0; j < 16; ++j) { sm[j * 64] = L1[j]; sm[(16 + j) * 64] = L2[j]; }
#pragma unroll
        for (int i = 0; i < 16; ++i) { const int pos = 255 - (C[i] & 255), a = pos >> 4, b = pos & 15; const int ka = sm[a * 64], kb = sm[(16 + b) * 64];
            te[i] = (127 - (ka & 127)) * 128 + (127 - (kb & 127)); tv[i] = key2f(ka & ~127) + key2f(kb & ~127); }
    } else {
#pragma unroll
    for (int i = 0; i < 16; ++i) C[i] = (int)0x80000000;
#pragma unroll
    for (int a = 0; a < 16; ++a)
#pragma unroll
        for (int b = 0; b < 16; ++b) if ((a + 1) * (b + 1) <= 16) { const int kx = TK_KX(a, b); INS16(C, kx); }
#pragma unroll
    for (int i = 0; i < 16; ++i) { const int pos = 255 - (C[i] & 255), a = pos >> 4, b = pos & 15; int ka = 0, kb = 0;
#pragma unroll
        for (int j = 0; j < 16; ++j) { ka = (a == j) ? L1[j] : ka; kb = (b == j) ? L2[j] : kb; }
        te[i] = (127 - (ka & 127)) * 128 + (127 - (kb & 127)); tv[i] = key2f(ka & ~127) + key2f(kb & ~127); }
    }
#undef TK_KX
    float sum = 0.f; const float tmax = tv[0];
#pragma unroll
    for (int i = 0; i < 16; ++i) { tv[i] = fexp2((tv[i] - tmax) * 1.4426950408889634f); sum += tv[i]; }
    const float inv = 1.f / sum;
    int* eo = eidx + (size_t)t * 128 + h * 16; float* go = gw + (size_t)t * 128 + h * 16;
#pragma unroll
    for (int i = 0; i < 16; i += 4) { *(int4*)(eo + i) = make_int4(te[i], te[i + 1], te[i + 2], te[i + 3]); *(f32x4*)(go + i) = (f32x4){tv[i] * inv, tv[i + 1] * inv, tv[i + 2] * inv, tv[i + 3] * inv}; }
}
DEVI void phase_peerk(const P& p, int l, char* lds, int v = -1) {
    const int tid = tid_(), lane = tid & 63, wid = tid >> 6, r32 = lane & 31, hi = lane >> 5;
    constexpr int KP = 136;
    const bf16_t* qp = (const bf16_t*)(WS(p) + OFF_Q); const bf16_t* SK = (const bf16_t*)(WS(p) + OFF_W + (size_t)l * W_LAYER + W_SK);
    int* eidx = (int*)(WS(p) + OFF_EIDX); float* gw = (float*)(WS(p) + OFF_VN);
    const int nit = (v >= 0) ? 2 : (8 * (T_ / 512) - (int)blockIdx.x + (int)gridDim.x - 1) / (int)gridDim.x;
    bf16_t* ks = (bf16_t*)lds;
    for (int it_ = 0; it_ < nit; ++it_) {
        int h, jg; if (v >= 0) pg8::PairOrder::item(v, it_, h, jg); else { const int item = (int)blockIdx.x + it_ * (int)gridDim.x; h = item & 7; jg = item >> 3; }
        const int t0 = jg * 512 + wid * 64;
        __syncthreads();
#pragma unroll
        for (int i = 0; i < 8; ++i) { const int id = tid + i * NTHR, row = id >> 4, c8 = (id & 15) * 8; *(u32x4*)(ks + row * KP + c8) = *(const u32x4*)(SK + (size_t)(h * 256 + row) * 128 + c8); }
        __syncthreads();
        int M0[16], M1[16];
#pragma unroll
        for (int i = 0; i < 16; ++i) { M0[i] = (int)0x80000000; M1[i] = (int)0x80000000; }
#pragma unroll 1
        for (int tile = 0; tile < 2; ++tile) {
            int La[16], Lb[16];
#define PK_HALF(LL, pp) do { \
                _Pragma("unroll") for (int i = 0; i < 16; ++i) LL[i] = (int)0x80000000; \
                const bf16_t* qrow = qp + (size_t)(t0 + tile * 32 + r32) * 2048 + (h * 2 + (pp)) * 128 + hi * 8; \
                const bf16_t* krow = ks + ((pp) * 128 + r32) * KP + hi * 8; \
                bf16x8 qf[8]; \
                _Pragma("unroll") for (int ds = 0; ds < 8; ++ds) qf[ds] = *(const bf16x8*)(qrow + ds * 16); \
                _Pragma("unroll") for (int kp = 0; kp < 2; ++kp) { f32x16 acc0, acc1; \
                    _Pragma("unroll") for (int r = 0; r < 16; ++r) { acc0[r] = 0.f; acc1[r] = 0.f; } \
                    _Pragma("unroll") for (int ds = 0; ds < 8; ++ds) { \
                        acc0 = MFMA32(*(const bf16x8*)(krow + (2 * kp) * 32 * KP + ds * 16), qf[ds], acc0); acc1 = MFMA32(*(const bf16x8*)(krow + (2 * kp + 1) * 32 * KP + ds * 16), qf[ds], acc1); } \
                    if (PEERK_NET) { int K0[16], K1[16]; \
                        _Pragma("unroll") for (int r = 0; r < 16; ++r) { const int kc = 127 - kp * 64 - ((r & 3) + 8 * (r >> 2)) - 4 * hi; K0[r] = (f2key(acc0[r]) & ~127) | kc; K1[r] = (f2key(acc1[r]) & ~127) | (kc - 32); } \
                        SORT16(K0); SORT16(K1); MERGE16(K0, K1); \
                        if (kp == 0) { _Pragma("unroll") for (int i = 0; i < 16; ++i) LL[i] = K0[i]; } else { MERGE16(LL, K0); } \
                    } else { \
                    _Pragma("unroll") for (int r = 0; r < 16; ++r) { const int kc = 127 - kp * 64 - ((r & 3) + 8 * (r >> 2)) - 4 * hi; \
                        { const int a = (f2key(acc0[r]) & ~127) | kc; INS16(LL, a); } { const int a = (f2key(acc1[r]) & ~127) | (kc - 32); INS16(LL, a); } } } \
                    __builtin_amdgcn_sched_barrier(0); } } while (0)
            PK_HALF(La, 0);
            PK_HALF(Lb, 1);
#undef PK_HALF
            int R0[16], R1[16];
#pragma unroll
            for (int i = 0; i < 16; ++i) { R0[i] = xchg32(La[i], hi != 0); R1[i] = xchg32(Lb[i], hi != 0); }
            if (PEERK_NET) { MERGE16(La, R0); MERGE16(Lb, R1); }
            else {
#pragma unroll
            for (int i = 0; i < 16; ++i) { INS16(La, R0[i]); INS16(Lb, R1[i]); } }
            const bool mine = (hi == tile);
#pragma unroll
            for (int i = 0; i < 16; ++i) { M0[i] = mine ? La[i] : M0[i]; M1[i] = mine ? Lb[i] : M1[i]; }
        }
        topk_finish(M0, M1, t0 + hi * 32 + r32, h, eidx, gw);
    }
}
DEVI void phase_peerk2(const P& p, int v, char* lds) {
    const int tid = tid_(), lane = tid & 63, wid = tid >> 6, r32 = lane & 31, hi = lane >> 5;
    const bf16_t* qp = (const bf16_t*)(WS(p) + OFF_Q); int* eidx = (int*)(WS(p) + OFF_EIDX); float* gw = (float*)(WS(p) + OFF_VN);
    for (int it_ = 0; it_ < 2; ++it_) {
        int h, jg; pg8::PairOrder::item(v, it_, h, jg);
        const int t0 = jg * 512 + wid * 64;
        int M0[16], M1[16];
#pragma unroll
        for (int i = 0; i < 16; ++i) { M0[i] = (int)0x80000000; M1[i] = (int)0x80000000; }
#pragma unroll 1
        for (int tile = 0; tile < 2; ++tile) {
            int La[16], Lb[16]; u32x4 wa[8], wb[8];
            { const bf16_t* sp = qp + (size_t)(t0 + tile * 32 + r32) * 2048 + (h * 2) * 128 + hi * 64;
#pragma unroll
              for (int i = 0; i < 8; ++i) { wa[i] = *(const u32x4*)(sp + i * 8); wb[i] = *(const u32x4*)(sp + 128 + i * 8); } }
#define PK2_HALF(LL, W) do { \
                _Pragma("unroll") for (int blk = 0; blk < 4; ++blk) { int K_[16]; \
                    _Pragma("unroll") for (int d = 0; d < 8; ++d) { const unsigned x = W[2 * blk + (d >> 2)][d & 3]; const int ki = hi * 64 + blk * 16 + 2 * d; \
                        K_[2 * d] = (f2key(bflo(x)) & ~127) | (127 - ki); K_[2 * d + 1] = (f2key(bfhi(x)) & ~127) | (126 - ki); } \
                    SORT16(K_); \
                    if (blk == 0) { _Pragma("unroll") for (int i = 0; i < 16; ++i) LL[i] = K_[i]; } else { MERGE16(LL, K_); } } } while (0)
            PK2_HALF(La, wa);
            PK2_HALF(Lb, wb);
#undef PK2_HALF
            int R0[16], R1[16];
#pragma unroll
            for (int i = 0; i < 16; ++i) { R0[i] = xchg32(La[i], hi != 0); R1[i] = xchg32(Lb[i], hi != 0); }
            MERGE16(La, R0); MERGE16(Lb, R1);
            const bool mine = (hi == tile);
#pragma unroll
            for (int i = 0; i < 16; ++i) { M0[i] = mine ? La[i] : M0[i]; M1[i] = mine ? Lb[i] : M1[i]; }
        }
        topk_finish(M0, M1, t0 + hi * 32 + r32, h, eidx, gw, (LAS int*)(lds + wid * 8192) + lane);
    }
}
#if TAB_FP4
typedef u32x2 rowreg_t;
DEVI void cvt16(const u32x2 w, f32x2 (&o)[8]) {
#pragma unroll
    for (int d = 0; d < 2; ++d) { o[4 * d] = __builtin_amdgcn_cvt_scalef32_pk_f32_fp4(w[d], 1.0f, 0); o[4 * d + 1] = __builtin_amdgcn_cvt_scalef32_pk_f32_fp4(w[d], 1.0f, 1);
        o[4 * d + 2] = __builtin_amdgcn_cvt_scalef32_pk_f32_fp4(w[d], 1.0f, 2); o[4 * d + 3] = __builtin_amdgcn_cvt_scalef32_pk_f32_fp4(w[d], 1.0f, 3); }
}
#else
typedef u32x4 rowreg_t;
#endif
DEVI void cvt16(const u32x4 w, f32x2 (&o)[8]) {
#pragma unroll
    for (int i = 0; i < 4; ++i) { o[2 * i] = __builtin_amdgcn_cvt_pk_f32_fp8((int)w[i], false); o[2 * i + 1] = __builtin_amdgcn_cvt_pk_f32_fp8((int)w[i], true); }
}
template <bool DRY> DEVI void phase_gather(const P& p, int l) {
    const int lane = tid_() & 63, wid = tid_() >> 6;
    const bf16_t* h2 = (const bf16_t*)(WS(p) + OFF_H); const int* eidx = (const int*)(WS(p) + OFF_EIDX); const float* gw = (const float*)(WS(p) + OFF_VN);
    const unsigned char* U = WS(p) + OFF_U + (size_t)l * 16384 * ROWB; const unsigned char* V = WS(p) + OFF_V + (size_t)l * 16384 * ROWB;
    const float* SU = (const float*)(WS(p) + OFF_SU) + l * 16384; const float* SV = (const float*)(WS(p) + OFF_SV) + l * 16384;
    const float* g2 = (const float*)(WS(p) + OFF_MOD) + (size_t)l * 2 * 6144 + 5120;
    const bool b5 = (lane & 32) != 0, b4 = (lane & 16) != 0, b3 = (lane & 8) != 0; const int grp = lane >> 3;
    for (int t = blockIdx.x * 8 + wid; t < T_; t += gridDim.x * 8) {
        f32x2 xf[8];
        { const u32x4 a = *(const u32x4*)(h2 + (size_t)t * DM + lane * 16), b = *(const u32x4*)(h2 + (size_t)t * DM + lane * 16 + 8);
#pragma unroll
          for (int j = 0; j < 4; ++j) { xf[j] = (f32x2){bflo(a[j]), bfhi(a[j])}; xf[4 + j] = (f32x2){bflo(b[j]), bfhi(b[j])}; } }
        const int ev0 = eidx[(size_t)t * 128 + lane] & (DRY ? DRY_EMASK : 0x3fff), ev1 = eidx[(size_t)t * 128 + 64 + lane] & (DRY ? DRY_EMASK : 0x3fff);
        const float su0 = SU[ev0], su1 = SU[ev1]; const float gs0 = gw[(size_t)t * 128 + lane] * SV[ev0], gs1 = gw[(size_t)t * 128 + 64 + lane] * SV[ev1];
        f32x2 acc[8];
#pragma unroll
        for (int i = 0; i < 8; ++i) acc[i] = (f32x2){0.f, 0.f};
        rowreg_t ru[8], rv[8];
#define GA_ISSUE(RR, TAB, jbn) do { const int evh_ = ((jbn) < 64) ? ev0 : ev1; const int jl_ = (jbn) & 63; \
            _Pragma("unroll") for (int q = 0; q < 8; ++q) { const int e = __builtin_amdgcn_readlane(evh_, jl_ + q); RR[q] = *(const rowreg_t*)(TAB + (size_t)e * ROWB + lane * (ROWB / 64)); } } while (0)
#define GA_BODY(jb, NEXT) do { \
            const int bidx_ = ((((jb) & 63) + grp) << 2); \
            const float su_ = __int_as_float(__builtin_amdgcn_ds_bpermute(bidx_, __float_as_int(((jb) < 64) ? su0 : su1))); \
            const float gs_ = __int_as_float(__builtin_amdgcn_ds_bpermute(bidx_, __float_as_int(((jb) < 64) ? gs0 : gs1))); \
            float d[8]; \
            _Pragma("unroll") for (int q = 0; q < 8; ++q) { f32x2 uf[8]; cvt16(ru[q], uf); f32x2 s2 = uf[0] * xf[0]; \
                _Pragma("unroll") for (int i = 1; i < 8; ++i) s2 = s2 + uf[i] * xf[i]; \
                d[q] = s2[0] + s2[1]; } \
            if (NEXT) GA_ISSUE(ru, U, (jb) + 8); \
              \
            float e4[4], f2[2], gq; \
            _Pragma("unroll") for (int i = 0; i < 4; ++i) e4[i] = swap32_sum(d[i], d[i + 4]); \
            _Pragma("unroll") for (int i = 0; i < 2; ++i) f2[i] = swap16_sum(e4[i], e4[i + 2]); \
            { const float snd = b3 ? f2[0] : f2[1], kp = b3 ? f2[1] : f2[0]; gq = kp + DPPF(snd, DPP_ROR8); } \
            gq += DPPF(gq, DPP_QX1); gq += DPPF(gq, DPP_QX2); gq += DPPF(gq, DPP_HMIR); \
            const float wq = gs_ * gelu_tanh(gq * su_); \
            _Pragma("unroll") for (int q = 0; q < 8; ++q) { const float w = __uint_as_float((unsigned)__builtin_amdgcn_readlane((int)__float_as_uint(wq), q * 8)); const f32x2 w2 = (f32x2){w, w}; f32x2 vf[8]; cvt16(rv[q], vf); \
                _Pragma("unroll") for (int i = 0; i < 8; ++i) acc[i] = acc[i] + w2 * vf[i]; } \
            if (NEXT) GA_ISSUE(rv, V, (jb) + 8); } while (0)
        GA_ISSUE(ru, U, 0); GA_ISSUE(rv, V, 0);
#pragma unroll 1
        for (int jb = 0; jb < 120; jb += 8) GA_BODY(jb, true);
        GA_BODY(120, false);
#undef GA_ISSUE
#undef GA_BODY
        if (DRY) { if (acc[0][0] == 1.2345e30f) XR(p)[0] = acc[1][0]; continue; }
        float* xp = XR(p) + (size_t)t * DM + lane * 16; const float* gp = g2 + ((t >= S_) ? 6144 : 0) + lane * 16;
        f32x4 xn[4]; float ss = 0.f;
#pragma unroll
        for (int q = 0; q < 4; ++q) { f32x4 xv = *(const f32x4*)(xp + q * 4); const f32x4 gv = *(const f32x4*)(gp + q * 4);
            xv[0] += gv[0] * acc[2 * q][0]; xv[1] += gv[1] * acc[2 * q][1]; xv[2] += gv[2] * acc[2 * q + 1][0]; xv[3] += gv[3] * acc[2 * q + 1][1]; xn[q] = xv;
            ss += xv[0] * xv[0] + xv[1] * xv[1] + xv[2] * xv[2] + xv[3] * xv[3]; }
        ss = wave_sum(ss); const float rs = rsqrtf(ss * (1.f / 1024.f) + 1e-6f);
        if (l + 1 < NL) {
            const float* mn = (const float*)(WS(p) + OFF_MOD) + (size_t)(l + 1) * 2 * 6144 + ((t >= S_) ? 6144 : 0) + lane * 16; bf16_t* hp = (bf16_t*)(WS(p) + OFF_H) + (size_t)t * DM + lane * 16;
#pragma unroll
            for (int q = 0; q < 4; ++q) { *(f32x4*)(xp + q * 4) = xn[q]; const f32x4 sh = *(const f32x4*)(mn + q * 4), sc = *(const f32x4*)(mn + 1024 + q * 4); { const f32x4 hv = xn[q] * rs * (sc + 1.f) + sh; st_bf4(hp + q * 4, hv); if (GATES_FP8) *(unsigned*)(WS(p) + OFF_H8 + (size_t)(hp - (bf16_t*)(WS(p) + OFF_H)) + q * 4) = pk4_fp8(hv); } }
        } else {
            const float* fn = p.final_norm + lane * 16;
#if PROBE_ATTN
            const float rsp = rs * (1.f + 10.f * __uint_as_float(((const unsigned*)(WS(p) + OFF_CTL))[4000]));
#else
            const float rsp = rs;
#endif
#pragma unroll
            for (int q = 0; q < 4; ++q) { const f32x4 g = *(const f32x4*)(fn + q * 4); *(f32x4*)(xp + q * 4) = xn[q] * rsp * g; }
        }
    }
}


#if TAB_FMT == 6 || TAB_FMT == 5 || TAB_FMT == 65 || TAB_FMT == 45
#define DPP_SHL4 0x104
#define DPP_SHR4 0x114
struct RowReg6 { u32x2 a, b, c; };
DEVI void row_load(RowReg6& r, const unsigned char* rowp, int l32) { const unsigned char* q = rowp + l32 * 24; r.a = *(const u32x2*)q; r.b = *(const u32x2*)(q + 8); r.c = *(const u32x2*)(q + 16); }
DEVI void row_decode(const RowReg6& r, f32x2 (&w)[16]) { const u32x6 pk = {r.a[0], r.a[1], r.b[0], r.b[1], r.c[0], r.c[1]}; const f32x32 v = __builtin_amdgcn_cvt_scalef32_pk32_f32_fp6(pk, 1.0f);
#pragma unroll
    for (int i = 0; i < 16; ++i) w[i] = (f32x2){v[2 * i], v[2 * i + 1]}; }
DEVI float row_scale(const RowReg6&) { return 1.f; }
struct RowReg4 { u32x4 d; unsigned short s; };
DEVI void row_load(RowReg4& r, const unsigned char* rowp, int l32) { r.d = *(const u32x4*)(rowp + l32 * 16); r.s = *(const unsigned short*)(rowp + 512 + l32 * 2); }
DEVI void row_decode(const RowReg4& r, f32x2 (&w)[16]) {
#pragma unroll
    for (int d = 0; d < 4; ++d) { w[4 * d] = __builtin_amdgcn_cvt_scalef32_pk_f32_fp4(r.d[d], 1.0f, 0); w[4 * d + 1] = __builtin_amdgcn_cvt_scalef32_pk_f32_fp4(r.d[d], 1.0f, 1);
        w[4 * d + 2] = __builtin_amdgcn_cvt_scalef32_pk_f32_fp4(r.d[d], 1.0f, 2); w[4 * d + 3] = __builtin_amdgcn_cvt_scalef32_pk_f32_fp4(r.d[d], 1.0f, 3); } }
DEVI float row_scale(const RowReg4& r) { return bf2f(r.s); }
struct RowReg4p { u32x4 d; };
DEVI void row_load(RowReg4p& r, const unsigned char* rowp, int l32) { r.d = *(const u32x4*)(rowp + l32 * 16); }
DEVI void row_decode(const RowReg4p& r, f32x2 (&w)[16]) { RowReg4 t; t.d = r.d; t.s = 0; row_decode(t, w); }
DEVI float row_scale(const RowReg4p&) { return 1.f; }
#if TAB_FMT == 45
typedef RowReg4p RowRegU; typedef RowReg4p RowRegV;
#elif TAB_FMT == 6
typedef RowReg6 RowRegU; typedef RowReg6 RowRegV;
#elif TAB_FMT == 65
typedef RowReg6 RowRegU; typedef RowReg4 RowRegV;
#else
typedef RowReg4 RowRegU; typedef RowReg4 RowRegV;
#endif
template <bool DRY> DEVI void phase_gather6(const P& p, int l) {
    const int lane = tid_() & 63, wid = tid_() >> 6, l32 = lane & 31; const bool hi = lane >= 32;
    const bf16_t* h2 = (const bf16_t*)(WS(p) + OFF_H); const int* eidx = (const int*)(WS(p) + OFF_EIDX); const float* gw = (const float*)(WS(p) + OFF_VN);
    const unsigned char* U = WS(p) + OFF_U + (size_t)l * 16384 * ROWB; const unsigned char* V = WS(p) + OFF_V + (size_t)l * 16384 * ROWB_V;
    const float* SU = (const float*)(WS(p) + OFF_SU) + l * 16384; const float* SV = (const float*)(WS(p) + OFF_SV) + l * 16384;
    const float* g2 = (const float*)(WS(p) + OFF_MOD) + (size_t)l * 2 * 6144 + 5120;
    const bool b3 = (lane & 8) != 0, b2 = (lane & 4) != 0; const int quad = lane >> 2;
    constexpr int T_STAT = 24576; unsigned* qctr = (unsigned*)(WS(p) + OFF_CTL) + 3600 + 64 * l;
    int t = blockIdx.x * 8 + wid; int tk_next = -1; bool dyn = false;
    if (t >= T_STAT) { dyn = true; unsigned r = 0u; if (lane == 0) r = atomicAdd(qctr, 1u); t = T_STAT + (int)__builtin_amdgcn_readfirstlane((int)r); }
    for (; t < T_; ) {
        if (DRY) { dyn = false; }
        unsigned tkr = 0u; const bool want = !DRY && (dyn || t + (int)gridDim.x * 8 >= T_STAT);
        if (want && lane == 0) tkr = atomicAdd(qctr, 1u);
#if GATHER_UMFMA && TAB_FMT == 45
        u32x4 hb0[8], hb1[8];
        { const unsigned char* hq0 = WS(p) + OFF_H4P + (size_t)t * 512 + (lane >> 4) * 16; const unsigned char* hq1 = hq0 + (size_t)T_ * 512;
#pragma unroll
          for (int kb = 0; kb < 8; ++kb) { hb0[kb] = *(const u32x4*)(hq0 + kb * 64); hb1[kb] = *(const u32x4*)(hq1 + kb * 64); } }
        const int hs_ = ((const int*)(WS(p) + OFF_HSC))[t]; int sa_ = 127, sb0_ = hs_ & 255, sb1_ = (hs_ >> 8) & 255; asm volatile("" : "+v"(sa_), "+v"(sb0_), "+v"(sb1_));
#else
        f32x2 xf[16];
#pragma unroll
        for (int m4 = 0; m4 < 8; ++m4) { const u32x2 a = *(const u32x2*)(h2 + (size_t)t * DM + CHUNK_COL(l32, m4)); xf[2 * m4] = (f32x2){bflo(a.x), bfhi(a.x)}; xf[2 * m4 + 1] = (f32x2){bflo(a.y), bfhi(a.y)}; }
#endif
        const int ev0 = eidx[(size_t)t * 128 + lane] & (DRY ? DRY_EMASK : 0x3fff), ev1 = eidx[(size_t)t * 128 + 64 + lane] & (DRY ? DRY_EMASK : 0x3fff);
        #if TAB_FMT == 6 || TAB_FMT == 45
        const float su0 = SU[ev0], su1 = SU[ev1]; const float gs0 = gw[(size_t)t * 128 + lane] * SV[ev0], gs1 = gw[(size_t)t * 128 + 64 + lane] * SV[ev1];
#elif TAB_FMT == 65
        const float su0 = SU[ev0], su1 = SU[ev1]; const float gs0 = gw[(size_t)t * 128 + lane], gs1 = gw[(size_t)t * 128 + 64 + lane];
#else
        const float su0 = 1.f, su1 = 1.f; const float gs0 = gw[(size_t)t * 128 + lane], gs1 = gw[(size_t)t * 128 + 64 + lane];
#endif
        float pd1 = 0.f, pd2 = 0.f;
        f32x2 acc[16];
#pragma unroll
        for (int i = 0; i < 16; ++i) acc[i] = (f32x2){0.f, 0.f};
#if GATHER_UMFMA && TAB_FMT == 45
        u32x4 ua[8]; RowRegV rv[8];
#define G6_UISSUE(jbn) do { const int er_ = __builtin_amdgcn_ds_bpermute((((jbn) & 63) + (lane & 15)) << 2, ((jbn) < 64) ? ev0 : ev1); const unsigned char* up_ = U + (size_t)er_ * ROWB + (lane >> 4) * 16; \
            _Pragma("unroll") for (int kb = 0; kb < 8; ++kb) ua[kb] = *(const u32x4*)(up_ + kb * 64); } while (0)
#else
        RowRegU ru[8]; RowRegV rv[8];
#endif
#define G6_ISSUE(RR, TAB, PITCH, jbn) do { const int evh_ = ((jbn) < 64) ? ev0 : ev1; const int jl_ = (jbn) & 63; \
            _Pragma("unroll") for (int q = 0; q < 8; ++q) { const int ea = __builtin_amdgcn_readlane(evh_, jl_ + q), eb = __builtin_amdgcn_readlane(evh_, jl_ + 8 + q); \
                row_load(RR[q], TAB + (size_t)(hi ? eb : ea) * PITCH, l32); } } while (0)
#define G6_PROBE(jb, gqv) do { if (PROBE_UM && l < 3) { \
            const int er_ = __builtin_amdgcn_ds_bpermute((((jb) & 63) + (lane & 15)) << 2, ((jb) < 64) ? ev0 : ev1); const unsigned char* up_ = U + (size_t)er_ * ROWB + (lane >> 4) * 16; \
            const unsigned char* hq0 = WS(p) + OFF_H4P + (size_t)t * 512 + (lane >> 4) * 16; const unsigned char* hq1 = hq0 + (size_t)T_ * 512; \
            const int hs_ = ((const int*)(WS(p) + OFF_HSC))[t]; int sa_ = 127, sb0_ = hs_ & 255, sb1_ = (hs_ >> 8) & 255; asm volatile("" : "+v"(sa_), "+v"(sb0_), "+v"(sb1_)); f32x4 a4_ = (f32x4){0.f, 0.f, 0.f, 0.f}; \
            _Pragma("unroll 1") for (int kb = 0; kb < 8; ++kb) { const u32x4 ua_ = *(const u32x4*)(up_ + kb * 64); const u32x4 b0_ = *(const u32x4*)(hq0 + kb * 64), b1_ = *(const u32x4*)(hq1 + kb * 64); \
                asm volatile("s_nop 7\n\tv_mfma_scale_f32_16x16x128_f8f6f4 %0, %1, %2, %0, %3, %4 op_sel_hi:[0,0,0] cbsz:4 blgp:4\n\ts_nop 15\n\ts_nop 15" : "+v"(a4_) : "v"(ua_), "v"(b0_), "v"(sa_), "v"(sb0_)); \
                asm volatile("s_nop 7\n\tv_mfma_scale_f32_16x16x128_f8f6f4 %0, %1, %2, %0, %3, %4 op_sel_hi:[0,0,0] cbsz:4 blgp:4\n\ts_nop 15\n\ts_nop 15" : "+v"(a4_) : "v"(ua_), "v"(b1_), "v"(sa_), "v"(sb1_)); } \
            const int si_ = (lane >> 2) & 3; const float gm_ = (si_ == 0) ? a4_[0] : (si_ == 1) ? a4_[1] : (si_ == 2) ? a4_[2] : a4_[3]; \
            pd1 += (gm_ - (gqv)) * (gm_ - (gqv)); pd2 += (gqv) * (gqv); } } while (0)
#if GATHER_UMFMA && TAB_FMT == 45
#define G6_MF(ACC, A, B, SB) asm volatile("v_mfma_scale_f32_16x16x128_f8f6f4 %0, %1, %2, %0, %3, %4 op_sel_hi:[0,0,0] cbsz:4 blgp:4" : "+v"(ACC) : "v"(A), "v"(B), "v"(sa_), "v"(SB))
#define G6_MF0(ACC, A, B, SB) asm volatile("v_mfma_scale_f32_16x16x128_f8f6f4 %0, %1, %2, 0, %3, %4 op_sel_hi:[0,0,0] cbsz:4 blgp:4" : "=&v"(ACC) : "v"(A), "v"(B), "v"(sa_), "v"(SB))
#define G6_UDOT(jb, NEXT) do { f32x4 aa_, ab_; \
            G6_MF0(aa_, ua[0], hb0[0], sb0_); G6_MF0(ab_, ua[0], hb1[0], sb1_); \
            _Pragma("unroll") for (int kb = 1; kb < 8; ++kb) { G6_MF(aa_, ua[kb], hb0[kb], sb0_); G6_MF(ab_, ua[kb], hb1[kb], sb1_); } \
            asm volatile("s_nop 15\n\ts_nop 15" ::: "memory"); \
            if (NEXT) G6_UISSUE((jb) + 16); \
            const f32x4 as_ = aa_ + ab_; const int si_ = (lane >> 2) & 3; gq = (si_ == 0) ? as_[0] : (si_ == 1) ? as_[1] : (si_ == 2) ? as_[2] : as_[3]; } while (0)
#else
#define G6_UDOT(jb, NEXT) do { float d[8]; \
            _Pragma("unroll") for (int q = 0; q < 8; ++q) { f32x2 w[16]; row_decode(ru[q], w); f32x2 s2 = w[0] * xf[0]; \
                _Pragma("unroll") for (int i = 1; i < 16; ++i) s2 = s2 + w[i] * xf[i]; \
                d[q] = (s2[0] + s2[1]) * row_scale(ru[q]); } \
            if (NEXT) G6_ISSUE(ru, U, ROWB, (jb) + 16); \
            float f4[4], g2_[2]; \
            _Pragma("unroll") for (int i = 0; i < 4; ++i) f4[i] = swap16_sum(d[i], d[i + 4]);                       \
            _Pragma("unroll") for (int i = 0; i < 2; ++i) { const float snd = b3 ? f4[i] : f4[i + 2], kp = b3 ? f4[i + 2] : f4[i]; g2_[i] = kp + DPPF(snd, DPP_ROR8); }     \
            { const float snd = b2 ? g2_[0] : g2_[1], kp = b2 ? g2_[1] : g2_[0]; const float rl = DPPF(snd, DPP_SHL4), rr_ = DPPF(snd, DPP_SHR4); gq = kp + (b2 ? rr_ : rl); }     \
            gq += DPPF(gq, DPP_QX1); gq += DPPF(gq, DPP_QX2);                                                       \
            } while (0)
#endif
#define G6_BODY(jb, NEXT) do { \
            const int bidx_ = ((((jb) & 63) + quad) << 2); \
            const float su_ = __int_as_float(__builtin_amdgcn_ds_bpermute(bidx_, __float_as_int(((jb) < 64) ? su0 : su1))); \
            const float gs_ = __int_as_float(__builtin_amdgcn_ds_bpermute(bidx_, __float_as_int(((jb) < 64) ? gs0 : gs1))); \
            float gq; \
            G6_UDOT(jb, NEXT); \
            G6_PROBE(jb, gq); \
            const float wq = gs_ * gelu_tanh(gq * su_); \
            _Pragma("unroll") for (int q = 0; q < 8; ++q) { \
                const float wa = __uint_as_float((unsigned)__builtin_amdgcn_readlane((int)__float_as_uint(wq), 4 * q)), wb = __uint_as_float((unsigned)__builtin_amdgcn_readlane((int)__float_as_uint(wq), 32 + 4 * q)); \
                const float w1 = (hi ? wb : wa) * row_scale(rv[q]); const f32x2 w2 = (f32x2){w1, w1}; f32x2 vw[16]; row_decode(rv[q], vw); \
                _Pragma("unroll") for (int i = 0; i < 16; ++i) acc[i] = acc[i] + w2 * vw[i]; } \
            if (NEXT) G6_ISSUE(rv, V, ROWB_V, (jb) + 16); } while (0)
#if GATHER_UMFMA && TAB_FMT == 45
        G6_UISSUE(0); G6_ISSUE(rv, V, ROWB_V, 0);
#else
        G6_ISSUE(ru, U, ROWB, 0); G6_ISSUE(rv, V, ROWB_V, 0);
#endif
#pragma unroll 1
        for (int jb = 0; jb < 112; jb += 16) G6_BODY(jb, true);
        G6_BODY(112, false);
        if (PROBE_UM && l < 3) { pd1 = wave_sum(pd1); pd2 = wave_sum(pd2); if (lane == 0) { atomicAdd((float*)(WS(p) + OFF_CTL) + 4001, pd1); atomicAdd((float*)(WS(p) + OFF_CTL) + 4002, pd2); } }
#undef G6_PROBE
#undef G6_ISSUE
#undef G6_BODY
#undef G6_UDOT
#ifdef G6_UISSUE
#undef G6_UISSUE
#undef G6_MF
#undef G6_MF0
#endif
#define G6_NEXT_TOKEN() do { if (want) { t = T_STAT + (int)__builtin_amdgcn_readfirstlane((int)tkr); dyn = true; } else { t += (int)gridDim.x * 8; } } while (0)
        if (DRY) { if (acc[0][0] == 1.2345e30f) XR(p)[0] = acc[1][0]; t += (int)gridDim.x * 8; continue; }
        f32x2 as[8];
#pragma unroll
        for (int i = 0; i < 8; ++i) { f32x2 lo, hh; lo[0] = swap32_sum(acc[i][0], acc[i][0]); lo[1] = swap32_sum(acc[i][1], acc[i][1]); hh[0] = swap32_sum(acc[8 + i][0], acc[8 + i][0]); hh[1] = swap32_sum(acc[8 + i][1], acc[8 + i][1]);
            as[i] = hi ? hh : lo; }
        const int hq = hi ? 4 : 0;
#define GCOL(q) CHUNK_COL(l32, hq + (q))
        float* xp = XR(p) + (size_t)t * DM; const float* gp = g2 + ((t >= S_) ? 6144 : 0); bf16_t* xbp = (bf16_t*)(WS(p) + OFF_XB) + (size_t)t * DM;
        f32x4 xn[4]; float ss = 0.f;
#pragma unroll
        for (int q = 0; q < 4; ++q) { f32x4 xv = XRES_BF16 ? ld_bf4(xbp + GCOL(q)) : *(const f32x4*)(xp + GCOL(q)); const f32x4 gv = *(const f32x4*)(gp + GCOL(q));
            xv[0] += gv[0] * as[2 * q][0]; xv[1] += gv[1] * as[2 * q][1]; xv[2] += gv[2] * as[2 * q + 1][0]; xv[3] += gv[3] * as[2 * q + 1][1]; xn[q] = xv;
            ss += xv[0] * xv[0] + xv[1] * xv[1] + xv[2] * xv[2] + xv[3] * xv[3]; }
        ss = wave_sum(ss); const float rs = rsqrtf(ss * (1.f / 1024.f) + 1e-6f);
        if (l + 1 < NL) {
            const float* mn = (const float*)(WS(p) + OFF_MOD) + (size_t)(l + 1) * 2 * 6144 + ((t >= S_) ? 6144 : 0); bf16_t* hp = (bf16_t*)(WS(p) + OFF_H) + (size_t)t * DM;
#pragma unroll
            for (int q = 0; q < 4; ++q) { if (XRES_BF16) st_bf4(xbp + GCOL(q), xn[q]); else *(f32x4*)(xp + GCOL(q)) = xn[q]; const f32x4 sh = *(const f32x4*)(mn + GCOL(q)), sc = *(const f32x4*)(mn + 1024 + GCOL(q)); { const f32x4 hv = xn[q] * rs * (sc + 1.f) + sh; st_bf4(hp + GCOL(q), hv); if (GATES_FP8) *(unsigned*)(WS(p) + OFF_H8 + (size_t)t * DM + GCOL(q)) = pk4_fp8(hv); } }
        } else {
            const float* fn = p.final_norm;
#if PROBE_UM
            const float s1_ = ((const float*)(WS(p) + OFF_CTL))[4001], s2_ = ((const float*)(WS(p) + OFF_CTL))[4002];
            const float rsp = rs * (1.f + 10.f * floorf(fminf(sqrtf(s1_ / fmaxf(s2_, 1e-30f)), 4.f) * 64.f + 0.5f) * (1.f / 64.f));
#elif PROBE_ATTN
            const float rsp = rs * (1.f + 10.f * __uint_as_float(((const unsigned*)(WS(p) + OFF_CTL))[4000]));
#else
            const float rsp = rs;
#endif
#pragma unroll
            for (int q = 0; q < 4; ++q) { const f32x4 g = *(const f32x4*)(fn + GCOL(q)); *(f32x4*)(xp + GCOL(q)) = xn[q] * rsp * g; }
        }
#undef GCOL
        G6_NEXT_TOKEN();
    }
}
#endif

#if PROBE_ATTN
DEVI void dsincos(double ang, double& s, double& c) {
    const double rev = ang * 0.15915494309189535; const double x = (rev - rint(rev)) * 6.283185307179586; const double x2 = x * x;
    double ts = x, tc = 1.0; s = x; c = 1.0;
    for (int n = 1; n <= 14; ++n) { tc *= -x2 / (double)((2 * n - 1) * (2 * n)); c += tc; ts *= -x2 / (double)((2 * n) * (2 * n + 1)); s += ts; }
}
DEVI void phase_attn_check(const P& p, char* lds) {
    const int lane = tid_() & 63, wid = tid_() >> 6;
    const int TS[24] = {0, 1, 2, 31, 32, 33, 63, 64, 65, 127, 128, 255, 256, 257, 511, 1000, 2047, 4096, 5000, 8191, 8192, 12345, 16382, 16383};
    const bf16_t* z = (const bf16_t*)(WS(p) + OFF_Z); const bf16_t* Qb = (const bf16_t*)(WS(p) + OFF_Q); const bf16_t* Kb = (const bf16_t*)(WS(p) + OFF_K);
    const bf16_t* Vb = (const bf16_t*)(WS(p) + OFF_VV); const bf16_t* Yb = (const bf16_t*)(WS(p) + OFF_CAT) + CAT_YB; unsigned* errw = (unsigned*)(WS(p) + OFF_CTL) + 4000;
    float* qs = (float*)lds + wid * 128;
    for (int v = blockIdx.x * 8 + wid; v < 16 * 24; v += gridDim.x * 8) {
        const int bh = v / 24, b = bh >> 3, h = bh & 7; int t = 0;
#pragma unroll
        for (int i = 0; i < 24; ++i) if (v % 24 == i) t = TS[i];
        const size_t tq = (size_t)b * S_ + t;
        float ss = 0.f; for (int i = lane; i < 384; i += 64) { const float a = bf2f(z[tq * ZC + Z_CQ + i]); ss += a * a; }
        ss = wave_sum(ss); const float rs = 1.0f / sqrtf(ss / 384.f + 1e-6f);
        qs[lane] = bf2f(Qb[tq * 768 + h * 96 + lane]) * rs; if (lane < 32) qs[64 + lane] = bf2f(Qb[tq * 768 + h * 96 + 64 + lane]) * rs;
        asm volatile("s_waitcnt lgkmcnt(0)" ::: "memory");
        if (lane < 16) { const float* rp_ = (const float*)(WS(p) + OFF_ROPE) + tq * 32; const float cs = rp_[lane], sn = rp_[16 + lane]; const float x1 = qs[64 + lane], x2 = qs[80 + lane];
            qs[64 + lane] = x1 * (float)cs - x2 * (float)sn; qs[80 + lane] = x2 * (float)cs + x1 * (float)sn; }
        asm volatile("s_waitcnt lgkmcnt(0)" ::: "memory");
        float mx = -1e30f;
        for (int pass = 0; pass < 2; ++pass) {
            float lsum = 0.f, o[16];
#pragma unroll
            for (int d = 0; d < 16; ++d) o[d] = 0.f;
            const float mglob = mx;
            for (int s = lane; s <= t; s += 64) {
                const size_t ts_ = (size_t)b * S_ + s; float dot = 0.f;
                for (int d = 0; d < 64; ++d) dot += qs[d] * bf2f(Kb[ts_ * 768 + h * 96 + d]);
                for (int i = 0; i < 16; ++i) { const float* rp_ = (const float*)(WS(p) + OFF_ROPE) + ts_ * 32; const float cs = rp_[i], sn = rp_[16 + i];
                    const float x1 = bf2f(z[ts_ * ZC + Z_KR + i]), x2 = bf2f(z[ts_ * ZC + Z_KR + 16 + i]);
                    dot += qs[64 + i] * (x1 * (float)cs - x2 * (float)sn) + qs[80 + i] * (x2 * (float)cs + x1 * (float)sn); }
                dot *= 0.10206207261596577f;
                if (pass == 0) mx = fmaxf(mx, dot);
                else { const float pr = expf(dot - mglob); lsum += pr;
#pragma unroll
                    for (int d = 0; d < 16; ++d) o[d] += pr * bf2f(Vb[ts_ * 512 + h * 64 + 4 * d]); }
            }
            if (pass == 0) {
#pragma unroll
                for (int of = 32; of > 0; of >>= 1) mx = fmaxf(mx, __shfl_xor(mx, of));
            } else {
                lsum = wave_sum(lsum); float emax = 0.f, r2 = 0.f;
#pragma unroll
                for (int d = 0; d < 16; ++d) { const float ref = wave_sum(o[d]) / lsum; const float got = bf2f(Yb[tq * 1024 + h * 64 + 4 * d]); emax = fmaxf(emax, fabsf(got - ref)); r2 += ref * ref; }
                const float rel = emax / (sqrtf(r2 / 16.f) + 1e-20f);
                if (lane == 0) atomicMax(errw, __float_as_uint((rel == rel) ? fminf(fmaxf(rel, 0.f), 4.f) : 3.0f));
            }
        }
    }
}
#endif

#define XB_TMO      128
#define XB_XCNT(j)  (256  + 64 * (j))
#define XB_XSUB(j)  (1280 + 64 * (j))
#define XB_XGEN(j)  (2304 + 64 * (j))
#define XB_TOP      3328
#define XB_TOPGEN   3392
#define XCD_BAR_WORDS 3456
#define XB_SPIN_CAP (1u << 18)

__device__ __forceinline__ unsigned xb_ld(unsigned* p)              { return __hip_atomic_load(p, __ATOMIC_RELAXED, __HIP_MEMORY_SCOPE_AGENT); }
__device__ __forceinline__ unsigned xb_add(unsigned* p, unsigned v) { return __hip_atomic_fetch_add(p, v, __ATOMIC_RELAXED, __HIP_MEMORY_SCOPE_AGENT); }
__device__ __forceinline__ unsigned xb_xcc_id() { return (unsigned)__builtin_amdgcn_s_getreg((3 << 11) | 20) & 0xFu; }
#define XB_SPIN(cond, bar) do { unsigned _sp = 0; while (cond) { __builtin_amdgcn_s_sleep(1); \
    if ((++_sp & 255u) == 0u) { if (xb_ld(&(bar)[XB_TMO])) break; if (_sp > XB_SPIN_CAP) { atomicAdd(&(bar)[XB_TMO], 1u); break; } } } } while (0)

struct XcdBarrier {
    unsigned* bar; unsigned x;
    volatile LAS unsigned* st;
};

__device__ __forceinline__ XcdBarrier xcd_barrier_post(unsigned* bar, volatile LAS unsigned* st) {
    XcdBarrier b; b.bar = bar; b.x = xb_xcc_id(); b.st = st;
    if (threadIdx.x == 0) (void)xb_add(&bar[XB_XCNT(b.x)], 1u);
    return b;
}
__device__ __forceinline__ void xcd_barrier_complete(unsigned* bar, unsigned x, unsigned& nloc, unsigned& nx) {
    const unsigned G = gridDim.x * gridDim.y * gridDim.z;
    unsigned sum, cnt, mine, sp = 0u;
    for (;;) {
        sum = 0u; cnt = 0u; mine = 0u;
#pragma unroll
        for (unsigned j = 0; j < 16; ++j) { const unsigned c = xb_ld(&bar[XB_XCNT(j)]); sum += c; cnt += (c > 0u) ? 1u : 0u; mine = (j == x) ? c : mine; }
        if (sum == G) break;
        __builtin_amdgcn_s_sleep(1);
        if ((++sp & 255u) == 0u) { if (xb_ld(&bar[XB_TMO])) break; if (sp > XB_SPIN_CAP) { atomicAdd(&bar[XB_TMO], 1u); break; } }
    }
    nloc = mine > 0u ? mine : 1u; nx = cnt > 0u ? cnt : 1u;
}

__device__ __forceinline__ void xcd_barrier(const XcdBarrier& b) {
    asm volatile("s_waitcnt vmcnt(0)" ::: "memory");
    __syncthreads();
    if (threadIdx.x == 0) {
        unsigned* bar = b.bar;
        __builtin_amdgcn_s_waitcnt(0);
        unsigned nloc = b.st[0], nx = b.st[1];
        if (nloc == 0u) { xcd_barrier_complete(bar, b.x, nloc, nx); b.st[0] = nloc; b.st[1] = nx; }
        const unsigned old = xb_add(&bar[XB_XSUB(b.x)], 1u);
        const unsigned gen = old / nloc;
        if (old + 1u == (gen + 1u) * nloc) {
            __builtin_amdgcn_fence(__ATOMIC_RELEASE, "agent");
            asm volatile("s_waitcnt vmcnt(0)" ::: "memory");
            const unsigned og = xb_add(&bar[XB_TOP], 1u);
            const unsigned tg = og / nx;
            if (og + 1u == (tg + 1u) * nx) xb_add(&bar[XB_TOPGEN], 1u);
            else XB_SPIN(xb_ld(&bar[XB_TOPGEN]) == tg, bar);
            __builtin_amdgcn_fence(__ATOMIC_ACQUIRE, "agent");
            xb_add(&bar[XB_XGEN(b.x)], 1u);
            asm volatile("s_waitcnt vmcnt(0)" ::: "memory");
        } else {
            XB_SPIN(xb_ld(&bar[XB_XGEN(b.x)]) == gen, bar);
            __builtin_amdgcn_fence(__ATOMIC_ACQUIRE, "agent");
            asm volatile("s_waitcnt vmcnt(0)" ::: "memory");
        }
    }
    __syncthreads();
}

enum { PH_PRO = 0, PH_NORM1, PH_GIN, PH_POST, PH_MIX_QKV, PH_ATTN, PH_MERGE, PH_WO, PH_NORM2, PH_PQ, PH_SC, PH_TOPK, PH_GATHER, PH_FINAL, PH_CHECK, PH_PEERK, PH_PQK };
template <int PH> DEVI void run_phase(const P& p, int l, char* lds) {
    l = opaque_i32(l);
    const unsigned char* wl = WS(p) + OFF_W + (size_t)l * W_LAYER; const float* mod = (const float*)(WS(p) + OFF_MOD) + (size_t)l * 2 * 6144;
    if constexpr (PH == PH_PRO) phase_prologue(p, lds);
    if constexpr (PH == PH_NORM1) phase_norm(p, p.x, mod + 0, mod + 1024, true);
    if constexpr (PH == PH_GIN) {
        if (GATES_FP8) {
            { EpiZ e{(bf16_t*)(WS(p) + OFF_Z)}; gemm256_phase((const bf16_t*)(WS(p) + OFF_H), DM, (const bf16_t*)(wl + W_INT), 1024, T_, Z_G, 1024, lds, e); }
            { EpiZG e{(bf16_t*)(WS(p) + OFF_Z)}; gemm256_phase_f8(WS(p) + OFF_H8, 1024, wl + W_G8, 1024, T_, 3072, 1024, lds, e); }
        } else { EpiZ e{(bf16_t*)(WS(p) + OFF_Z)}; gemm256_phase((const bf16_t*)(WS(p) + OFF_H), DM, (const bf16_t*)(wl + W_INT), 1024, T_, ZC, 1024, lds, e); }
    }
    if constexpr (PH == PH_POST) phase_post(p);
    if constexpr (PH == PH_MIX_QKV) {
        phase_mixa(p, l, lds);
        { EpiBf e{(bf16_t*)(WS(p) + OFF_Q), 768}; gemm256_phase((const bf16_t*)(WS(p) + OFF_Z) + Z_CQ, ZC, (const bf16_t*)(wl + W_UQ), 384, T_, 768, 384, lds, e); }
        { EpiKV e{(bf16_t*)(WS(p) + OFF_K), (bf16_t*)(WS(p) + OFF_VV), (const float*)(WS(p) + OFF_RS) + T_}; gemm256_phase((const bf16_t*)(WS(p) + OFF_Z) + Z_CKV, ZC, (const bf16_t*)(wl + W_UKV), 256, T_, 1024, 256, lds, e); }
    }
    if constexpr (PH == PH_ATTN) phase_attn(p, lds);
#ifndef MERGE_SIMPLE
#define MERGE_SIMPLE 0
#endif
    if constexpr (PH == PH_MERGE) {
        if (MERGE_SIMPLE) phase_merge(p, l, lds);
        else { const bf16_t* zg = (const bf16_t*)(WS(p) + OFF_Z) + Z_G; EpiMergeLast e{(bf16_t*)(WS(p) + OFF_H), zg + 2048}; pg8::GateSeg sg{zg, ZC, 1024, 4, 12};
            gemm256_phase_seg((const bf16_t*)(WS(p) + OFF_CAT), 1024, (const bf16_t*)(wl + W_A), 1024, T_, 1024, 1024, lds, e, sg); }
    }
    if constexpr (PH == PH_WO) {
        if (XRES_BF16) { bf16_t* xb = (bf16_t*)(WS(p) + OFF_XB); EpiWoB e{(l == 0) ? p.x : nullptr, xb, xb, mod + 2048}; gemm256_phase((const bf16_t*)(WS(p) + OFF_H), DM, (const bf16_t*)(wl + W_O), 1024, T_, 1024, 1024, lds, e); }
        else { EpiWo e{(l == 0) ? p.x : (const float*)XR(p), XR(p), mod + 2048}; gemm256_phase((const bf16_t*)(WS(p) + OFF_H), DM, (const bf16_t*)(wl + W_O), 1024, T_, 1024, 1024, lds, e); } }
    if constexpr (PH == PH_NORM2) phase_norm(p, XR(p), mod + 3072, mod + 4096, false, XRES_BF16 ? (const bf16_t*)(WS(p) + OFF_XB) : nullptr, (PROBE_UM != 0) || (GATHER_UMFMA != 0));
    if constexpr (PH == PH_PQ) { EpiBf e{(bf16_t*)(WS(p) + OFF_Q), 2048}; gemm256_phase((const bf16_t*)(WS(p) + OFF_H), DM, (const bf16_t*)(wl + W_PQ), 1024, T_, 2048, 1024, lds, e); }
    if constexpr (PH == PH_SC) { EpiScT e{(float*)(WS(p) + OFF_Z)}; gemm_phase((const bf16_t*)(WS(p) + OFF_Q), 2048, 128, (const bf16_t*)(wl + W_SK), 128, T_, 2048, 128, lds, e); }
    if constexpr (PH == PH_TOPK) phase_topk(p);
    if constexpr (PH == PH_PEERK) phase_peerk(p, l, lds);
    if constexpr (PH == PH_PQK) {
        for (int v = (int)blockIdx.x; v < 256; v += (int)gridDim.x) {
            { EpiBf e{(bf16_t*)(WS(p) + OFF_Q), 2048}; gemm256_pair((const bf16_t*)(WS(p) + OFF_H), DM, (const bf16_t*)(wl + W_PQ), 1024, T_, 2048, 1024, lds, e, v); }
            asm volatile("s_waitcnt vmcnt(0)" ::: "memory"); __syncthreads(); __builtin_amdgcn_fence(__ATOMIC_ACQUIRE, "agent");
            if (PQ_FOLD) phase_peerk2(p, v, lds); else phase_peerk(p, l, lds, v);
        }
    }
#if TAB_FMT == 6 || TAB_FMT == 5 || TAB_FMT == 65 || TAB_FMT == 45
    if constexpr (PH == PH_GATHER) phase_gather6<false>(p, l);
    if constexpr (PH == PH_GATHER + 100) phase_gather6<true>(p, l);
#else
    if constexpr (PH == PH_GATHER) phase_gather<false>(p, l);
    if constexpr (PH == PH_GATHER + 100) phase_gather<true>(p, l);
#endif
    if constexpr (PH == PH_FINAL) phase_final(p);
#if PROBE_ATTN
    if constexpr (PH == PH_CHECK) phase_attn_check(p, lds);
#endif
}
#ifndef MEGA
#define MEGA 1
#endif
#if MEGA
__global__ void __launch_bounds__(NTHR, 2) k_mega(P p) {
    extern __shared__ __attribute__((aligned(16))) char lds[];
    if (threadIdx.x == 0) *(u32x4*)(lds + LDS_BYTES - 16) = (u32x4){0u, 0u, 0u, 0u};
    ctx_init(p, lds);
    __syncthreads();
    (void)xcd_barrier_post((unsigned*)(p.ws + OFF_CTL), (volatile LAS unsigned*)(lds + LDS_BYTES - 16));
#define GRID_BARRIER() do { XcdBarrier b_; b_.bar = (unsigned*)(WS(p) + OFF_CTL); b_.x = xb_xcc_id(); b_.st = (volatile LAS unsigned*)(lds + LDS_BYTES - 16); xcd_barrier(b_); } while (0)
    run_phase<PH_PRO>(p, 0, lds); GRID_BARRIER();
    if (DUP_MASK & 1) { run_phase<PH_PRO>(p, 0, lds); GRID_BARRIER(); }
    if (DUP_MASK & 0x10000) { for (int i = 0; i < 48; ++i) GRID_BARRIER(); }
#pragma unroll 1
    for (int l = 0; l < NL; ++l) {
        if (l == 0) { run_phase<PH_NORM1>(p, l, lds); GRID_BARRIER(); }
        run_phase<PH_GIN>(p, l, lds); GRID_BARRIER();
        if (DUP_MASK & (1 << PH_GIN)) { run_phase<PH_GIN>(p, l, lds); GRID_BARRIER(); }
        run_phase<PH_POST>(p, l, lds); GRID_BARRIER();
        if (DUP_MASK & (1 << PH_POST)) { run_phase<PH_POST>(p, l, lds); GRID_BARRIER(); }
        run_phase<PH_MIX_QKV>(p, l, lds); GRID_BARRIER();
        if (DUP_MASK & (1 << PH_MIX_QKV)) { run_phase<PH_MIX_QKV>(p, l, lds); GRID_BARRIER(); }
        run_phase<PH_ATTN>(p, l, lds); GRID_BARRIER();
#if PROBE_ATTN
        if (l == 1) { phase_attn_check(p, lds); GRID_BARRIER(); }
#endif
        if (DUP_MASK & (1 << PH_ATTN)) { run_phase<PH_ATTN>(p, l, lds); GRID_BARRIER(); }
        run_phase<PH_MERGE>(p, l, lds); GRID_BARRIER();
        if (DUP_MASK & (1 << PH_MERGE)) { run_phase<PH_MERGE>(p, l, lds); GRID_BARRIER(); }
        run_phase<PH_WO>(p, l, lds); GRID_BARRIER();
        run_phase<PH_NORM2>(p, l, lds); GRID_BARRIER();
        if (DUP_MASK & (1 << PH_NORM2)) { run_phase<PH_NORM2>(p, l, lds); GRID_BARRIER(); }
#if FUSE_PQK
        run_phase<PH_PQK>(p, l, lds); GRID_BARRIER();
#else
        run_phase<PH_PQ>(p, l, lds); GRID_BARRIER();
        if (DUP_MASK & (1 << PH_PQ)) { run_phase<PH_PQ>(p, l, lds); GRID_BARRIER(); }
        run_phase<PH_PEERK>(p, l, lds); GRID_BARRIER();
#endif
        if (DUP_MASK & (1 << PH_TOPK)) { run_phase<PH_PEERK>(p, l, lds); GRID_BARRIER(); }
        run_phase<PH_GATHER>(p, l, lds); GRID_BARRIER();
        if (DUP_MASK & (1 << PH_GATHER)) { run_phase<PH_GATHER + 100>(p, l, lds); GRID_BARRIER(); }
    }
}
#else
template <int PH> __global__ void __launch_bounds__(NTHR, 2) k_phase(P p, int l) {
    extern __shared__ __attribute__((aligned(16))) char lds[];
    ctx_init(p, lds); __syncthreads();
    run_phase<PH>(p, l, lds);
}
template <int PH> static void launch_phase(const P& p, int l, hipStream_t stream) {
    static bool attr = false;
    if (!attr) { (void)hipFuncSetAttribute((const void*)k_phase<PH>, hipFuncAttributeMaxDynamicSharedMemorySize, LDS_BYTES); attr = true; }
    hipLaunchKernelGGL(k_phase<PH>, dim3(256), dim3(NTHR), LDS_BYTES, stream, p, l);
}
#endif

extern "C" void kernel_launch(void* const* d_in, const int* in_sizes, int n_in, void* d_out, int out_size, void* d_ws, size_t ws_size, hipStream_t stream) {
    P p{};
    p.x = (const float*)d_in[0]; p.c = (const float*)d_in[1]; p.pos = (const int*)d_in[2];
    p.w_mod = (const float*)d_in[3]; p.b_mod = (const float*)d_in[4]; p.w_in = (const float*)d_in[5]; p.w_s = (const float*)d_in[6]; p.b_s = (const float*)d_in[7];
    p.q_norm = (const float*)d_in[8]; p.w_uq = (const float*)d_in[9]; p.kv_norm = (const float*)d_in[10]; p.w_ukv = (const float*)d_in[11]; p.w_pool = (const float*)d_in[12];
    p.pool_scale = (const float*)d_in[13]; p.w_a = (const float*)d_in[14]; p.w_b = (const float*)d_in[15]; p.w_c = (const float*)d_in[16]; p.w_o = (const float*)d_in[17];
    p.w_pq = (const float*)d_in[18]; p.sub_keys = (const float*)d_in[19]; p.u_tab = (const float*)d_in[20]; p.v_tab = (const float*)d_in[21]; p.final_norm = (const float*)d_in[22];
    p.xr = (float*)d_out; p.ws = (unsigned char*)d_ws;
    for (int i = 0; i < 16; ++i) p.invf[i] = (double)(float)(1.0 / pow(10000.0, (double)(2 * i) / 32.0));
#if MEGA
    static int grid = 0;
    if (!grid) {
        (void)hipFuncSetAttribute((const void*)k_mega, hipFuncAttributeMaxDynamicSharedMemorySize, LDS_BYTES);
        int dev = 0, cus = 0, per_cu = 0;
        (void)hipGetDevice(&dev); (void)hipDeviceGetAttribute(&cus, hipDeviceAttributeMultiprocessorCount, dev);
        (void)hipOccupancyMaxActiveBlocksPerMultiprocessor(&per_cu, (const void*)k_mega, NTHR, LDS_BYTES);
        if (cus <= 0) cus = 256;
        grid = cus * (per_cu < 1 ? 1 : 1);
    }
    (void)hipMemsetAsync(p.ws + OFF_CTL, 0, 16384, stream);
    hipLaunchKernelGGL(k_mega, dim3(grid), dim3(NTHR), LDS_BYTES, stream, p);
#else
    (void)hipMemsetAsync(p.ws + OFF_CTL, 0, 16384, stream);
    launch_phase<PH_PRO>(p, 0, stream);
    for (int l = 0; l < NL; ++l) {
        if (l == 0) launch_phase<PH_NORM1>(p, l, stream); launch_phase<PH_GIN>(p, l, stream); launch_phase<PH_POST>(p, l, stream); launch_phase<PH_MIX_QKV>(p, l, stream);
        launch_phase<PH_ATTN>(p, l, stream); if (PROBE_ATTN && l == 1) launch_phase<PH_CHECK>(p, l, stream); launch_phase<PH_MERGE>(p, l, stream); launch_phase<PH_WO>(p, l, stream); launch_phase<PH_NORM2>(p, l, stream);
        launch_phase<PH_PQ>(p, l, stream); launch_phase<PH_PEERK>(p, l, stream); launch_phase<PH_GATHER>(p, l, stream);
    }
#endif
}
```

```cpp
#include <hip/hip_runtime.h>
#include <stdint.h>
#include <math.h>

#ifndef PROBE_ATTN
#define PROBE_ATTN 0
#endif
#ifndef DUP_MASK
#define DUP_MASK 0
#endif
#ifndef FUSE_PQK
#define FUSE_PQK 1
#endif
#ifndef PEERK_NET
#define PEERK_NET 1
#endif
#ifndef PROBE_UM
#define PROBE_UM 0
#endif
#ifndef GATHER_UMFMA
#define GATHER_UMFMA 1
#endif
#ifndef PQ_FOLD
#define PQ_FOLD 1
#endif
#ifndef GATES_ST8
#define GATES_ST8 1
#endif
#ifndef XRES_BF16
#define XRES_BF16 1
#endif
#ifndef GATES_FP8
#define GATES_FP8 1
#endif
#ifndef DRY_EMASK
#define DRY_EMASK 0x3fff
#endif
#ifndef EPI_PERM
#define EPI_PERM 1
#endif
#define DEVI __device__ __forceinline__
typedef unsigned short bf16_t;
typedef short bf16x8 __attribute__((ext_vector_type(8)));
typedef short s16x4 __attribute__((ext_vector_type(4)));
typedef float f32x4 __attribute__((ext_vector_type(4)));
typedef float f32x2 __attribute__((ext_vector_type(2)));
typedef float f32x16 __attribute__((ext_vector_type(16)));
typedef unsigned u32x4 __attribute__((ext_vector_type(4)));
typedef unsigned u32x2 __attribute__((ext_vector_type(2)));
typedef __bf16 bf16x2_t __attribute__((ext_vector_type(2)));
typedef float f32x32 __attribute__((ext_vector_type(32)));
typedef unsigned u32x6 __attribute__((ext_vector_type(6)));
#define LAS __attribute__((address_space(3)))

constexpr int T_ = 32768, S_ = 16384, DM = 1024, NL = 4;
constexpr int ZC = 4608;
constexpr int Z_U = 0, Z_V = 256, Z_CQ = 512, Z_CKV = 896, Z_P = 1152, Z_KR = 1408, Z_G = 1536;
constexpr int NTHR = 512;
constexpr int LDS_BYTES = 147456;
constexpr float C2F = 0.14724445f;

constexpr size_t al256(size_t x) { return (x + 255) & ~(size_t)255; }
constexpr size_t OFF_CTL = 0;
constexpr size_t OFF_MOD = 16384;
constexpr size_t OFF_ROPE = OFF_MOD + al256((size_t)NL * 2 * 6144 * 4);
constexpr size_t OFF_W = OFF_ROPE + al256((size_t)T_ * 32 * 4);
constexpr size_t W_INT = 0;
constexpr size_t W_UQ = W_INT + (size_t)ZC * 1024 * 2;
constexpr size_t W_UKV = W_UQ + (size_t)768 * 384 * 2;
constexpr size_t W_A = W_UKV + (size_t)1024 * 256 * 2;
constexpr size_t W_B = W_A + (size_t)1024 * 256 * 2;
constexpr size_t W_C = W_B + (size_t)1024 * 512 * 2;
constexpr size_t W_O = W_C + (size_t)1024 * 256 * 2;
constexpr size_t W_PQ = W_O + (size_t)1024 * 1024 * 2;
constexpr size_t W_SK = W_PQ + (size_t)2048 * 1024 * 2;
constexpr size_t W_S = W_SK + (size_t)16 * 128 * 128 * 2;
constexpr size_t W_G8 = W_S + (size_t)4 * 128 * 128 * 2;
constexpr size_t W_LAYER = W_G8 + (size_t)3072 * 1024;
#ifndef TAB_FMT
#define TAB_FMT 45
#endif
#define TAB_FP4 (TAB_FMT == 4)
constexpr int ROWB = (TAB_FMT == 4 || TAB_FMT == 45) ? 512 : TAB_FMT == 5 ? 576 : (TAB_FMT == 6 || TAB_FMT == 65) ? 768 : 1024;
constexpr int ROWB_V = TAB_FMT == 65 ? 576 : ROWB;
#define CHUNK_COL(l32, m4) ((TAB_FMT == 5 || TAB_FMT == 45) ? ((m4) * 128 + 4 * (l32)) : ((l32) * 32 + 4 * (m4)))
constexpr size_t OFF_U = OFF_W + NL * W_LAYER;
constexpr size_t OFF_V = OFF_U + (size_t)NL * 16384 * ROWB;
constexpr size_t OFF_SU = OFF_V + (size_t)NL * 16384 * ROWB;
constexpr size_t OFF_SV = OFF_SU + (size_t)NL * 16384 * 4;
constexpr size_t OFF_H = OFF_SV + (size_t)NL * 16384 * 4;
constexpr size_t OFF_Z = OFF_H + (size_t)T_ * 1024 * 2;
constexpr size_t OFF_VN = OFF_Z + (size_t)T_ * ZC * 2;
constexpr size_t OFF_PRE = OFF_VN + (size_t)T_ * 256 * 2;
constexpr size_t OFF_YA = OFF_PRE + (size_t)T_ * 256 * 2;
constexpr size_t OFF_YB = OFF_YA + (size_t)T_ * 256 * 2;
constexpr size_t OFF_CAT = OFF_PRE;
constexpr int CAT_YA = 0, CAT_YB = 256, CAT_PRE = 768;
constexpr size_t OFF_EIDX = OFF_YA;
constexpr size_t OFF_RS = OFF_YB + (size_t)T_ * 512 * 2;
constexpr size_t OFF_Q = OFF_RS + (size_t)T_ * 2 * 4;
constexpr size_t OFF_K = OFF_Q + (size_t)T_ * 768 * 2;
constexpr size_t OFF_VV = OFF_K + (size_t)T_ * 768 * 2;
constexpr size_t OFF_H8 = OFF_VV + (size_t)T_ * 512 * 2;
constexpr size_t OFF_XB = OFF_H8 + (size_t)T_ * 1024;
constexpr size_t OFF_H4P = OFF_XB + (size_t)T_ * 1024 * 2;
constexpr size_t OFF_HSC = OFF_H4P + (size_t)2 * T_ * 512;
constexpr size_t OFF_END = OFF_HSC + (size_t)T_ * 4;
static_assert(OFF_END <= ((size_t)1 << 30), "workspace map exceeds 1 GiB");

struct P {
    const float *x, *c; const int* pos;
    const float *w_mod, *b_mod, *w_in, *w_s, *b_s, *q_norm, *w_uq, *kv_norm, *w_ukv, *w_pool, *pool_scale, *w_a, *w_b, *w_c, *w_o, *w_pq, *sub_keys, *u_tab, *v_tab, *final_norm;
    float* xr;
    unsigned char* ws;
    double invf[16];
};

DEVI unsigned cvtpk(float lo, float hi) { f32x2 v = {lo, hi}; bf16x2_t b = __builtin_convertvector(v, bf16x2_t); return __builtin_bit_cast(unsigned, b); }
DEVI bf16_t f2bf(float f) { return (bf16_t)(cvtpk(f, 0.f) & 0xffffu); }
DEVI float bf2f(bf16_t b) { return __uint_as_float(((unsigned)b) << 16); }
DEVI float bflo(unsigned w) { return __uint_as_float(w << 16); }
DEVI float bfhi(unsigned w) { return __uint_as_float(w & 0xffff0000u); }
DEVI unsigned pk4_fp8(f32x4 v) { int pk = 0; pk = __builtin_amdgcn_cvt_pk_fp8_f32(v[0], v[1], pk, false); pk = __builtin_amdgcn_cvt_pk_fp8_f32(v[2], v[3], pk, true); return (unsigned)pk; }
DEVI float fexp2(float x) { return __builtin_amdgcn_exp2f(x); }
DEVI float frcp(float x) { return __builtin_amdgcn_rcpf(x); }
DEVI float sigmoidf_(float x) { return frcp(1.f + fexp2(-1.4426950408889634f * x)); }
DEVI float gelu_tanh(float x) { const float u = 0.7978845608028654f * (x + 0.044715f * x * x * x); return x * frcp(1.f + fexp2(-2.8853900817779268f * u)); }
#define DPPF(v, ctrl) __int_as_float(__builtin_amdgcn_update_dpp(0, __float_as_int(v), (ctrl), 0xf, 0xf, true))
#define DPP_QX1 0xB1
#define DPP_QX2 0x4E
#define DPP_HMIR 0x141
#define DPP_MIR 0x140
#define DPP_ROR8 0x128
DEVI float swap16_sum(float a, float b) { auto r = __builtin_amdgcn_permlane16_swap(__float_as_uint(a), __float_as_uint(b), false, false); return __uint_as_float(r[0]) + __uint_as_float(r[1]); }
DEVI float swap32_sum(float a, float b) { auto r = __builtin_amdgcn_permlane32_swap(__float_as_uint(a), __float_as_uint(b), false, false); return __uint_as_float(r[0]) + __uint_as_float(r[1]); }
DEVI float wave_sum(float v) {
    v += DPPF(v, DPP_QX1); v += DPPF(v, DPP_QX2); v += DPPF(v, DPP_HMIR); v += DPPF(v, DPP_MIR);
    v = swap16_sum(v, v); return swap32_sum(v, v);
}
DEVI int xchg32(int v, bool hi) { auto r = __builtin_amdgcn_permlane32_swap((unsigned)v, (unsigned)v, false, false); return (int)(hi ? r[0] : r[1]); }
DEVI int tid_() { int t = threadIdx.x; asm volatile("" : "+v"(t)); return t; }
DEVI unsigned long long opaque_u64(unsigned long long v) { unsigned lo = (unsigned)v, hi = (unsigned)(v >> 32); asm volatile("" : "+v"(lo), "+v"(hi));
    lo = __builtin_amdgcn_readfirstlane(lo); hi = __builtin_amdgcn_readfirstlane(hi); return ((unsigned long long)hi << 32) | lo; }
DEVI int opaque_i32(int v) { asm volatile("" : "+v"(v)); return __builtin_amdgcn_readfirstlane(v); }
DEVI unsigned long long ctx_u64(int slot) { extern __shared__ __attribute__((aligned(16))) char lds_ctx_[]; volatile LAS unsigned* q = (volatile LAS unsigned*)(lds_ctx_ + LDS_BYTES - 48 + slot * 8);
    const unsigned lo = q[0], hi = q[1]; return ((unsigned long long)(unsigned)__builtin_amdgcn_readfirstlane((int)hi) << 32) | (unsigned)__builtin_amdgcn_readfirstlane((int)lo); }
DEVI void ctx_init(const P& p, char* lds) { if (threadIdx.x == 0) { *(unsigned long long*)(lds + LDS_BYTES - 48) = (unsigned long long)p.ws; *(unsigned long long*)(lds + LDS_BYTES - 40) = (unsigned long long)p.xr; } }
typedef __attribute__((address_space(1))) unsigned char* g_u8p;
DEVI unsigned char* WS(const P&) { return (unsigned char*)(g_u8p)ctx_u64(0); }
DEVI float* XR(const P&) { return (float*)(g_u8p)ctx_u64(1); }
#define MFMA16(a, b, c) __builtin_amdgcn_mfma_f32_16x16x32_bf16(a, b, c, 0, 0, 0)
#define MFMA32(a, b, c) __builtin_amdgcn_mfma_f32_32x32x16_bf16(a, b, c, 0, 0, 0)

constexpr int GP = 64;
DEVI void gemm_kloop(f32x4 (&acc)[4][4], const bf16_t* __restrict__ Ap, int lda, const bf16_t* __restrict__ Bp, int ldb, int K, char* lds) {
    const int tid = tid_(), lane = tid & 63, wid = tid >> 6, wm = wid >> 1, wn = wid & 1, fr = lane & 15, fq = lane >> 4;
    bf16_t* const As0 = (bf16_t*)lds; bf16_t* const Bs0 = As0 + 256 * GP; bf16_t* const As1 = Bs0 + 128 * GP; bf16_t* const Bs1 = As1 + 256 * GP;
    const int nt = K >> 6;
    const int sr = tid >> 3, sc = (tid & 7) * 8, scw = ((tid & 7) ^ (sr & 7)) * 8;
    const bf16_t* ag = Ap + (size_t)sr * lda + sc; const bf16_t* bg = Bp + (size_t)sr * ldb + sc;
    const int fx = fr & 7;
    u32x4 ra[4], rb[2];
#define G_LOAD(kt) do { _Pragma("unroll") for (int i_ = 0; i_ < 4; ++i_) ra[i_] = *(const u32x4*)(ag + (size_t)(i_ * 64) * lda + (kt) * 64); \
                        _Pragma("unroll") for (int i_ = 0; i_ < 2; ++i_) rb[i_] = *(const u32x4*)(bg + (size_t)(i_ * 64) * ldb + (kt) * 64); } while (0)
#define G_WRITE(As, Bs) do { _Pragma("unroll") for (int i_ = 0; i_ < 4; ++i_) *(u32x4*)((As) + (sr + i_ * 64) * GP + scw) = ra[i_]; \
                             _Pragma("unroll") for (int i_ = 0; i_ < 2; ++i_) *(u32x4*)((Bs) + (sr + i_ * 64) * GP + scw) = rb[i_]; } while (0)
    __syncthreads();
    G_LOAD(0); G_WRITE(As0, Bs0);
    __syncthreads();
    for (int kt = 0; kt < nt; ++kt) {
        const bf16_t* As = (kt & 1) ? As1 : As0; const bf16_t* Bs = (kt & 1) ? Bs1 : Bs0;
        if (kt + 1 < nt) G_LOAD(kt + 1);
#pragma unroll
        for (int kk = 0; kk < 2; ++kk) {
            bf16x8 af[4], bfr[4]; const int ch = ((kk * 4 + fq) ^ fx) * 8;
#pragma unroll
            for (int m = 0; m < 4; ++m) af[m] = *(const bf16x8*)(As + (wm * 64 + m * 16 + fr) * GP + ch);
#pragma unroll
            for (int n = 0; n < 4; ++n) bfr[n] = *(const bf16x8*)(Bs + (wn * 64 + n * 16 + fr) * GP + ch);
#pragma unroll
            for (int m = 0; m < 4; ++m)
#pragma unroll
                for (int n = 0; n < 4; ++n) acc[m][n] = MFMA16(bfr[n], af[m], acc[m][n]);
        }
        if (kt + 1 < nt) { if (kt & 1) G_WRITE(As0, Bs0); else G_WRITE(As1, Bs1); }
        __syncthreads();
    }
#undef G_LOAD
#undef G_WRITE
}
DEVI void acc_zero(f32x4 (&acc)[4][4]) {
#pragma unroll
    for (int m = 0; m < 4; ++m)
#pragma unroll
        for (int n = 0; n < 4; ++n) acc[m][n] = (f32x4){0.f, 0.f, 0.f, 0.f};
}
template <class Epi>
DEVI void gemm_phase(const bf16_t* A, int lda, int a_pn_stride, const bf16_t* Bt, int ldb, int M, int N, int K, char* lds, const Epi& epi) {
    const int nn = N >> 7, nu = (M >> 8) * nn;
    const int lane = tid_() & 63, wid = tid_() >> 6, wm = wid >> 1, wn = wid & 1, fr = lane & 15, fq = lane >> 4;
    for (int u = blockIdx.x; u < nu; u += gridDim.x) {
        const int pm = u / nn, pn = u - pm * nn;
        f32x4 acc[4][4]; acc_zero(acc);
        gemm_kloop(acc, A + (size_t)pm * 256 * lda + (size_t)pn * a_pn_stride, lda, Bt + (size_t)pn * 128 * ldb, ldb, K, lds);
#pragma unroll
        for (int m = 0; m < 4; ++m)
#pragma unroll
            for (int n = 0; n < 4; ++n) epi(pm * 256 + wm * 64 + m * 16 + fr, pn * 128 + wn * 64 + n * 16 + 4 * fq, acc[m][n]);
    }
}
DEVI void st_bf4(bf16_t* p, f32x4 v) { u32x2 w; w.x = cvtpk(v[0], v[1]); w.y = cvtpk(v[2], v[3]); *(u32x2*)p = w; }
DEVI f32x4 ld_bf4(const bf16_t* p) { const u32x2 w = *(const u32x2*)p; return (f32x4){bflo(w.x), bfhi(w.x), bflo(w.y), bfhi(w.y)}; }
DEVI void st_bf8(bf16_t* p, f32x4 a, f32x4 b) { u32x4 w; w.x = cvtpk(a[0], a[1]); w.y = cvtpk(a[2], a[3]); w.z = cvtpk(b[0], b[1]); w.w = cvtpk(b[2], b[3]); *(u32x4*)p = w; }

struct EpiZ { bf16_t* z;
    DEVI void operator()(int row, int col, f32x4 v) const {
        if (col < Z_CQ) { v[0] = gelu_tanh(v[0]); v[1] = gelu_tanh(v[1]); v[2] = gelu_tanh(v[2]); v[3] = gelu_tanh(v[3]); }
        else if (col >= Z_G) { v[0] = sigmoidf_(v[0]); v[1] = sigmoidf_(v[1]); v[2] = sigmoidf_(v[2]); v[3] = sigmoidf_(v[3]); }
        st_bf4(z + (size_t)row * ZC + col, v); }
    DEVI void v8(int row, int col, f32x4 a, f32x4 b) const {
#pragma unroll
        for (int i = 0; i < 4; ++i) { if (col < Z_CQ) { a[i] = gelu_tanh(a[i]); b[i] = gelu_tanh(b[i]); } else if (col >= Z_G) { a[i] = sigmoidf_(a[i]); b[i] = sigmoidf_(b[i]); } }
        st_bf8(z + (size_t)row * ZC + col, a, b); } };
struct EpiZG { bf16_t* z;
    DEVI void operator()(int row, int col, f32x4 v) const {
#pragma unroll
        for (int i = 0; i < 4; ++i) v[i] = frcp(1.f + fexp2(-0.022542110013889f * v[i]));
        st_bf4(z + (size_t)row * ZC + Z_G + col, v); }
    DEVI void v8(int row, int col, f32x4 a, f32x4 b) const {
#pragma unroll
        for (int i = 0; i < 4; ++i) { a[i] = frcp(1.f + fexp2(-0.022542110013889f * a[i])); b[i] = frcp(1.f + fexp2(-0.022542110013889f * b[i])); }
        if (GATES_ST8) { u32x2 w; w.x = pk4_fp8(a * 256.f); w.y = pk4_fp8(b * 256.f); *(u32x2*)((unsigned char*)(z + (size_t)row * ZC + Z_G) + col) = w; }
        else st_bf8(z + (size_t)row * ZC + Z_G + col, a, b); } };
struct EpiBf { bf16_t* o; int ldo;
    DEVI void operator()(int row, int col, f32x4 v) const { st_bf4(o + (size_t)row * ldo + col, v); }
    DEVI void v8(int row, int col, f32x4 a, f32x4 b) const { st_bf8(o + (size_t)row * ldo + col, a, b); } };
struct EpiKV { bf16_t* k; bf16_t* v_; const float* rs;
    DEVI void operator()(int row, int col, f32x4 v) const {
        const float s = rs[row]; v = v * s; const int h = col >> 7, c = col & 127;
        if (c < 64) st_bf4(k + (size_t)row * 768 + h * 96 + c, v); else st_bf4(v_ + (size_t)row * 512 + h * 64 + (c - 64), v); }
    DEVI void v8(int row, int col, f32x4 a, f32x4 b) const {
        const float s = rs[row]; a = a * s; b = b * s; const int h = col >> 7, c = col & 127;
        if (c < 64) st_bf8(k + (size_t)row * 768 + h * 96 + c, a, b); else st_bf8(v_ + (size_t)row * 512 + h * 64 + (c - 64), a, b); } };
struct EpiWo { const float* xin; float* x; const float* g;
    DEVI void operator()(int row, int col, f32x4 v) const {
        const float* gp = g + (row >= S_ ? 6144 : 0) + col; float* xp = x + (size_t)row * DM + col;
        f32x4 xv = *(const f32x4*)(xin + (size_t)row * DM + col); const f32x4 gv = *(const f32x4*)gp; xv = xv + gv * v; *(f32x4*)xp = xv; }
    DEVI void v8(int row, int col, f32x4 a, f32x4 b) const {
        const float* gp = g + (row >= S_ ? 6144 : 0) + col; float* xp = x + (size_t)row * DM + col; const float* xi = xin + (size_t)row * DM + col;
        f32x4 x0 = *(const f32x4*)xi, x1 = *(const f32x4*)(xi + 4); const f32x4 g0 = *(const f32x4*)gp, g1 = *(const f32x4*)(gp + 4);
        x0 = x0 + g0 * a; x1 = x1 + g1 * b; *(f32x4*)xp = x0; *(f32x4*)(xp + 4) = x1; } };
struct EpiWoB { const float* xin32; const bf16_t* xinb; bf16_t* xo; const float* g;
    DEVI void operator()(int row, int col, f32x4 v) const {
        const float* gp = g + (row >= S_ ? 6144 : 0) + col; const f32x4 gv = *(const f32x4*)gp;
        f32x4 xv = xin32 ? *(const f32x4*)(xin32 + (size_t)row * DM + col) : ld_bf4(xinb + (size_t)row * DM + col); st_bf4(xo + (size_t)row * DM + col, xv + gv * v); }
    DEVI void v8(int row, int col, f32x4 a, f32x4 b) const {
        const float* gp = g + (row >= S_ ? 6144 : 0) + col; const f32x4 g0 = *(const f32x4*)gp, g1 = *(const f32x4*)(gp + 4); f32x4 x0, x1;
        if (xin32) { const float* xi = xin32 + (size_t)row * DM + col; x0 = *(const f32x4*)xi; x1 = *(const f32x4*)(xi + 4); }
        else { const u32x4 w = *(const u32x4*)(xinb + (size_t)row * DM + col); x0 = (f32x4){bflo(w.x), bfhi(w.x), bflo(w.y), bfhi(w.y)}; x1 = (f32x4){bflo(w.z), bfhi(w.z), bflo(w.w), bfhi(w.w)}; }
        st_bf8(xo + (size_t)row * DM + col, x0 + g0 * a, x1 + g1 * b); } };
struct EpiMergeLast { bf16_t* mg; const bf16_t* gate;
    DEVI void operator()(int row, int col, f32x4 v) const { const f32x4 g = ld_bf4(gate + (size_t)row * ZC + col); st_bf4(mg + (size_t)row * DM + col, g * v); }
    DEVI void v8(int row, int col, f32x4 a, f32x4 b) const {
        if (GATES_ST8) { const u32x2 w = *(const u32x2*)((const unsigned char*)(gate + (size_t)row * ZC) + col);
            const f32x2 g01 = __builtin_amdgcn_cvt_pk_f32_fp8((int)w.x, false), g23 = __builtin_amdgcn_cvt_pk_f32_fp8((int)w.x, true), g45 = __builtin_amdgcn_cvt_pk_f32_fp8((int)w.y, false), g67 = __builtin_amdgcn_cvt_pk_f32_fp8((int)w.y, true);
            const f32x4 g0 = (f32x4){g01[0], g01[1], g23[0], g23[1]} * (1.f / 256.f), g1 = (f32x4){g45[0], g45[1], g67[0], g67[1]} * (1.f / 256.f); st_bf8(mg + (size_t)row * DM + col, g0 * a, g1 * b); }
        else { const u32x4 w = *(const u32x4*)(gate + (size_t)row * ZC + col);
        const f32x4 g0 = (f32x4){bflo(w.x), bfhi(w.x), bflo(w.y), bfhi(w.y)}, g1 = (f32x4){bflo(w.z), bfhi(w.z), bflo(w.w), bfhi(w.w)}; st_bf8(mg + (size_t)row * DM + col, g0 * a, g1 * b); } } };
struct EpiScT { float* s;
    DEVI void operator()(int row, int col, f32x4 v) const {
#pragma unroll
        for (int i = 0; i < 4; ++i) s[(size_t)(col + i) * T_ + row] = v[i]; } };

namespace pg8 {
#define PG8_LAS __attribute__((address_space(3)))
constexpr int BM = 256, BK = 64, HALF = 128, HTB = HALF * BK * 2  , STAGE_BYTES = 8 * HTB, NXCD = 8, WGM = 8;

__host__ __device__ __forceinline__ int lds_byte(int r, int c) { const int st = (r >> 4) * 2 + (c >> 5), rr = r & 15, cc = c & 31, ob = rr * 64 + cc * 2; return st * 1024 + (ob ^ (((ob >> 9) & 1) << 5)); }
__host__ __device__ __forceinline__ void stage_rc(int b, int& R, int& C) { const int st = b / 1024, sb = b % 1024, swz = sb ^ (((sb >> 9) & 1) << 5); R = (st >> 1) * 16 + swz / 64; C = (st & 1) * 32 + (swz % 64) / 2; }
__host__ __device__ __forceinline__ int perm32(int rho) { const int n = rho >> 4, i = rho & 15; return 8 * (i >> 2) + 4 * n + (i & 3); }
struct Unit { int pm, pn; };
struct Gemm { const bf16_t* A; const bf16_t* Bt; int M, N, K, lda, ldb; };
struct StaticOrder {
    int nM, nN, nwg, G, c;
    __host__ __device__ void init(int M, int N, int G_, int c_) { nM = M / BM; nN = N / BM; nwg = nM * nN; G = G_; c = c_; }
    __host__ __device__ bool next(int i, Unit& u) const {
        const long L = (long)i * G + c; if (L >= nwg) return false;
        int wgid = (int)L; { const int q = nwg / NXCD, r = nwg % NXCD, xcd = wgid % NXCD, off = wgid / NXCD; wgid = (xcd < r ? xcd * (q + 1) : r * (q + 1) + (xcd - r) * q) + off; }
        const int nig = WGM * nN, gid = wgid / nig, fm = gid * WGM, gsz = (nM - fm) < WGM ? (nM - fm) : WGM;
        u.pm = fm + ((wgid % nig) % gsz); u.pn = (wgid % nig) / gsz; return true;
    }
    __device__ __forceinline__ void a_ready(const Unit&) const {}
    __device__ __forceinline__ void done(const Unit&) const {}
};
struct PairOrder { int v;
    __host__ __device__ static void item(int v, int i, int& h, int& j) { const int idx = (v >> 3) * 2 + i; h = idx & 7; j = (v & 7) + 8 * (idx >> 3); }
    __host__ __device__ bool next(int i, Unit& u) const { if (i >= 4) return false; int h, j; item(v, i >> 1, h, j); u.pm = 2 * j + (i & 1); u.pn = h; return true; }
    __device__ __forceinline__ void a_ready(const Unit&) const {}
    __device__ __forceinline__ void done(const Unit&) const {}
};
template <class F> struct EpiAd { static constexpr bool PERM = (EPI_PERM != 0), AFTER_DRAIN = false; F f;
    __device__ __forceinline__ void operator()(const f32x4 (&acc)[2][2][4][2], const Unit& u, int wr, int wc, int fr, int fq) const {
#pragma unroll
        for (int ai = 0; ai < 2; ++ai)
#pragma unroll
            for (int m = 0; m < 4; ++m)
#pragma unroll
                for (int bj = 0; bj < 2; ++bj) {
                    if constexpr (PERM) f.v8(u.pm * BM + ai * HALF + wr * 64 + m * 16 + fr, u.pn * BM + bj * HALF + wc * 32 + 8 * fq, acc[ai][bj][m][0], acc[ai][bj][m][1]);
                    else {
#pragma unroll
                        for (int n = 0; n < 2; ++n) f(u.pm * BM + ai * HALF + wr * 64 + m * 16 + fr, u.pn * BM + bj * HALF + wc * 32 + n * 16 + 4 * fq, acc[ai][bj][m][n]); }
                }
    } };
struct NoSeg { static constexpr bool ON = false; };
struct GateSeg { static constexpr bool ON = true; const bf16_t* gate; int ldg, gstride, t0, t1;
#if EPI_PERM
    __device__ __forceinline__ void rescale(f32x4 (&acc)[2][2][4][2], const Unit& u, int s, int wr, int wc, int fr, int fq) const {
        const bf16_t* g0 = gate + (size_t)(u.pm * BM + wr * 64 + fr) * ldg + (size_t)s * gstride + u.pn * BM + wc * 32 + 8 * fq;
#if GATES_ST8
        const unsigned char* g8 = (const unsigned char*)(gate + (size_t)(u.pm * BM + wr * 64 + fr) * ldg) + (size_t)s * 1024 + u.pn * BM + wc * 32 + 8 * fq;
        u32x2 ga[2][2][2], gb[2][2][2];
#define PG8_GLOAD(bf, ai, mh) do { _Pragma("unroll") for (int mm = 0; mm < 2; ++mm) _Pragma("unroll") for (int bj = 0; bj < 2; ++bj) { \
            const unsigned char* gp = g8 + (size_t)((ai) * HALF + (2 * (mh) + mm) * 16) * ldg * 2 + bj * HALF; ga[bf][mm][bj] = *(const u32x2*)gp; gb[bf][mm][bj] = *(const u32x2*)(gp + 1024); } } while (0)
#define PG8_GR(x, y) ((x) * __builtin_amdgcn_rcpf(__builtin_fmaxf((y), 1e-20f)))
#define PG8_GMUL(bf, ai, mh) do { _Pragma("unroll") for (int mm = 0; mm < 2; ++mm) _Pragma("unroll") for (int bj = 0; bj < 2; ++bj) { \
            const u32x2 a_ = ga[bf][mm][bj], b_ = gb[bf][mm][bj]; f32x4& c0 = acc[ai][bj][2 * (mh) + mm][0]; f32x4& c1 = acc[ai][bj][2 * (mh) + mm][1]; \
            const f32x2 a01 = __builtin_amdgcn_cvt_pk_f32_fp8((int)a_.x, false), a23 = __builtin_amdgcn_cvt_pk_f32_fp8((int)a_.x, true), a45 = __builtin_amdgcn_cvt_pk_f32_fp8((int)a_.y, false), a67 = __builtin_amdgcn_cvt_pk_f32_fp8((int)a_.y, true); \
            const f32x2 b01 = __builtin_amdgcn_cvt_pk_f32_fp8((int)b_.x, false), b23 = __builtin_amdgcn_cvt_pk_f32_fp8((int)b_.x, true), b45 = __builtin_amdgcn_cvt_pk_f32_fp8((int)b_.y, false), b67 = __builtin_amdgcn_cvt_pk_f32_fp8((int)b_.y, true); \
            c0[0] *= PG8_GR(a01[0], b01[0]); c0[1] *= PG8_GR(a01[1], b01[1]); c0[2] *= PG8_GR(a23[0], b23[0]); c0[3] *= PG8_GR(a23[1], b23[1]); \
            c1[0] *= PG8_GR(a45[0], b45[0]); c1[1] *= PG8_GR(a45[1], b45[1]); c1[2] *= PG8_GR(a67[0], b67[0]); c1[3] *= PG8_GR(a67[1], b67[1]); } } while (0)
#else
        u32x4 ga[2][2][2], gb[2][2][2];
#define PG8_GLOAD(bf, ai, mh) do { _Pragma("unroll") for (int mm = 0; mm < 2; ++mm) _Pragma("unroll") for (int bj = 0; bj < 2; ++bj) { \
            const bf16_t* gp = g0 + (size_t)((ai) * HALF + (2 * (mh) + mm) * 16) * ldg + bj * HALF; ga[bf][mm][bj] = *(const u32x4*)gp; gb[bf][mm][bj] = *(const u32x4*)(gp + gstride); } } while (0)
#define PG8_GR(x, y) ((x) * __builtin_amdgcn_rcpf(__builtin_fmaxf((y), 1e-20f)))
#define PG8_GMUL(bf, ai, mh) do { _Pragma("unroll") for (int mm = 0; mm < 2; ++mm) _Pragma("unroll") for (int bj = 0; bj < 2; ++bj) { \
            const u32x4 a_ = ga[bf][mm][bj], b_ = gb[bf][mm][bj]; f32x4& c0 = acc[ai][bj][2 * (mh) + mm][0]; f32x4& c1 = acc[ai][bj][2 * (mh) + mm][1]; \
            c0[0] *= PG8_GR(bflo(a_.x), bflo(b_.x)); c0[1] *= PG8_GR(bfhi(a_.x), bfhi(b_.x)); c0[2] *= PG8_GR(bflo(a_.y), bflo(b_.y)); c0[3] *= PG8_GR(bfhi(a_.y), bfhi(b_.y)); \
            c1[0] *= PG8_GR(bflo(a_.z), bflo(b_.z)); c1[1] *= PG8_GR(bfhi(a_.z), bfhi(b_.z)); c1[2] *= PG8_GR(bflo(a_.w), bflo(b_.w)); c1[3] *= PG8_GR(bfhi(a_.w), bfhi(b_.w)); } } while (0)
#endif
        PG8_GLOAD(0, 0, 0); __builtin_amdgcn_sched_barrier(0);
        PG8_GLOAD(1, 0, 1); __builtin_amdgcn_sched_barrier(0); PG8_GMUL(0, 0, 0); __builtin_amdgcn_sched_barrier(0);
        PG8_GLOAD(0, 1, 0); __builtin_amdgcn_sched_barrier(0); PG8_GMUL(1, 0, 1); __builtin_amdgcn_sched_barrier(0);
        PG8_GLOAD(1, 1, 1); __builtin_amdgcn_sched_barrier(0); PG8_GMUL(0, 1, 0); __builtin_amdgcn_sched_barrier(0);
        PG8_GMUL(1, 1, 1); __builtin_amdgcn_sched_barrier(0);
#undef PG8_GLOAD
#undef PG8_GR
#undef PG8_GMUL
    }
#else
    __device__ __forceinline__ void rescale(f32x4 (&acc)[2][2][4][2], const Unit& u, int s, int wr, int wc, int fr, int fq) const {
        const bf16_t* g0 = gate + (size_t)(u.pm * BM + wr * 64 + fr) * ldg + (size_t)s * gstride + u.pn * BM + wc * 32 + 4 * fq;
#pragma unroll
        for (int ai = 0; ai < 2; ++ai)
#pragma unroll
            for (int mh = 0; mh < 2; ++mh) {
                u32x2 ga[2][4], gb[2][4];
#pragma unroll
                for (int mm = 0; mm < 2; ++mm)
#pragma unroll
                    for (int q = 0; q < 4; ++q) { const bf16_t* gp = g0 + (size_t)(ai * HALF + (2 * mh + mm) * 16) * ldg + (q >> 1) * HALF + (q & 1) * 16;
                        ga[mm][q] = *(const u32x2*)gp; gb[mm][q] = *(const u32x2*)(gp + gstride); }
                __builtin_amdgcn_sched_barrier(0);
#pragma unroll
                for (int mm = 0; mm < 2; ++mm)
#pragma unroll
                    for (int q = 0; q < 4; ++q) { f32x4& a = acc[ai][q >> 1][2 * mh + mm][q & 1];
                        a[0] *= bflo(ga[mm][q].x) * __builtin_amdgcn_rcpf(__builtin_fmaxf(bflo(gb[mm][q].x), 1e-20f)); a[1] *= bfhi(ga[mm][q].x) * __builtin_amdgcn_rcpf(__builtin_fmaxf(bfhi(gb[mm][q].x), 1e-20f));
                        a[2] *= bflo(ga[mm][q].y) * __builtin_amdgcn_rcpf(__builtin_fmaxf(bflo(gb[mm][q].y), 1e-20f)); a[3] *= bfhi(ga[mm][q].y) * __builtin_amdgcn_rcpf(__builtin_fmaxf(bfhi(gb[mm][q].y), 1e-20f)); }
                __builtin_amdgcn_sched_barrier(0);
            }
    }
#endif
};
template <class Epi, class Sched, bool ALIGN_EPI = false, bool SP2 = false, class Seg = NoSeg, bool F8 = false>
__device__ __forceinline__ void gemm_phase(PG8_LAS unsigned char* lds, const Gemm g, const Sched& S, const Epi& E, const Seg& SG = Seg()) {
    const int tid = tid_(), wid = __builtin_amdgcn_readfirstlane(tid >> 6), lane = tid & 63, wr = wid >> 2, wc = wid & 3, fr = lane & 15, fq = lane >> 4;
    const int K = g.K, nt = K / BK, lda = g.lda, ldb = g.ldb;
    unsigned voffA[2], voffB[2];
#pragma unroll
    for (int i = 0; i < 2; ++i) { int R, C; stage_rc(tid * 16 + i * 8192, R, C); const int Rb = Epi::PERM ? ((R & ~31) + perm32(R & 31)) : R;
        voffA[i] = (unsigned)(R * lda + C) * 2u; voffB[i] = (unsigned)(Rb * ldb + C) * 2u; }
    const size_t kstep = (size_t)(BK * 2);
    const size_t hstepA = (size_t)HALF * lda * 2, hstepB = (size_t)HALF * ldb * 2;
    const size_t tstepA = 2 * hstepA, tstepB = 2 * hstepB;
    const unsigned ldsw = (unsigned)wid * 1024u;
    const int aoff = lds_byte(wr * 64 + fr, fq * 8), boff = lds_byte(wc * 32 + fr, fq * 8);
    const int a8o0 = lds_byte(wr * 64 + fr, (fq & 1) * 16) + (fq >> 1) * 1024, a8o1 = lds_byte(wr * 64 + fr, (fq & 1) * 16 + 8) + (fq >> 1) * 1024;
    const int b8o0 = lds_byte(wc * 32 + fr, (fq & 1) * 16) + (fq >> 1) * 1024, b8o1 = lds_byte(wc * 32 + fr, (fq & 1) * 16 + 8) + (fq >> 1) * 1024;
    typedef int i32x8 __attribute__((ext_vector_type(8))); typedef int i32x4 __attribute__((ext_vector_type(4)));
    int sc1_ = 127; asm volatile("" : "+v"(sc1_));
#define PG8_SA(b, h) (((b) * 2 + (h)) * HTB)
#define PG8_SB(b, h) ((4 + (b) * 2 + (h)) * HTB)
#define PG8_STAGE(bufoff, gbase, voff) do { _Pragma("unroll") for (int _i = 0; _i < 2; ++_i) \
        __builtin_amdgcn_global_load_lds((const unsigned*)((const char*)(gbase) + (voff)[_i]), (PG8_LAS unsigned*)(lds + (bufoff) + ldsw + _i * 8192), 16, 0, 0); } while (0)
#define PG8_LD8(off) (*(const PG8_LAS i32x4*)(lds + (off)))
#define PG8_LDA(dst, b, h) do { if constexpr (F8) { _Pragma("unroll") for (int m = 0; m < 4; ++m) dst##8[m] = __builtin_shufflevector(PG8_LD8(PG8_SA(b, h) + a8o0 + m * 2048), PG8_LD8(PG8_SA(b, h) + a8o1 + m * 2048), 0, 1, 2, 3, 4, 5, 6, 7); } \
        else { _Pragma("unroll") for (int m = 0; m < 4; ++m) _Pragma("unroll") for (int k = 0; k < 2; ++k) dst[m][k] = *(const PG8_LAS bf16x8*)(lds + PG8_SA(b, h) + aoff + m * 2048 + k * 1024); } } while (0)
#define PG8_LDB(dst, b, h) do { if constexpr (F8) { _Pragma("unroll") for (int n = 0; n < 2; ++n) dst##8[n] = __builtin_shufflevector(PG8_LD8(PG8_SB(b, h) + b8o0 + n * 2048), PG8_LD8(PG8_SB(b, h) + b8o1 + n * 2048), 0, 1, 2, 3, 4, 5, 6, 7); } \
        else { _Pragma("unroll") for (int n = 0; n < 2; ++n) _Pragma("unroll") for (int k = 0; k < 2; ++k) dst[n][k] = *(const PG8_LAS bf16x8*)(lds + PG8_SB(b, h) + boff + n * 2048 + k * 1024); } } while (0)
#define PG8_MMA(ai, bj, At, Bt) do { __builtin_amdgcn_s_setprio(1); \
        if constexpr (F8) { _Pragma("unroll") for (int m = 0; m < 4; ++m) _Pragma("unroll") for (int n = 0; n < 2; ++n) \
            asm volatile("v_mfma_scale_f32_16x16x128_f8f6f4 %0, %1, %2, %0, %3, %3 op_sel_hi:[0,0,0]" : "+v"(acc[ai][bj][m][n]) : "v"(Bt##8[n]), "v"(At##8[m]), "v"(sc1_)); } \
        else { _Pragma("unroll") for (int m = 0; m < 4; ++m) _Pragma("unroll") for (int n = 0; n < 2; ++n) _Pragma("unroll") for (int k = 0; k < 2; ++k) \
            acc[ai][bj][m][n] = __builtin_amdgcn_mfma_f32_16x16x32_bf16(Bt[n][k], At[m][k], acc[ai][bj][m][n], 0, 0, 0); } \
        __builtin_amdgcn_s_setprio(0); } while (0)
#define PG8_WAIT_V(n) asm volatile("s_waitcnt vmcnt(" #n ")" ::: "memory")
#define PG8_WAIT_L(n) asm volatile("s_waitcnt lgkmcnt(" #n ")" ::: "memory")
#define PG8_BAR __builtin_amdgcn_s_barrier()
#define PG8_SCHED __builtin_amdgcn_sched_barrier(0)
    Unit cur, nxt; int ui = 0;
    if (!S.next(0, cur)) return;
    f32x4 acc[2][2][4][2];
#pragma unroll
    for (int a = 0; a < 2; ++a)
#pragma unroll
        for (int b = 0; b < 2; ++b)
#pragma unroll
            for (int m = 0; m < 4; ++m)
#pragma unroll
                for (int n = 0; n < 2; ++n) acc[a][b][m][n] = (f32x4){0.f, 0.f, 0.f, 0.f};
    bf16x8 At[4][2], B0[2][2], B1[2][2];
    i32x8 At8[4], B08[2], B18[2];
    const char* cA = (const char*)g.A + (size_t)cur.pm * tstepA; const char* cB = (const char*)g.Bt + (size_t)cur.pn * tstepB;
    S.a_ready(cur);
    if constexpr (SP2) {
        PG8_STAGE(PG8_SB(0, 0), cB, voffB); PG8_STAGE(PG8_SB(0, 1), cB + hstepB, voffB); PG8_STAGE(PG8_SA(0, 0), cA, voffA); PG8_STAGE(PG8_SA(0, 1), cA + hstepA, voffA);
        if (wr == 1) PG8_BAR;
        PG8_WAIT_V(2); PG8_BAR;
        PG8_STAGE(PG8_SB(1, 0), cB + kstep, voffB); PG8_STAGE(PG8_SA(1, 0), cA + kstep, voffA); PG8_STAGE(PG8_SB(1, 1), cB + hstepB + kstep, voffB);
        PG8_WAIT_V(6); PG8_BAR;
    } else {
        PG8_STAGE(PG8_SB(0, 0), cB, voffB); PG8_STAGE(PG8_SA(0, 0), cA, voffA); PG8_STAGE(PG8_SB(0, 1), cB + hstepB, voffB); PG8_STAGE(PG8_SA(0, 1), cA + hstepA, voffA);
        if (wr == 1) PG8_BAR;
        PG8_WAIT_V(4); PG8_BAR;
        PG8_STAGE(PG8_SB(1, 0), cB + kstep, voffB); PG8_STAGE(PG8_SA(1, 0), cA + kstep, voffA); PG8_STAGE(PG8_SB(1, 1), cB + hstepB + kstep, voffB);
        PG8_WAIT_V(6); PG8_BAR;
    }
    for (;;) {
        const bool has_next = S.next(ui + 1, nxt);
        const char* nA = has_next ? (const char*)g.A + (size_t)nxt.pm * tstepA : cA; const char* nB = has_next ? (const char*)g.Bt + (size_t)nxt.pn * tstepB : cB;
#pragma unroll 1
        for (int t = 0; t < nt; t += 2) {
            if constexpr (Seg::ON) { if (t == SG.t0 || t == SG.t1) SG.rescale(acc, cur, (t == SG.t0) ? 0 : 1, wr, wc, fr, fq); }
            const bool last = (t == nt - 2);
            const char* a1 = cA + (size_t)(t + 1) * kstep;
            const char* a2 = last ? nA : cA + (size_t)(t + 2) * kstep; const char* b2 = last ? nB : cB + (size_t)(t + 2) * kstep;
            const char* a3 = a2 + kstep; const char* b3 = b2 + kstep;
            if (last && has_next) S.a_ready(nxt);
            if constexpr (SP2) {
            PG8_LDB(B0, 0, 0); PG8_LDB(B1, 0, 1); PG8_SCHED; PG8_LDA(At, 0, 0); PG8_STAGE(PG8_SA(1, 1), a1 + hstepA, voffA);
            PG8_WAIT_V(8); PG8_WAIT_L(0); PG8_BAR; PG8_MMA(0, 0, At, B0); PG8_MMA(0, 1, At, B1); PG8_BAR; PG8_SCHED;
            PG8_LDA(At, 0, 1); PG8_STAGE(PG8_SB(0, 0), b2, voffB); PG8_STAGE(PG8_SB(0, 1), b2 + hstepB, voffB); PG8_STAGE(PG8_SA(0, 0), a2, voffA);
            PG8_WAIT_V(8); PG8_WAIT_L(0); PG8_BAR; PG8_MMA(1, 0, At, B0); PG8_MMA(1, 1, At, B1); PG8_BAR; PG8_SCHED;
            PG8_LDB(B0, 1, 0); PG8_LDB(B1, 1, 1); PG8_SCHED; PG8_LDA(At, 1, 0); PG8_STAGE(PG8_SA(0, 1), a2 + hstepA, voffA);
            PG8_WAIT_V(8); PG8_WAIT_L(0); PG8_BAR; PG8_MMA(0, 0, At, B0); PG8_MMA(0, 1, At, B1); PG8_BAR; PG8_SCHED;
            PG8_LDA(At, 1, 1); PG8_STAGE(PG8_SB(1, 0), b3, voffB); PG8_STAGE(PG8_SB(1, 1), b3 + hstepB, voffB); PG8_STAGE(PG8_SA(1, 0), a3, voffA);
            PG8_WAIT_V(8); PG8_WAIT_L(0); PG8_BAR; PG8_MMA(1, 0, At, B0); PG8_MMA(1, 1, At, B1); PG8_BAR; PG8_SCHED;
            } else {
            PG8_LDB(B0, 0, 0); PG8_SCHED; PG8_LDA(At, 0, 0); PG8_STAGE(PG8_SA(1, 1), a1 + hstepA, voffA);
            PG8_WAIT_L(8); PG8_BAR; PG8_WAIT_L(0); PG8_MMA(0, 0, At, B0); PG8_BAR; PG8_SCHED;
            PG8_LDB(B1, 0, 1); PG8_STAGE(PG8_SB(0, 0), b2, voffB);
            PG8_BAR; PG8_WAIT_L(0); PG8_MMA(0, 1, At, B1); PG8_BAR;
            PG8_LDA(At, 0, 1); PG8_STAGE(PG8_SA(0, 0), a2, voffA);
            PG8_BAR; PG8_WAIT_L(0); PG8_MMA(1, 0, At, B0); PG8_BAR; PG8_SCHED;
            PG8_STAGE(PG8_SB(0, 1), b2 + hstepB, voffB);
            PG8_WAIT_V(6); PG8_BAR; PG8_MMA(1, 1, At, B1); PG8_BAR;
            PG8_LDB(B0, 1, 0); PG8_SCHED; PG8_LDA(At, 1, 0); PG8_STAGE(PG8_SA(0, 1), a2 + hstepA, voffA);
            PG8_WAIT_L(8); PG8_BAR; PG8_WAIT_L(0); PG8_MMA(0, 0, At, B0); PG8_BAR; PG8_SCHED;
            PG8_LDB(B1, 1, 1); PG8_STAGE(PG8_SB(1, 0), b3, voffB);
            PG8_BAR; PG8_WAIT_L(0); PG8_MMA(0, 1, At, B1); PG8_BAR;
            PG8_LDA(At, 1, 1); PG8_STAGE(PG8_SA(1, 0), a3, voffA);
            PG8_BAR; PG8_WAIT_L(0); PG8_MMA(1, 0, At, B0); PG8_BAR; PG8_SCHED;
            PG8_STAGE(PG8_SB(1, 1), b3 + hstepB, voffB);
            PG8_WAIT_V(6); PG8_BAR; PG8_MMA(1, 1, At, B1); PG8_BAR;
            }
        }
        if constexpr (ALIGN_EPI) { if (wr == 0) PG8_BAR; }
        if constexpr (F8) asm volatile("s_nop 15\n\ts_nop 15" ::: "memory");
        if constexpr (!Epi::AFTER_DRAIN) { E(acc, cur, wr, wc, fr, fq); S.done(cur); }
        if (!has_next) break;
#pragma unroll
        for (int a = 0; a < 2; ++a)
#pragma unroll
            for (int b = 0; b < 2; ++b)
#pragma unroll
                for (int m = 0; m < 4; ++m)
#pragma unroll
                    for (int n = 0; n < 2; ++n) acc[a][b][m][n] = (f32x4){0.f, 0.f, 0.f, 0.f};
        cur = nxt; cA = nA; cB = nB; ++ui;
        if constexpr (ALIGN_EPI) { if (wr == 1) PG8_BAR; }
    }
    PG8_WAIT_V(0);
    if constexpr (!ALIGN_EPI) { if (wr == 0) PG8_BAR; }
    PG8_BAR;
    if constexpr (Epi::AFTER_DRAIN) { E.fused(acc, cur, wr, wc, fr, fq, lds, wid, lane); S.done(cur); }
#undef PG8_SA
#undef PG8_SB
#undef PG8_STAGE
#undef PG8_LDA
#undef PG8_LDB
#undef PG8_MMA
#undef PG8_LD8
#undef PG8_WAIT_V
#undef PG8_WAIT_L
#undef PG8_BAR
#undef PG8_SCHED
}
}
template <class F> DEVI void gemm256_phase_f8(const unsigned char* A, int lda_bytes, const unsigned char* Bt, int ldb_bytes, int M, int N, int K, char* lds, const F& f) {
    pg8::Gemm g{(const bf16_t*)A, (const bf16_t*)Bt, M, N, opaque_i32(K >> 1), opaque_i32(lda_bytes >> 1), opaque_i32(ldb_bytes >> 1)}; pg8::StaticOrder S; S.init(M, N, (int)gridDim.x, (int)blockIdx.x); pg8::EpiAd<F> E{f};
    __syncthreads();
    pg8::gemm_phase<pg8::EpiAd<F>, pg8::StaticOrder, true, true, pg8::NoSeg, true>((PG8_LAS unsigned char*)lds, g, S, E);
}
template <class F> DEVI void gemm256_phase_seg(const bf16_t* A, int lda, const bf16_t* Bt, int ldb, int M, int N, int K, char* lds, const F& f, const pg8::GateSeg& sg) {
    pg8::Gemm g{A, Bt, M, N, opaque_i32(K), opaque_i32(lda), opaque_i32(ldb)}; pg8::StaticOrder S; S.init(M, N, (int)gridDim.x, (int)blockIdx.x); pg8::EpiAd<F> E{f};
    __syncthreads();
    pg8::gemm_phase<pg8::EpiAd<F>, pg8::StaticOrder, true, true, pg8::GateSeg>((PG8_LAS unsigned char*)lds, g, S, E, sg);
}
template <class F> DEVI void gemm256_pair(const bf16_t* A, int lda, const bf16_t* Bt, int ldb, int M, int N, int K, char* lds, const F& f, int v) {
    pg8::Gemm g{A, Bt, M, N, opaque_i32(K), opaque_i32(lda), opaque_i32(ldb)}; pg8::PairOrder S{v}; pg8::EpiAd<F> E{f};
    __syncthreads();
    pg8::gemm_phase<pg8::EpiAd<F>, pg8::PairOrder, true, true>((PG8_LAS unsigned char*)lds, g, S, E);
}
template <class F> DEVI void gemm256_phase(const bf16_t* A, int lda, const bf16_t* Bt, int ldb, int M, int N, int K, char* lds, const F& f) {
    pg8::Gemm g{A, Bt, M, N, opaque_i32(K), opaque_i32(lda), opaque_i32(ldb)}; pg8::StaticOrder S; S.init(M, N, (int)gridDim.x, (int)blockIdx.x); pg8::EpiAd<F> E{f};
    __syncthreads();
    pg8::gemm_phase<pg8::EpiAd<F>, pg8::StaticOrder, true, true>((PG8_LAS unsigned char*)lds, g, S, E);
}

DEVI void job_transpose(const float* __restrict__ src, int K, int N, bf16_t* __restrict__ dst, int mapmode, const float* __restrict__ kscale, char* lds, int& rot, int ldd = 0) {
    if (ldd == 0) ldd = K;
    float* tile = (float*)lds;
    const int tid = tid_(), nkt = K >> 6, nnt = (N + 127) >> 7, ntile = nkt * nnt;
    const int bfirst = (int)((blockIdx.x + gridDim.x - (unsigned)rot % gridDim.x) % gridDim.x); rot += ntile;
    for (int t = bfirst; t < ntile; t += gridDim.x) {
        const int kt = t / nnt, ntl = t - kt * nnt, k0 = kt * 64, n0 = ntl * 128, ncols = (N - n0 < 128) ? (N - n0) : 128;
        __syncthreads();
#pragma unroll
        for (int i = 0; i < 4; ++i) { const int id = tid + i * NTHR, r = id >> 5, c4 = (id & 31) * 4;
            if (c4 < ncols) { f32x4 v = *(const f32x4*)(src + (size_t)(k0 + r) * N + n0 + c4);
                if (kscale) { const float s = kscale[k0 + r]; v = v * s; }
                tile[r * 129 + c4] = v[0]; tile[r * 129 + c4 + 1] = v[1]; tile[r * 129 + c4 + 2] = v[2]; tile[r * 129 + c4 + 3] = v[3]; } }
        __syncthreads();
#pragma unroll
        for (int i = 0; i < 2; ++i) { const int id = tid + i * NTHR, nl = id >> 3, kc = (id & 7) * 8;
            if (nl < ncols) { int n = n0 + nl;
                if (mapmode == 1) { n = (n < 1152) ? n : (n < 1184) ? n + 256 : (n < 1440) ? n - 32 : n + 96; }
                u32x4 w; w.x = cvtpk(tile[(kc + 0) * 129 + nl], tile[(kc + 1) * 129 + nl]); w.y = cvtpk(tile[(kc + 2) * 129 + nl], tile[(kc + 3) * 129 + nl]);
                w.z = cvtpk(tile[(kc + 4) * 129 + nl], tile[(kc + 5) * 129 + nl]); w.w = cvtpk(tile[(kc + 6) * 129 + nl], tile[(kc + 7) * 129 + nl]);
                *(u32x4*)(dst + (size_t)n * ldd + k0 + kc) = w; } }
    }
}
DEVI void job_transpose8(const float* __restrict__ src, int lds_src, int K, int N, unsigned char* __restrict__ dst, float mul, char* lds, int& rot) {
    float* tile = (float*)lds;
    const int tid = tid_(), nkt = K >> 6, nnt = N >> 7, ntile = nkt * nnt;
    const int bfirst = (int)((blockIdx.x + gridDim.x - (unsigned)rot % gridDim.x) % gridDim.x); rot += ntile;
    for (int t = bfirst; t < ntile; t += gridDim.x) {
        const int kt = t / nnt, ntl = t - kt * nnt, k0 = kt * 64, n0 = ntl * 128;
        __syncthreads();
#pragma unroll
        for (int i = 0; i < 4; ++i) { const int id = tid + i * NTHR, r = id >> 5, c4 = (id & 31) * 4; const f32x4 v = *(const f32x4*)(src + (size_t)(k0 + r) * lds_src + n0 + c4) * mul;
            tile[r * 129 + c4] = v[0]; tile[r * 129 + c4 + 1] = v[1]; tile[r * 129 + c4 + 2] = v[2]; tile[r * 129 + c4 + 3] = v[3]; }
        __syncthreads();
#pragma unroll
        for (int i = 0; i < 2; ++i) { const int id = tid + i * NTHR, nl = id >> 3, kc = (id & 7) * 8; u32x2 w;
            w.x = pk4_fp8((f32x4){tile[(kc + 0) * 129 + nl], tile[(kc + 1) * 129 + nl], tile[(kc + 2) * 129 + nl], tile[(kc + 3) * 129 + nl]});
            w.y = pk4_fp8((f32x4){tile[(kc + 4) * 129 + nl], tile[(kc + 5) * 129 + nl], tile[(kc + 6) * 129 + nl], tile[(kc + 7) * 129 + nl]});
            *(u32x2*)(dst + (size_t)(n0 + nl) * K + k0 + kc) = w; }
    }
}
DEVI void job_convert(const float* __restrict__ src, bf16_t* __restrict__ dst, size_t n4, int tril) {
    const size_t stride = (size_t)gridDim.x * NTHR;
    for (size_t i = (size_t)blockIdx.x * NTHR + tid_(); i < n4; i += stride) {
        f32x4 v = *(const f32x4*)(src + i * 4);
        if (tril) { const int e = (int)((i * 4) & 16383), t = e >> 7, s = e & 127;
#pragma unroll
            for (int j = 0; j < 4; ++j) if (s + j > t) v[j] = 0.f; }
        st_bf4(dst + i * 4, v);
    }
}
DEVI void job_quant_rows(const float* __restrict__ src, unsigned char* __restrict__ dst, float* __restrict__ scale, int nrows) {
    const int lane = tid_() & 63, wid = tid_() >> 6;
    for (int r = blockIdx.x * 8 + wid; r < nrows; r += gridDim.x * 8) {
        const float* sp = src + (size_t)r * 1024 + lane * 16; f32x4 v[4]; float am = 0.f;
#pragma unroll
        for (int i = 0; i < 4; ++i) { v[i] = *(const f32x4*)(sp + i * 4); am = fmaxf(am, fmaxf(fmaxf(fabsf(v[i][0]), fabsf(v[i][1])), fmaxf(fabsf(v[i][2]), fabsf(v[i][3])))); }
#pragma unroll
        for (int o = 32; o > 0; o >>= 1) am = fmaxf(am, __shfl_xor(am, o));
        am = fmaxf(am, 1e-30f);
#if TAB_FP4
        const float q = 6.f / am; u32x2 w;
#pragma unroll
        for (int d = 0; d < 2; ++d) { unsigned pk = 0u;
            pk = __builtin_amdgcn_cvt_scalef32_pk_fp4_f32(pk, v[2 * d][0] * q, v[2 * d][1] * q, 1.0f, 0); pk = __builtin_amdgcn_cvt_scalef32_pk_fp4_f32(pk, v[2 * d][2] * q, v[2 * d][3] * q, 1.0f, 1);
            pk = __builtin_amdgcn_cvt_scalef32_pk_fp4_f32(pk, v[2 * d + 1][0] * q, v[2 * d + 1][1] * q, 1.0f, 2); pk = __builtin_amdgcn_cvt_scalef32_pk_fp4_f32(pk, v[2 * d + 1][2] * q, v[2 * d + 1][3] * q, 1.0f, 3); w[d] = pk; }
        *(u32x2*)(dst + (size_t)r * ROWB + lane * 8) = w;
        if (lane == 0) scale[r] = am * (1.f / 6.f);
#else
        const float q = 256.f / am;
        u32x4 w;
#pragma unroll
        for (int i = 0; i < 4; ++i) { int pk = 0; pk = __builtin_amdgcn_cvt_pk_fp8_f32(v[i][0] * q, v[i][1] * q, pk, false); pk = __builtin_amdgcn_cvt_pk_fp8_f32(v[i][2] * q, v[i][3] * q, pk, true); w[i] = (unsigned)pk; }
        *(u32x4*)(dst + (size_t)r * ROWB + lane * 16) = w;
        if (lane == 0) scale[r] = am * (1.f / 256.f);
#endif
    }
}
#if TAB_FMT == 5 || TAB_FMT == 65
DEVI void job_quant_rows5(const float* __restrict__ src, unsigned char* __restrict__ dst, int nrows) {
    const int lane = tid_() & 63, wid = tid_() >> 6, l32 = lane & 31, hi = lane >> 5;
    for (int r0 = (blockIdx.x * 8 + wid) * 2; r0 < nrows; r0 += gridDim.x * 16) {
        const int r = r0 + hi; const float* sp = src + (size_t)r * 1024; f32x4 v[8]; float am = 0.f;
#pragma unroll
        for (int i = 0; i < 8; ++i) { v[i] = *(const f32x4*)(sp + CHUNK_COL(l32, i)); am = fmaxf(am, fmaxf(fmaxf(fabsf(v[i][0]), fabsf(v[i][1])), fmaxf(fabsf(v[i][2]), fabsf(v[i][3])))); }
        const bf16_t sb = f2bf(fmaxf(am, 1e-30f) * (1.f / 6.f)); const float q = 1.f / bf2f(sb);
        u32x4 w;
#pragma unroll
        for (int d = 0; d < 4; ++d) { unsigned pk = 0u;
            pk = __builtin_amdgcn_cvt_scalef32_pk_fp4_f32(pk, v[2 * d][0] * q, v[2 * d][1] * q, 1.0f, 0); pk = __builtin_amdgcn_cvt_scalef32_pk_fp4_f32(pk, v[2 * d][2] * q, v[2 * d][3] * q, 1.0f, 1);
            pk = __builtin_amdgcn_cvt_scalef32_pk_fp4_f32(pk, v[2 * d + 1][0] * q, v[2 * d + 1][1] * q, 1.0f, 2); pk = __builtin_amdgcn_cvt_scalef32_pk_fp4_f32(pk, v[2 * d + 1][2] * q, v[2 * d + 1][3] * q, 1.0f, 3); w[d] = pk; }
        unsigned char* dp = dst + (size_t)r * ROWB_V; *(u32x4*)(dp + l32 * 16) = w; *(bf16_t*)(dp + 512 + l32 * 2) = sb;
    }
}
#endif
#if TAB_FMT == 45
DEVI void job_quant_rows45(const float* __restrict__ src, unsigned char* __restrict__ dst, float* __restrict__ scale, int nrows) {
    const int lane = tid_() & 63, wid = tid_() >> 6, l32 = lane & 31, hi = lane >> 5;
    for (int r0 = (blockIdx.x * 8 + wid) * 2; r0 < nrows; r0 += gridDim.x * 16) {
        const int r = r0 + hi; const float* sp = src + (size_t)r * 1024; f32x4 v[8]; float am = 0.f;
#pragma unroll
        for (int i = 0; i < 8; ++i) { v[i] = *(const f32x4*)(sp + CHUNK_COL(l32, i)); am = fmaxf(am, fmaxf(fmaxf(fabsf(v[i][0]), fabsf(v[i][1])), fmaxf(fabsf(v[i][2]), fabsf(v[i][3])))); }
        am = fmaxf(am, DPPF(am, DPP_QX1)); am = fmaxf(am, DPPF(am, DPP_QX2)); am = fmaxf(am, DPPF(am, DPP_HMIR)); am = fmaxf(am, DPPF(am, DPP_MIR));
        { auto rr = __builtin_amdgcn_permlane16_swap(__float_as_uint(am), __float_as_uint(am), false, false); am = fmaxf(__uint_as_float(rr[0]), __uint_as_float(rr[1])); }
        am = fmaxf(am, 1e-30f); const float q = 6.f / am; u32x4 w;
#pragma unroll
        for (int d = 0; d < 4; ++d) { unsigned pk = 0u;
            pk = __builtin_amdgcn_cvt_scalef32_pk_fp4_f32(pk, v[2 * d][0] * q, v[2 * d][1] * q, 1.0f, 0); pk = __builtin_amdgcn_cvt_scalef32_pk_fp4_f32(pk, v[2 * d][2] * q, v[2 * d][3] * q, 1.0f, 1);
            pk = __builtin_amdgcn_cvt_scalef32_pk_fp4_f32(pk, v[2 * d + 1][0] * q, v[2 * d + 1][1] * q, 1.0f, 2); pk = __builtin_amdgcn_cvt_scalef32_pk_fp4_f32(pk, v[2 * d + 1][2] * q, v[2 * d + 1][3] * q, 1.0f, 3); w[d] = pk; }
        *(u32x4*)(dst + (size_t)r * ROWB + l32 * 16) = w; if (l32 == 0) scale[r] = am * (1.f / 6.f);
    }
}
#endif
#if TAB_FMT == 6 || TAB_FMT == 65
DEVI float fp6_val(int k) { return k < 16 ? 0.125f * (float)k : k < 24 ? 2.f + 0.25f * (float)(k - 16) : 4.f + 0.5f * (float)(k - 24); }
DEVI int fp6_idx(float w) { return w < 2.f ? (int)(w * 8.f + 0.5f) : w < 4.f ? 16 + (int)((w - 2.f) * 4.f + 0.5f) : 24 + (int)((w - 4.f) * 2.f + 0.5f); }
DEVI void job_quant_rows6(const float* __restrict__ src, unsigned char* __restrict__ dst, float* __restrict__ scale, int nrows, char* lds) {
    const int lane = tid_() & 63, wid = tid_() >> 6, l32 = lane & 31, hi = lane >> 5;
    float* stage = (float*)(lds + wid * 8448) + lane * 32; int* ptab = (int*)(lds + wid * 8448 + 8192);
    int pinv[32];
    { f32x16 ca, cb;
#pragma unroll
      for (int i = 0; i < 16; ++i) { ca[i] = fp6_val(i); cb[i] = fp6_val(16 + i); }
      const u32x6 pk = __builtin_amdgcn_cvt_scalef32_2xpk16_fp6_f32(ca, cb, 1.0f); const f32x32 w = __builtin_amdgcn_cvt_scalef32_pk32_f32_fp6(pk, 1.0f);
#pragma unroll
      for (int k = 0; k < 32; ++k) { const int m = fp6_idx(w[k]) & 31; if (lane == 0) ptab[m] = k; }
      asm volatile("s_waitcnt lgkmcnt(0)" ::: "memory");
#pragma unroll
      for (int m = 0; m < 32; ++m) pinv[m] = ptab[m];
      asm volatile("s_waitcnt lgkmcnt(0)" ::: "memory"); }
    f32x4 vn[8];
    { const int rf = (blockIdx.x * 8 + wid) * 2 + hi; const float* sp = src + (size_t)(rf < nrows ? rf : 0) * 1024 + l32 * 32;
#pragma unroll
      for (int i = 0; i < 8; ++i) vn[i] = *(const f32x4*)(sp + i * 4); }
    for (int r0 = (blockIdx.x * 8 + wid) * 2; r0 < nrows; r0 += gridDim.x * 16) {
        const int r = r0 + hi; f32x4 v[8]; float am = 0.f;
#pragma unroll
        for (int i = 0; i < 8; ++i) v[i] = vn[i];
        { const int rn = r + gridDim.x * 16; const float* sp = src + (size_t)(rn < nrows ? rn : r) * 1024 + l32 * 32;
#pragma unroll
          for (int i = 0; i < 8; ++i) vn[i] = *(const f32x4*)(sp + i * 4); }
#pragma unroll
        for (int i = 0; i < 8; ++i) am = fmaxf(am, fmaxf(fmaxf(fabsf(v[i][0]), fabsf(v[i][1])), fmaxf(fabsf(v[i][2]), fabsf(v[i][3]))));
        am = fmaxf(am, DPPF(am, DPP_QX1)); am = fmaxf(am, DPPF(am, DPP_QX2)); am = fmaxf(am, DPPF(am, DPP_HMIR)); am = fmaxf(am, DPPF(am, DPP_MIR));
        { auto rr = __builtin_amdgcn_permlane16_swap(__float_as_uint(am), __float_as_uint(am), false, false); am = fmaxf(__uint_as_float(rr[0]), __uint_as_float(rr[1])); }
        am = fmaxf(am, 1e-30f); const float q = 7.5f / am;
#pragma unroll
        for (int i = 0; i < 8; ++i) *(f32x4*)(stage + i * 4) = v[i] * q;
        asm volatile("s_waitcnt lgkmcnt(0)" ::: "memory");
        f32x16 a, b;
#pragma unroll
        for (int m = 0; m < 16; ++m) { a[m] = stage[pinv[m]]; b[m] = stage[pinv[16 + m]]; }
        asm volatile("s_waitcnt lgkmcnt(0)" ::: "memory");
        const u32x6 pk = __builtin_amdgcn_cvt_scalef32_2xpk16_fp6_f32(a, b, 1.0f);
        unsigned char* dp = dst + (size_t)r * ROWB + l32 * 24;
        *(u32x2*)(dp) = (u32x2){pk[0], pk[1]}; *(u32x2*)(dp + 8) = (u32x2){pk[2], pk[3]}; *(u32x2*)(dp + 16) = (u32x2){pk[4], pk[5]};
        if (l32 == 0) scale[r] = am * (1.f / 7.5f);
    }
}
#endif
DEVI bf16x8 ld8_f32_bf(const float* p) { const f32x4 a = *(const f32x4*)p, b = *(const f32x4*)(p + 4); u32x4 w; w.x = cvtpk(a[0], a[1]); w.y = cvtpk(a[2], a[3]); w.z = cvtpk(b[0], b[1]); w.w = cvtpk(b[2], b[3]); return __builtin_bit_cast(bf16x8, w); }
DEVI void job_fold_pq(const P& p) {
    const int lane = tid_() & 63, wid = tid_() >> 6, fr = lane & 15, fq = lane >> 4;
    for (int item = blockIdx.x; item < NL * 64; item += gridDim.x) {
        const int l = item >> 6, hh = (item >> 2) & 15, k00 = (item & 3) * 256;
        const float* sk = p.sub_keys + ((size_t)l * 16 + hh) * 128 * 128 + (size_t)(wid * 16 + fr) * 128 + fq * 8;
        const float* wq = p.w_pq + (size_t)l * 1024 * 2048 + hh * 128 + fq * 8;
        bf16_t* out = (bf16_t*)(WS(p) + OFF_W + (size_t)l * W_LAYER + W_PQ) + (size_t)(hh * 128 + wid * 16 + fr) * 1024;
        bf16x8 kf_[4];
#pragma unroll
        for (int ks = 0; ks < 4; ++ks) kf_[ks] = ld8_f32_bf(sk + ks * 32);
#pragma unroll 2
        for (int kt = 0; kt < 16; ++kt) { const int k0 = k00 + kt * 16; f32x4 acc = (f32x4){0.f, 0.f, 0.f, 0.f};
#pragma unroll
            for (int ks = 0; ks < 4; ++ks) acc = MFMA16(ld8_f32_bf(wq + (size_t)(k0 + fr) * 2048 + ks * 32), kf_[ks], acc);
            st_bf4(out + k0 + 4 * fq, acc); }
    }
}
DEVI void phase_prologue(const P& p, char* lds) {
    const int tid = tid_();
    const size_t gtid = (size_t)blockIdx.x * NTHR + tid, gstride = (size_t)gridDim.x * NTHR;
    { float* rope = (float*)(WS(p) + OFF_ROPE);
      for (size_t i = gtid; i < (size_t)T_ * 16; i += gstride) { const int t = (int)(i >> 4), f = (int)(i & 15);
          const float angf = (float)p.pos[t] * (float)p.invf[f];
          const double rev = (double)angf * 0.15915494309189535; const double fr = rev - rint(rev);
          rope[(size_t)t * 32 + f] = __builtin_amdgcn_cosf((float)fr); rope[(size_t)t * 32 + 16 + f] = __builtin_amdgcn_sinf((float)fr); } }
    { float* ca = (float*)lds; f32x4* red = (f32x4*)(ca + 2048);
      float* mod = (float*)(WS(p) + OFF_MOD);
      __syncthreads();
      for (int i = tid; i < 2048; i += NTHR) { const float cv = p.c[i]; ca[i] = cv * sigmoidf_(cv); }
      __syncthreads();
      for (int wi = blockIdx.x; wi < NL * 48; wi += gridDim.x) {
          const int l = wi / 48, j0 = (wi - l * 48) * 128, kq = tid >> 5, cq = tid & 31;
          const float* w = p.w_mod + (size_t)l * 1024 * 6144 + j0 + cq * 4; f32x4 a0 = (f32x4){0.f, 0.f, 0.f, 0.f}, a1 = a0;
#pragma unroll 8
          for (int k = kq * 64; k < kq * 64 + 64; ++k) { const f32x4 wv = *(const f32x4*)(w + (size_t)k * 6144); a0 = a0 + wv * ca[k]; a1 = a1 + wv * ca[1024 + k]; }
          red[(kq * 2 + 0) * 32 + cq] = a0; red[(kq * 2 + 1) * 32 + cq] = a1;
          __syncthreads();
          if (tid < 64) { const int b = tid >> 5; f32x4 s = red[b * 32 + cq];
#pragma unroll
              for (int q = 1; q < 16; ++q) s = s + red[(q * 2 + b) * 32 + cq];
              const f32x4 bb = *(const f32x4*)(p.b_mod + (size_t)l * 6144 + j0 + cq * 4); *(f32x4*)(mod + ((size_t)l * 2 + b) * 6144 + j0 + cq * 4) = s + bb; }
          __syncthreads();
      } }
    int rot = 192;
    for (int l = 0; l < NL; ++l) {
        unsigned char* wl = WS(p) + OFF_W + (size_t)l * W_LAYER;
        job_transpose(p.w_in + (size_t)l * 1024 * 4512, 1024, 4512, (bf16_t*)(wl + W_INT), 1, nullptr, lds, rot);
        for (size_t i = gtid; i < (size_t)96 * 1024 / 8; i += gstride) ((u32x4*)(wl + W_INT + (size_t)1440 * 1024 * 2))[i] = (u32x4){0u, 0u, 0u, 0u};
        if (GATES_FP8) job_transpose8(p.w_in + (size_t)l * 1024 * 4512 + 1440, 4512, 1024, 3072, wl + W_G8, 64.f, lds, rot);
        job_transpose(p.w_uq + (size_t)l * 384 * 768, 384, 768, (bf16_t*)(wl + W_UQ), 0, p.q_norm + l * 384, lds, rot);
        job_transpose(p.w_ukv + (size_t)l * 256 * 1024, 256, 1024, (bf16_t*)(wl + W_UKV), 0, p.kv_norm + l * 256, lds, rot);
        job_transpose(p.w_a + (size_t)l * 256 * 1024, 256, 1024, (bf16_t*)(wl + W_A) + CAT_YA, 0, nullptr, lds, rot, 1024);
        job_transpose(p.w_b + (size_t)l * 512 * 1024, 512, 1024, (bf16_t*)(wl + W_A) + CAT_YB, 0, nullptr, lds, rot, 1024);
        job_transpose(p.w_o + (size_t)l * 1024 * 1024, 1024, 1024, (bf16_t*)(wl + W_O), 0, nullptr, lds, rot);
        if (!PQ_FOLD) job_transpose(p.w_pq + (size_t)l * 1024 * 2048, 1024, 2048, (bf16_t*)(wl + W_PQ), 0, nullptr, lds, rot);
        job_convert(p.sub_keys + (size_t)l * 16 * 128 * 128, (bf16_t*)(wl + W_SK), (size_t)16 * 128 * 128 / 4, 0);
        job_convert(p.w_s + (size_t)l * 4 * 128 * 128, (bf16_t*)(wl + W_S), (size_t)4 * 128 * 128 / 4, 1);
    }
    if (PQ_FOLD) job_fold_pq(p);
    { float* Tt = (float*)lds; float* Wp = Tt + 64 * 65;
      for (int wi = (int)((blockIdx.x + gridDim.x - (unsigned)rot % gridDim.x) % gridDim.x); wi < NL * 4 * 16; wi += gridDim.x) {
          const int l = wi >> 6, g = (wi >> 4) & 3, n0 = (wi & 15) * 64;
          const float* wp = p.w_pool + (size_t)l * 4 * 64 * 64 + (size_t)g * 64 * 64; const float* ps = p.pool_scale + l * 256 + g * 64; const float* wcs = p.w_c + (size_t)l * 256 * 1024 + (size_t)g * 64 * 1024 + n0;
          __syncthreads();
#pragma unroll
          for (int i = 0; i < 8; ++i) { const int id = tid + i * NTHR, r = id >> 6, c = id & 63; Tt[r * 65 + c] = ps[r] * wcs[(size_t)r * 1024 + c]; Wp[r * 65 + c] = wp[r * 64 + c]; }
          __syncthreads();
          const int n = tid & 63, cg = tid >> 6; float a[8];
#pragma unroll
          for (int i = 0; i < 8; ++i) a[i] = 0.f;
          for (int jj = 0; jj < 64; ++jj) { const float tv = Tt[jj * 65 + n];
#pragma unroll
              for (int i = 0; i < 8; ++i) a[i] += Wp[(cg * 8 + i) * 65 + jj] * tv; }
          u32x4 w; w.x = cvtpk(a[0], a[1]); w.y = cvtpk(a[2], a[3]); w.z = cvtpk(a[4], a[5]); w.w = cvtpk(a[6], a[7]);
          *(u32x4*)((bf16_t*)(WS(p) + OFF_W + (size_t)l * W_LAYER + W_A) + (size_t)(n0 + n) * 1024 + CAT_PRE + g * 64 + cg * 8) = w;
      } }
#if TAB_FMT == 45
    job_quant_rows45(p.u_tab, WS(p) + OFF_U, (float*)(WS(p) + OFF_SU), NL * 16384);
    job_quant_rows45(p.v_tab, WS(p) + OFF_V, (float*)(WS(p) + OFF_SV), NL * 16384);
#elif TAB_FMT == 5
    job_quant_rows5(p.u_tab, WS(p) + OFF_U, NL * 16384);
    job_quant_rows5(p.v_tab, WS(p) + OFF_V, NL * 16384);
#elif TAB_FMT == 65
    __syncthreads();
    job_quant_rows6(p.u_tab, WS(p) + OFF_U, (float*)(WS(p) + OFF_SU), NL * 16384, lds);
    job_quant_rows5(p.v_tab, WS(p) + OFF_V, NL * 16384);
#elif TAB_FMT == 6
    __syncthreads();
    job_quant_rows6(p.u_tab, WS(p) + OFF_U, (float*)(WS(p) + OFF_SU), NL * 16384, lds);
    job_quant_rows6(p.v_tab, WS(p) + OFF_V, (float*)(WS(p) + OFF_SV), NL * 16384, lds);
#else
    job_quant_rows(p.u_tab, WS(p) + OFF_U, (float*)(WS(p) + OFF_SU), NL * 16384);
    job_quant_rows(p.v_tab, WS(p) + OFF_V, (float*)(WS(p) + OFF_SV), NL * 16384);
#endif
}

DEVI void phase_norm(const P& p, const float* xsrc, const float* sh, const float* sc, bool also8, const bf16_t* xsrcb = nullptr, bool alsop = false) {
    const int lane = tid_() & 63, wid = tid_() >> 6, j = lane & 15, tk = lane >> 4; bf16_t* h = (bf16_t*)(WS(p) + OFF_H);
    for (int t0 = (blockIdx.x * 8 + wid) * 4; t0 < T_; t0 += gridDim.x * 32) {
        const int t = t0 + tk; const float* xp = xsrc + (size_t)t * DM + j * 4; f32x4 v[16]; float ss = 0.f;
#pragma unroll
        for (int i = 0; i < 16; ++i) { v[i] = xsrcb ? ld_bf4(xsrcb + (size_t)t * DM + j * 4 + i * 64) : *(const f32x4*)(xp + i * 64); ss += v[i][0] * v[i][0] + v[i][1] * v[i][1] + v[i][2] * v[i][2] + v[i][3] * v[i][3]; }
        ss += DPPF(ss, DPP_QX1); ss += DPPF(ss, DPP_QX2); ss += DPPF(ss, DPP_HMIR); ss += DPPF(ss, DPP_MIR);
        const float rs = rsqrtf(ss * (1.f / 1024.f) + 1e-6f); const int bo = (t >= S_) ? 6144 : 0;
#pragma unroll
        for (int i = 0; i < 16; ++i) { const int col = j * 4 + i * 64; const f32x4 a = *(const f32x4*)(sc + bo + col), b = *(const f32x4*)(sh + bo + col);
            const f32x4 o = v[i] * rs * (a + 1.f) + b; st_bf4(h + (size_t)t * DM + col, o); if (GATES_FP8 && also8) *(unsigned*)(WS(p) + OFF_H8 + (size_t)t * DM + col) = pk4_fp8(o); v[i] = o; }
        if (alsop) {
            float am = 0.f;
#pragma unroll
            for (int i = 0; i < 16; ++i) am = fmaxf(am, fmaxf(fmaxf(fabsf(v[i][0]), fabsf(v[i][1])), fmaxf(fabsf(v[i][2]), fabsf(v[i][3]))));
            am = fmaxf(am, DPPF(am, DPP_QX1)); am = fmaxf(am, DPPF(am, DPP_QX2)); am = fmaxf(am, DPPF(am, DPP_HMIR)); am = fmaxf(am, DPPF(am, DPP_MIR));
            const int e0 = (int)((__float_as_uint(fmaxf(am, 1e-20f) * (1.f / 6.f)) >> 23) & 255u) - 126;
            const float inv0 = __uint_as_float((unsigned)(127 - e0) << 23), s0 = __uint_as_float((unsigned)(127 + e0) << 23), inv1 = inv0 * 4.f;
            unsigned char* p0 = WS(p) + OFF_H4P + (size_t)t * 512; unsigned char* p1 = p0 + (size_t)T_ * 512;
#pragma unroll
            for (int i = 0; i < 16; ++i) { const f32x4 o = v[i]; unsigned pk = 0u;
                pk = __builtin_amdgcn_cvt_scalef32_pk_fp4_f32(pk, o[0] * inv0, o[1] * inv0, 1.0f, 0); pk = __builtin_amdgcn_cvt_scalef32_pk_fp4_f32(pk, o[2] * inv0, o[3] * inv0, 1.0f, 1);
                const f32x2 d01 = __builtin_amdgcn_cvt_scalef32_pk_f32_fp4(pk, 1.0f, 0), d23 = __builtin_amdgcn_cvt_scalef32_pk_f32_fp4(pk, 1.0f, 1);
                unsigned pr = 0u;
                pr = __builtin_amdgcn_cvt_scalef32_pk_fp4_f32(pr, (o[0] - d01[0] * s0) * inv1, (o[1] - d01[1] * s0) * inv1, 1.0f, 0); pr = __builtin_amdgcn_cvt_scalef32_pk_fp4_f32(pr, (o[2] - d23[0] * s0) * inv1, (o[3] - d23[1] * s0) * inv1, 1.0f, 1);
                const int off = (16 * (i & 1) + j) * 16 + (i >> 1) * 2;
                *(unsigned short*)(p0 + off) = (unsigned short)(pk & 0xffffu); *(unsigned short*)(p1 + off) = (unsigned short)(pr & 0xffffu); }
            if (j == 0) ((int*)(WS(p) + OFF_HSC))[t] = (127 + e0) | ((127 + e0 - 2) << 8);
        }
    }
}
DEVI void phase_final(const P& p) {
    const int lane = tid_() & 63, wid = tid_() >> 6;
#if PROBE_ATTN
    const float pscale = 1.f + 10.f * __uint_as_float(((const unsigned*)(WS(p) + OFF_CTL))[4000]);
#else
    const float pscale = 1.f;
#endif
    for (int t = blockIdx.x * 8 + wid; t < T_; t += gridDim.x * 8) {
        float* xp = XR(p) + (size_t)t * DM; f32x4 v[4]; float ss = 0.f;
#pragma unroll
        for (int i = 0; i < 4; ++i) { v[i] = *(const f32x4*)(xp + i * 256 + lane * 4); ss += v[i][0] * v[i][0] + v[i][1] * v[i][1] + v[i][2] * v[i][2] + v[i][3] * v[i][3]; }
        ss = wave_sum(ss); const float rs = rsqrtf(ss * (1.f / 1024.f) + 1e-6f);
#pragma unroll
        for (int i = 0; i < 4; ++i) { const int col = i * 256 + lane * 4; const f32x4 g = *(const f32x4*)(p.final_norm + col); *(f32x4*)(xp + col) = v[i] * (rs * pscale) * g; }
    }
}
DEVI void ld8_bf(const bf16_t* p, float (&o)[8]) { const u32x4 w = *(const u32x4*)p;
#pragma unroll
    for (int k = 0; k < 4; ++k) { o[2 * k] = bflo(w[k]); o[2 * k + 1] = bfhi(w[k]); } }
DEVI void st8_bf(bf16_t* p, const float (&v)[8]) { u32x4 w;
#pragma unroll
    for (int k = 0; k < 4; ++k) w[k] = cvtpk(v[2 * k], v[2 * k + 1]);
    *(u32x4*)p = w; }
DEVI float sum8(float v) { v += DPPF(v, DPP_QX1); v += DPPF(v, DPP_QX2); v += DPPF(v, DPP_HMIR); return v; }
DEVI void phase_post(const P& p) {
    const int lane = tid_() & 63, wid = tid_() >> 6, j = lane & 7, tk = lane >> 3;
    const bf16_t* z = (const bf16_t*)(WS(p) + OFF_Z); bf16_t* vn = (bf16_t*)(WS(p) + OFF_VN); bf16_t* pre = (bf16_t*)(WS(p) + OFF_CAT) + CAT_PRE; bf16_t* Kb = (bf16_t*)(WS(p) + OFF_K);
    float* rsq = (float*)(WS(p) + OFF_RS); float* rskv = rsq + T_; const float* rope = (const float*)(WS(p) + OFF_ROPE);
    for (int t0 = (blockIdx.x * 8 + wid) * 8; t0 < T_; t0 += gridDim.x * 64) {
        const int t = t0 + tk; const bf16_t* zr = z + (size_t)t * ZC;
        { float v[32]; float s = 0.f;
#pragma unroll
          for (int q = 0; q < 4; ++q) { float u[8]; ld8_bf(zr + Z_V + j * 32 + q * 8, u);
#pragma unroll
              for (int k = 0; k < 8; ++k) { v[q * 8 + k] = u[k]; s += u[k]; } }
          const float mu = sum8(s) * (1.f / 256.f); float s2 = 0.f;
#pragma unroll
          for (int k = 0; k < 32; ++k) { v[k] -= mu; s2 += v[k] * v[k]; }
          const float rstd = rsqrtf(sum8(s2) * (1.f / 256.f) + 1e-6f);
#pragma unroll
          for (int q = 0; q < 4; ++q) { float u[8];
#pragma unroll
              for (int k = 0; k < 8; ++k) u[k] = v[q * 8 + k] * rstd;
              st8_bf(vn + (size_t)t * 256 + j * 32 + q * 8, u); } }
        { float sq = 0.f, sk = 0.f;
#pragma unroll
          for (int q = 0; q < 6; ++q) { float u[8]; ld8_bf(zr + Z_CQ + j * 48 + q * 8, u);
#pragma unroll
              for (int k = 0; k < 8; ++k) sq += u[k] * u[k]; }
#pragma unroll
          for (int q = 0; q < 4; ++q) { float u[8]; ld8_bf(zr + Z_CKV + j * 32 + q * 8, u);
#pragma unroll
              for (int k = 0; k < 8; ++k) sk += u[k] * u[k]; }
          sq = sum8(sq); sk = sum8(sk);
          if (j == 0) rsq[t] = rsqrtf(sq * (1.f / 384.f) + 1e-6f); if (j == 1) rskv[t] = rsqrtf(sk * (1.f / 256.f) + 1e-6f); }
        {
          float x1[16], x2[16]; { float u[8]; ld8_bf(zr + Z_KR, u);
#pragma unroll
              for (int k = 0; k < 8; ++k) x1[k] = u[k]; ld8_bf(zr + Z_KR + 8, u);
#pragma unroll
              for (int k = 0; k < 8; ++k) x1[8 + k] = u[k]; ld8_bf(zr + Z_KR + 16, u);
#pragma unroll
              for (int k = 0; k < 8; ++k) x2[k] = u[k]; ld8_bf(zr + Z_KR + 24, u);
#pragma unroll
              for (int k = 0; k < 8; ++k) x2[8 + k] = u[k]; }
          const float* rp = rope + (size_t)t * 32; bf16_t* kr = Kb + (size_t)t * 768 + j * 96 + 64;
#pragma unroll
          for (int q = 0; q < 2; ++q) { float o1[8], o2[8];
#pragma unroll
              for (int k4 = 0; k4 < 2; ++k4) { const f32x4 cs = *(const f32x4*)(rp + q * 8 + k4 * 4), sn = *(const f32x4*)(rp + 16 + q * 8 + k4 * 4);
#pragma unroll
                  for (int k = 0; k < 4; ++k) { const int i = q * 8 + k4 * 4 + k; o1[k4 * 4 + k] = x1[i] * cs[k] - x2[i] * sn[k]; o2[k4 * 4 + k] = x2[i] * cs[k] + x1[i] * sn[k]; } }
              st8_bf(kr + q * 8, o1); st8_bf(kr + 16 + q * 8, o2); } }
        {
          const int tt = t & (S_ - 1), w = 2 << (j >> 1), n = (tt + 1 < w) ? tt + 1 : w; const bf16_t* zp = zr + Z_P + j * 32; float sum[32], self[32];
#pragma unroll
          for (int q = 0; q < 4; ++q) { float u[8]; ld8_bf(zp + q * 8, u);
#pragma unroll
              for (int k = 0; k < 8; ++k) { self[q * 8 + k] = u[k]; sum[q * 8 + k] = u[k]; } }
          for (int s = 1; s < n; ++s) {
#pragma unroll
              for (int q = 0; q < 4; ++q) { float u[8]; ld8_bf(zp - (size_t)s * ZC + q * 8, u);
#pragma unroll
                  for (int k = 0; k < 8; ++k) sum[q * 8 + k] += u[k]; } }
          const float inv = 1.f / (float)n;
#pragma unroll
          for (int q = 0; q < 4; ++q) { float u[8];
#pragma unroll
              for (int k = 0; k < 8; ++k) u[k] = sum[q * 8 + k] * inv - self[q * 8 + k];
              st8_bf(pre + (size_t)t * 1024 + j * 32 + q * 8, u); } }
    }
}
DEVI void phase_mixa(const P& p, int l, char* lds) {
    const int tid = tid_(), lane = tid & 63, wid = tid >> 6, fr = lane & 15, fq = lane >> 4, g = wid >> 1, th = (wid & 1) * 64;
    constexpr int VP = 136;
    bf16_t* vnT = (bf16_t*)lds;
    const bf16_t* vn = (const bf16_t*)(WS(p) + OFF_VN); const bf16_t* z = (const bf16_t*)(WS(p) + OFF_Z); bf16_t* ya = (bf16_t*)(WS(p) + OFF_CAT) + CAT_YA;
    const bf16_t* Wg = (const bf16_t*)(WS(p) + OFF_W + (size_t)l * W_LAYER + W_S) + (size_t)g * 128 * 128; const float* bs = p.b_s + (size_t)l * 512 + g * 128;
    for (int ch = blockIdx.x; ch < T_ / 128; ch += gridDim.x) {
        const size_t t0 = (size_t)ch * 128;
        __syncthreads();
#pragma unroll
        for (int i = 0; i < 8; ++i) { const int id = tid + i * NTHR, s = id >> 5, c8 = (id & 31) * 8; const u32x4 w = *(const u32x4*)(vn + (t0 + s) * 256 + c8);
            bf16_t* d = vnT + c8 * VP + s; d[0] = (bf16_t)(w.x & 0xffff); d[VP] = (bf16_t)(w.x >> 16); d[2 * VP] = (bf16_t)(w.y & 0xffff); d[3 * VP] = (bf16_t)(w.y >> 16);
            d[4 * VP] = (bf16_t)(w.z & 0xffff); d[5 * VP] = (bf16_t)(w.z >> 16); d[6 * VP] = (bf16_t)(w.w & 0xffff); d[7 * VP] = (bf16_t)(w.w >> 16); }
        __syncthreads();
        f32x4 acc[4][4]; acc_zero(acc);
#pragma unroll
        for (int kk = 0; kk < 4; ++kk) {
            bf16x8 af[4], bfr[4];
#pragma unroll
            for (int m = 0; m < 4; ++m) af[m] = *(const bf16x8*)(Wg + (size_t)(th + m * 16 + fr) * 128 + kk * 32 + fq * 8);
#pragma unroll
            for (int n = 0; n < 4; ++n) bfr[n] = *(const bf16x8*)(vnT + (g * 64 + n * 16 + fr) * VP + kk * 32 + fq * 8);
#pragma unroll
            for (int m = 0; m < 4; ++m)
#pragma unroll
                for (int n = 0; n < 4; ++n) acc[m][n] = MFMA16(bfr[n], af[m], acc[m][n]);
        }
#pragma unroll
        for (int m = 0; m < 4; ++m) { const int tl = th + m * 16 + fr; const float bias = bs[tl];
#pragma unroll
            for (int n = 0; n < 4; ++n) { const int c = g * 64 + n * 16 + 4 * fq; const f32x4 u = ld_bf4(z + (t0 + tl) * ZC + Z_U + c); f32x4 o = (acc[m][n] + bias) * u; st_bf4(ya + (t0 + tl) * 1024 + c, o); } }
    }
}
DEVI int crow(int r, int hi) { return (r & 3) + 8 * (r >> 2) + 4 * hi; }
DEVI s16x4 vtr(const char* p) { typedef short v4i16_t __attribute__((ext_vector_type(4))); return __builtin_bit_cast(s16x4, __builtin_amdgcn_ds_read_tr16_b64_v4i16((LAS v4i16_t*)p)); }
DEVI float hswap_max(float v) { return fmaxf(v, __shfl_xor(v, 32)); }
DEVI void attn_unit(const P& p, int b, int h, int qb, char* lds) {
    const int tid = tid_(), lane = tid & 63, r32 = lane & 31, hi = lane >> 5, wid = tid >> 6;
    char* Ks = lds; char* Vs = lds + 12288; float* wsf = (float*)(lds + 20480) + wid * 64;
    const bf16_t* Qb = (const bf16_t*)(WS(p) + OFF_Q); const bf16_t* Kb = (const bf16_t*)(WS(p) + OFF_K); const bf16_t* Vb = (const bf16_t*)(WS(p) + OFF_VV); bf16_t* Yb = (bf16_t*)(WS(p) + OFF_CAT) + CAT_YB;
    const size_t rowbase = (size_t)b * S_; const int q0 = qb * 256, NT = 4 * qb + 4;
    bf16x8 qr[6];
    { const size_t tq = rowbase + q0 + wid * 32 + r32; const bf16_t* qp = Qb + tq * 768 + h * 96 + hi * 8; const float rs = ((const float*)(WS(p) + OFF_RS))[tq]; const float sc = rs * C2F;
      const float* rp = (const float*)(WS(p) + OFF_ROPE) + tq * 32 + hi * 8;
      u32x4 raw[6];
#pragma unroll
      for (int d0 = 0; d0 < 6; ++d0) raw[d0] = *(const u32x4*)(qp + d0 * 16);
#pragma unroll
      for (int d0 = 0; d0 < 4; ++d0) { u32x4 w;
#pragma unroll
          for (int j = 0; j < 4; ++j) w[j] = cvtpk(bflo(raw[d0][j]) * sc, bfhi(raw[d0][j]) * sc);
          qr[d0] = __builtin_bit_cast(bf16x8, w); }
      u32x4 w1, w2;
#pragma unroll
      for (int j = 0; j < 4; ++j) { const float a0 = bflo(raw[4][j]), a1 = bfhi(raw[4][j]), b0 = bflo(raw[5][j]), b1 = bfhi(raw[5][j]);
          const float c0 = rp[2 * j], c1 = rp[2 * j + 1], s0 = rp[16 + 2 * j], s1 = rp[16 + 2 * j + 1];
          w1[j] = cvtpk((a0 * c0 - b0 * s0) * sc, (a1 * c1 - b1 * s1) * sc); w2[j] = cvtpk((b0 * c0 + a0 * s0) * sc, (b1 * c1 + a1 * s1) * sc); }
      qr[4] = __builtin_bit_cast(bf16x8, w1); qr[5] = __builtin_bit_cast(bf16x8, w2); }
    const bf16_t* Kg = Kb + rowbase * 768 + h * 96; const bf16_t* Vg = Vb + rowbase * 512 + h * 64;
    const int kc0 = tid >> 6, kk0 = tid & 63;
    const int vw = tid >> 6, vl = tid & 63, vrow = 16 * (vw & 3) + (vl >> 2), vcol = (vw >> 2) * 32 + (vl & 3) * 8;
    u32x4 rk0, rk1 = (u32x4){0u, 0u, 0u, 0u}, rv;
#define A_LOAD(t) do { rk0 = *(const u32x4*)(Kg + (size_t)((t) * 64 + kk0) * 768 + kc0 * 8); if (tid < 256) rk1 = *(const u32x4*)(Kg + (size_t)((t) * 64 + kk0) * 768 + (kc0 + 8) * 8); \
                       rv = *(const u32x4*)(Vg + (size_t)((t) * 64 + vrow) * 512 + vcol); } while (0)
    A_LOAD(0);
    f32x16 o0, o1;
#pragma unroll
    for (int r = 0; r < 16; ++r) { o0[r] = 0.f; o1[r] = 0.f; }
    float mrun = -1e30f, lrun = 0.f;
    const int qrel = wid * 32 + r32;
    const char* vp0 = Vs + ((lane >> 4) & 1) * 32 + (lane & 3) * 8 + (4 * hi + ((lane & 15) >> 2)) * 64;
    for (int t = 0; t < NT; ++t) {
        __syncthreads();
        *(u32x4*)(Ks + kc0 * 1024 + kk0 * 16) = rk0; if (tid < 256) *(u32x4*)(Ks + (kc0 + 8) * 1024 + kk0 * 16) = rk1;
        *(u32x4*)(Vs + vw * 1024 + vl * 16) = rv;
        __syncthreads();
        if (t + 1 < NT) A_LOAD(t + 1);
        f32x16 p0, p1;
#pragma unroll
        for (int r = 0; r < 16; ++r) { p0[r] = 0.f; p1[r] = 0.f; }
#pragma unroll
        for (int d0 = 0; d0 < 6; ++d0) { const bf16x8 k0 = *(const bf16x8*)(Ks + (2 * d0 + hi) * 1024 + r32 * 16), k1 = *(const bf16x8*)(Ks + (2 * d0 + hi) * 1024 + 512 + r32 * 16);
            p0 = MFMA32(k0, qr[d0], p0); p1 = MFMA32(k1, qr[d0], p1); }
        if (t >= NT - 4) { const int kb = 64 * (t - (NT - 4)) + 4 * hi;
#pragma unroll
            for (int r = 0; r < 16; ++r) { const int kv = kb + (r & 3) + 8 * (r >> 2); if (kv > qrel) p0[r] = -INFINITY; if (kv + 32 > qrel) p1[r] = -INFINITY; } }
        float rm = fmaxf(p0[0], p1[0]);
#pragma unroll
        for (int r = 1; r < 16; ++r) rm = fmaxf(rm, fmaxf(p0[r], p1[r]));
        rm = hswap_max(rm);
        const float mnew = fmaxf(mrun, rm), alpha = fexp2(mrun - mnew); mrun = mnew;
        float ls = 0.f;
#pragma unroll
        for (int r = 0; r < 16; ++r) { p0[r] = fexp2(p0[r] - mnew); p1[r] = fexp2(p1[r] - mnew); ls += p0[r] + p1[r]; }
        lrun = lrun * alpha + ls;
        if (__any(alpha != 1.f)) {
            if (hi == 0) wsf[r32] = alpha;
            asm volatile("s_waitcnt lgkmcnt(0)" ::: "memory");
#pragma unroll
            for (int r = 0; r < 16; ++r) { const float f = wsf[crow(r, hi)]; o0[r] *= f; o1[r] *= f; }
            asm volatile("s_waitcnt lgkmcnt(0)" ::: "memory");
        }
        u32x4 pw[4];
#pragma unroll
        for (int j = 0; j < 4; ++j) { pw[0][j] = cvtpk(p0[2 * j], p0[2 * j + 1]); pw[1][j] = cvtpk(p0[8 + 2 * j], p0[8 + 2 * j + 1]); pw[2][j] = cvtpk(p1[2 * j], p1[2 * j + 1]); pw[3][j] = cvtpk(p1[8 + 2 * j], p1[8 + 2 * j + 1]); }
#pragma unroll
        for (int ks = 0; ks < 4; ++ks) {
            const s16x4 a0 = vtr(vp0 + ks * 1024), a1 = vtr(vp0 + ks * 1024 + 512), b0 = vtr(vp0 + 4096 + ks * 1024), b1 = vtr(vp0 + 4096 + ks * 1024 + 512);
            const bf16x8 v0 = (bf16x8){a0[0], a0[1], a0[2], a0[3], a1[0], a1[1], a1[2], a1[3]}, v1 = (bf16x8){b0[0], b0[1], b0[2], b0[3], b1[0], b1[1], b1[2], b1[3]};
            const bf16x8 pa = __builtin_bit_cast(bf16x8, pw[ks]);
            o0 = MFMA32(pa, v0, o0); o1 = MFMA32(pa, v1, o1);
        }
    }
#undef A_LOAD
    lrun += __shfl_xor(lrun, 32);
    if (hi == 0) wsf[32 + r32] = lrun;
    asm volatile("s_waitcnt lgkmcnt(0)" ::: "memory");
    bf16_t* yo = Yb + (rowbase + q0 + wid * 32) * 1024 + h * 64 + r32;
#pragma unroll
    for (int r = 0; r < 16; ++r) { const int row = crow(r, hi); const float rl = frcp(wsf[32 + row]); yo[(size_t)row * 1024] = f2bf(o0[r] * rl); yo[(size_t)row * 1024 + 32] = f2bf(o1[r] * rl); }
    asm volatile("s_waitcnt lgkmcnt(0)" ::: "memory");
}

namespace at96 {
constexpr int KSLOT = 12288, VSLOT = 8192, LDS_K = 0, LDS_V = 3 * KSLOT, LDS_WS = LDS_V + 3 * VSLOT, LDS_OST = LDS_WS + 8 * 256, LDS_NEED = LDS_OST + 8 * 4096;
#define A9_THR 8
#define SBAR() __builtin_amdgcn_sched_barrier(0)
#define PIN(x) asm volatile("" : "+v"(x))
#define WAIT_BAR(N) asm volatile("s_waitcnt vmcnt(" #N ") lgkmcnt(0)\n\ts_barrier" ::: "memory")
#define WAIT_BAR2(NA, NB) do { if (w03) { WAIT_BAR(NA); } else { WAIT_BAR(NB); } } while (0)
typedef __attribute__((address_space(3))) const char* lds_cptr;
DEVI unsigned cvtpk_a(float lo, float hi) { unsigned r; asm("v_cvt_pk_bf16_f32 %0, %1, %2" : "=v"(r) : "v"(lo), "v"(hi)); return r; }
DEVI void glds16(const void* g, unsigned lds_base) {
    unsigned sv; asm volatile("s_mov_b32 %0, m0\n\ts_mov_b32 m0, %2\n\ts_nop 0\n\tglobal_load_lds_dwordx4 %1, off\n\ts_mov_b32 m0, %0" : "=&s"(sv) : "v"(g), "s"(lds_base) : "memory"); }
DEVI void kload2(bf16x8* kf, lds_cptr kp, int d0) { kf[2 * d0] = *(const LAS bf16x8*)(kp + d0 * 2048); kf[2 * d0 + 1] = *(const LAS bf16x8*)(kp + d0 * 2048 + 512); }
DEVI s16x4 vtr3(lds_cptr p) { typedef short v4i16_t __attribute__((ext_vector_type(4))); return __builtin_bit_cast(s16x4, __builtin_amdgcn_ds_read_tr16_b64_v4i16((LAS v4i16_t*)p)); }
#define MX3(a, b, c) __builtin_fmaxf(__builtin_fmaxf((a), (b)), (c))
DEVI float rowmax(const f32x16& p0, const f32x16& p1) {
    float a = MX3(p0[0], p0[1], p1[0]), b = MX3(p0[2], p0[3], p1[1]); a = MX3(a, p1[2], p1[3]);
#pragma unroll
    for (int r = 4; r < 16; r += 4) { a = MX3(a, p0[r], p0[r + 1]); b = MX3(b, p0[r + 2], p0[r + 3]); a = MX3(a, p1[r], p1[r + 1]); b = MX3(b, p1[r + 2], p1[r + 3]); }
    float m = __builtin_fmaxf(a, b); auto rr = __builtin_amdgcn_permlane32_swap(__float_as_uint(m), __float_as_uint(m), false, false);
    return __builtin_fmaxf(__uint_as_float(rr[0]), __uint_as_float(rr[1])); }
DEVI void cmask(f32x16& p0, f32x16& p1, int jb, int qrel, int hi) {
    const int kb = 64 * jb + 4 * hi;
#pragma unroll
    for (int r = 0; r < 16; ++r) { const int kv = kb + (r & 3) + 8 * (r >> 2); if (kv > qrel) p0[r] = -INFINITY; if (kv + 32 > qrel) p1[r] = -INFINITY; } }

DEVI void attn_unit(const P& p, int b, int h, int qb, char* lds) {
    const int tid = tid_(), lane = tid & 63, r32 = lane & 31, hi = lane >> 5; const int wid = __builtin_amdgcn_readfirstlane(tid >> 6);
    const bf16_t* Qb = (const bf16_t*)(WS(p) + OFF_Q); const bf16_t* Kb = (const bf16_t*)(WS(p) + OFF_K); const bf16_t* Vb = (const bf16_t*)(WS(p) + OFF_VV); bf16_t* Yb = (bf16_t*)(WS(p) + OFF_CAT) + CAT_YB;
    const size_t rowbase = (size_t)b * S_; const int q0 = qb * 256, NT = 4 * qb + 4;
    bf16x8 qr[6];
    { const size_t tq = rowbase + q0 + wid * 32 + r32; const bf16_t* qp = Qb + tq * 768 + h * 96 + hi * 8; const float rs = ((const float*)(WS(p) + OFF_RS))[tq]; const float sc = rs * C2F;
      const float* rp = (const float*)(WS(p) + OFF_ROPE) + tq * 32 + hi * 8;
      u32x4 raw[6];
#pragma unroll
      for (int d0 = 0; d0 < 6; ++d0) raw[d0] = *(const u32x4*)(qp + d0 * 16);
#pragma unroll
      for (int d0 = 0; d0 < 4; ++d0) { u32x4 w;
#pragma unroll
          for (int j = 0; j < 4; ++j) w[j] = cvtpk(bflo(raw[d0][j]) * sc, bfhi(raw[d0][j]) * sc);
          qr[d0] = __builtin_bit_cast(bf16x8, w); }
      u32x4 w1, w2;
#pragma unroll
      for (int j = 0; j < 4; ++j) { const float a0 = bflo(raw[4][j]), a1 = bfhi(raw[4][j]), b0 = bflo(raw[5][j]), b1 = bfhi(raw[5][j]);
          const float c0 = rp[2 * j], c1 = rp[2 * j + 1], s0 = rp[16 + 2 * j], s1 = rp[16 + 2 * j + 1];
          w1[j] = cvtpk((a0 * c0 - b0 * s0) * sc, (a1 * c1 - b1 * s1) * sc); w2[j] = cvtpk((b0 * c0 + a0 * s0) * sc, (b1 * c1 + a1 * s1) * sc); }
      qr[4] = __builtin_bit_cast(bf16x8, w1); qr[5] = __builtin_bit_cast(bf16x8, w2); }
    const unsigned lds0 = (unsigned)(uintptr_t)lds; float* wsf = (float*)(lds + LDS_WS) + wid * 64;
    const bf16_t* Kg = Kb + rowbase * 768 + h * 96; const bf16_t* Vg = Vb + rowbase * 512 + h * 64;
    const bf16_t* ksrc1 = Kg + (size_t)lane * 768 + wid * 8; const bf16_t* ksrc2 = Kg + (size_t)lane * 768 + (8 + (wid & 3)) * 8;
    const bf16_t* vsrc = Vg + (size_t)(16 * (wid & 3) + (lane >> 2)) * 512 + (wid >> 2) * 32 + (lane & 3) * 8;
    const bool w03 = wid < 4;
    const unsigned kdst1 = lds0 + LDS_K + wid * 1024, kdst2 = lds0 + LDS_K + (8 + (wid & 3)) * 1024, vdst = lds0 + LDS_V + wid * 1024;
#define RFL(x) ((unsigned)__builtin_amdgcn_readfirstlane((int)(x)))
#define DMA_K(t, sl) do { glds16(ksrc1 + (size_t)(t) * 64 * 768, RFL(kdst1 + (sl) * KSLOT)); if (w03) glds16(ksrc2 + (size_t)(t) * 64 * 768, RFL(kdst2 + (sl) * KSLOT)); } while (0)
#define DMA_V(t, sl) glds16(vsrc + (size_t)(t) * 64 * 512, RFL(vdst + (sl) * VSLOT))
    const lds_cptr vp0 = (lds_cptr)lds + LDS_V + ((lane >> 4) & 1) * 32 + (lane & 3) * 8 + (4 * hi + ((lane & 15) >> 2)) * 64;
    const lds_cptr kp0 = (lds_cptr)lds + LDS_K + hi * 1024 + r32 * 16;
    DMA_K(0, 0); DMA_V(0, 0); DMA_K(1, 1); DMA_K(2, 2);
    float mhat = 0.f, l_reg = 0.f; f32x16 o[2];
#pragma unroll
    for (int r = 0; r < 16; ++r) { o[0][r] = 0.f; o[1][r] = 0.f; }
    const f32x16 zero16 = o[0];
    f32x16 negm = o[0]; asm volatile("" : "+v"(negm));
    const int qrel = wid * 32 + r32; bool resc = false;
    f32x16 pA0, pA1, pB0, pB1; bf16x8 kf[12]; s16x4 vlo[8], vhi[8]; u32x4 pw0, pw1, pw2, pw3;
    int sl_prev = 0, sl_cur = 0, sl_next = 1;
#define ROT() do { sl_prev = sl_cur; sl_cur = sl_next; sl_next = (sl_next == 2) ? 0 : sl_next + 1; } while (0)
#define EX(v) __builtin_amdgcn_exp2f(v)
#define RESC() do { if (resc) { _Pragma("unroll") for (int d_ = 0; d_ < 2; ++d_) _Pragma("unroll") for (int r = 0; r < 16; ++r) o[d_][r] *= wsf[crow(r, hi)]; } } while (0)
    if (wid >= 4) __builtin_amdgcn_s_setprio(1);
    WAIT_BAR2(5, 3);
    _Pragma("unroll") for (int d0 = 0; d0 < 6; ++d0) kload2(kf, kp0, d0);
    pA0 = MFMA32(kf[0], qr[0], zero16); pA1 = MFMA32(kf[1], qr[0], zero16);
    _Pragma("unroll") for (int d0 = 1; d0 < 6; ++d0) { pA0 = MFMA32(kf[2 * d0], qr[d0], pA0); pA1 = MFMA32(kf[2 * d0 + 1], qr[d0], pA1); }
    if (NT == 4) cmask(pA0, pA1, 0, qrel, hi);
    { const float rm = rowmax(pA0, pA1); mhat = rm;
#pragma unroll
      for (int r = 0; r < 16; ++r) { pA0[r] = EX(pA0[r] - rm); pA1[r] = EX(pA1[r] - rm); negm[r] = -rm; }
      asm volatile("" : "+v"(negm)); }
    WAIT_BAR(0);
    DMA_K(3, 0); DMA_V(1, 1); ROT();
    _Pragma("unroll") for (int d0 = 0; d0 < 6; ++d0) kload2(kf, kp0 + sl_cur * KSLOT, d0);
    WAIT_BAR2(3, 2);
#define PKW(P, i) cvtpk_a(P[i], P[i + 1])
#define PAF(k) __builtin_bit_cast(bf16x8, pw##k)
#define VFR(i) (bf16x8){vlo[i][0], vlo[i][1], vlo[i][2], vlo[i][3], vhi[i][0], vhi[i][1], vhi[i][2], vhi[i][3]}
#define VRD(i) do { vlo[i] = vtr3(vp_ + (((i) >> 2) * 4096 + ((i) & 3) * 1024)); vhi[i] = vtr3(vp_ + (((i) >> 2) * 4096 + ((i) & 3) * 1024 + 512)); } while (0)
#define KRD(G, d0) do { if (G) { kload2(kf, kp0 + sl_next * KSLOT, d0); SBAR(); } } while (0)
#define GAPA(MF, a0, a1, a2, a3, W0, W1, PW) do { MF; sacc += a0; sacc += a1; sacc += a2; sacc += a3; W0; W1; PIN(PW); PIN(sacc); SBAR(); } while (0)
#define GAPB(MF, X, i) do { MF; X[i] = EX(X[i]); X[i + 1] = EX(X[i + 1]); X[i + 2] = EX(X[i + 2]); X[i + 3] = EX(X[i + 3]); PIN(X); SBAR(); } while (0)
#define STEP(C0, C1, P0, P1, t, MASK, GK, GV, GL) do { SBAR(); \
    const lds_cptr vp_ = vp0 + sl_prev * VSLOT; \
    VRD(0); SBAR(); float sacc = P0[0] + P0[1]; \
                    GAPA(C0 = MFMA32(kf[0], qr[0], negm), P0[2], P0[3], P0[4], P0[5],     pw0[0] = PKW(P0, 0),  pw0[1] = PKW(P0, 2),  pw0); \
    VRD(4); SBAR(); GAPA(C1 = MFMA32(kf[1], qr[0], negm), P0[6], P0[7], P0[8], P0[9],     pw0[2] = PKW(P0, 4),  pw0[3] = PKW(P0, 6),  pw0); \
    VRD(1); SBAR(); GAPA(C0 = MFMA32(kf[2], qr[1], C0),    P0[10], P0[11], P0[12], P0[13], pw1[0] = PKW(P0, 8),  pw1[1] = PKW(P0, 10), pw1); \
    VRD(5); SBAR(); GAPA(C1 = MFMA32(kf[3], qr[1], C1),    P0[14], P0[15], P1[0], P1[1],   pw1[2] = PKW(P0, 12), pw1[3] = PKW(P0, 14), pw1); \
                    GAPA(C0 = MFMA32(kf[4], qr[2], C0),    P1[2], P1[3], P1[4], P1[5],     pw2[0] = PKW(P1, 0),  pw2[1] = PKW(P1, 2),  pw2); \
                    GAPA(C1 = MFMA32(kf[5], qr[2], C1),    P1[6], P1[7], P1[8], P1[9],     pw2[2] = PKW(P1, 4),  pw2[3] = PKW(P1, 6),  pw2); \
                    GAPA(C0 = MFMA32(kf[6], qr[3], C0),    P1[10], P1[11], P1[12], P1[13], pw3[0] = PKW(P1, 8),  pw3[1] = PKW(P1, 10), pw3); \
                    GAPA(C1 = MFMA32(kf[7], qr[3], C1),    P1[14], P1[15], 0.f, 0.f,       pw3[2] = PKW(P1, 12), pw3[3] = PKW(P1, 14), pw3); \
    KRD(GL, 0); C0 = MFMA32(kf[8], qr[4], C0); SBAR(); KRD(GL, 1); C1 = MFMA32(kf[9], qr[4], C1); SBAR(); KRD(GL, 2); C0 = MFMA32(kf[10], qr[5], C0); SBAR(); KRD(GL, 3); C1 = MFMA32(kf[11], qr[5], C1); SBAR();     \
    l_reg += sacc; \
    if (GK) DMA_K((t) + 3, sl_cur); if (GV) DMA_V((t) + 1, sl_next);                                                       \
    if (MASK) cmask(C0, C1, (t) - (NT - 4), qrel, hi); \
    { const float rm = rowmax(C0, C1); resc = false;                                                                        \
      if (__builtin_expect(__any(rm > (float)A9_THR), 0)) { const float dl = __builtin_fmaxf(rm, 0.f); mhat += dl;          \
          _Pragma("unroll") for (int r = 0; r < 16; ++r) { C0[r] -= dl; C1[r] -= dl; negm[r] = -mhat; } asm volatile("" : "+v"(negm)); \
          const float f = __builtin_amdgcn_exp2f(-dl); l_reg *= f; if (hi == 0) wsf[r32] = f; resc = true; } } \
    SBAR(); \
    VRD(2); SBAR(); GAPB(o[0] = MFMA32(PAF(0), VFR(0), o[0]), C0, 0);              VRD(6); SBAR(); GAPB(o[1] = MFMA32(PAF(0), VFR(4), o[1]), C0, 4);                \
    VRD(3); SBAR(); GAPB(o[0] = MFMA32(PAF(1), VFR(1), o[0]), C0, 8);  VRD(7); SBAR(); GAPB(o[1] = MFMA32(PAF(1), VFR(5), o[1]), C0, 12); \
    GAPB(o[0] = MFMA32(PAF(2), VFR(2), o[0]), C1, 0);  GAPB(o[1] = MFMA32(PAF(2), VFR(6), o[1]), C1, 4); \
    KRD(GL, 4); GAPB(o[0] = MFMA32(PAF(3), VFR(3), o[0]), C1, 8);  KRD(GL, 5); GAPB(o[1] = MFMA32(PAF(3), VFR(7), o[1]), C1, 12); \
    } while (0)
    int t = 1;
    for (; t + 5 < NT; t += 2) {
        STEP(pB0, pB1, pA0, pA1, t, false, true, true, true);     WAIT_BAR2(3, 2); RESC(); ROT();
        STEP(pA0, pA1, pB0, pB1, t + 1, false, true, true, true); WAIT_BAR2(3, 2); RESC(); ROT();
    }
#define ENDW(tt) do { if ((tt) + 3 < NT) { WAIT_BAR2(3, 2); } else if ((tt) + 2 < NT) { WAIT_BAR(1); } else { WAIT_BAR(0); } } while (0)
    for (; t + 1 < NT; t += 2) {
        STEP(pB0, pB1, pA0, pA1, t, true, (t + 3 < NT), (t + 1 < NT), (t + 1 < NT));         ENDW(t);     RESC(); ROT();
        STEP(pA0, pA1, pB0, pB1, t + 1, true, (t + 4 < NT), (t + 2 < NT), (t + 2 < NT));     ENDW(t + 1); RESC(); ROT();
    }
    STEP(pB0, pB1, pA0, pA1, NT - 1, true, false, false, false); RESC();
    { float sacc = pB0[0] + pB0[1];
#pragma unroll
      for (int r = 2; r < 16; ++r) sacc += pB0[r];
#pragma unroll
      for (int r = 0; r < 16; ++r) sacc += pB1[r];
      l_reg += sacc;
      pw0 = (u32x4){PKW(pB0, 0), PKW(pB0, 2), PKW(pB0, 4), PKW(pB0, 6)}; pw1 = (u32x4){PKW(pB0, 8), PKW(pB0, 10), PKW(pB0, 12), PKW(pB0, 14)};
      pw2 = (u32x4){PKW(pB1, 0), PKW(pB1, 2), PKW(pB1, 4), PKW(pB1, 6)}; pw3 = (u32x4){PKW(pB1, 8), PKW(pB1, 10), PKW(pB1, 12), PKW(pB1, 14)};
      const lds_cptr vp_ = vp0 + sl_cur * VSLOT; _Pragma("unroll") for (int i = 0; i < 8; ++i) VRD(i);
      o[0] = MFMA32(PAF(0), VFR(0), o[0]); o[1] = MFMA32(PAF(0), VFR(4), o[1]); o[0] = MFMA32(PAF(1), VFR(1), o[0]); o[1] = MFMA32(PAF(1), VFR(5), o[1]);
      o[0] = MFMA32(PAF(2), VFR(2), o[0]); o[1] = MFMA32(PAF(2), VFR(6), o[1]); o[0] = MFMA32(PAF(3), VFR(3), o[0]); o[1] = MFMA32(PAF(3), VFR(7), o[1]); }
    { auto rr = __builtin_amdgcn_permlane32_swap(__float_as_uint(l_reg), __float_as_uint(l_reg), false, false); l_reg = __uint_as_float(rr[0]) + __uint_as_float(rr[1]); }
    if (hi == 0) wsf[32 + r32] = l_reg; asm volatile("s_waitcnt lgkmcnt(0)" ::: "memory");
    float rli[16];
#pragma unroll
    for (int r = 0; r < 16; ++r) rli[r] = __builtin_amdgcn_rcpf(wsf[32 + crow(r, hi)]);
    bf16_t* Ow = Yb + (rowbase + q0 + wid * 32) * 1024 + h * 64; bf16_t* stg = (bf16_t*)(lds + LDS_OST) + wid * 2048;
#pragma unroll
    for (int r = 0; r < 16; ++r) { const int orow = crow(r, hi);
#pragma unroll
        for (int d0 = 0; d0 < 2; ++d0) stg[orow * 64 + d0 * 32 + r32] = f2bf(o[d0][r] * rli[r]); }
    asm volatile("s_waitcnt lgkmcnt(0)" ::: "memory");
#pragma unroll
    for (int i = 0; i < 4; ++i) { const int row = i * 8 + (lane >> 3), ch = lane & 7; *(u32x4*)(Ow + (size_t)row * 1024 + ch * 8) = *(const u32x4*)(stg + row * 64 + ch * 8); }
    __builtin_amdgcn_s_setprio(0);
    asm volatile("s_waitcnt lgkmcnt(0)\n\ts_barrier" ::: "memory");
#undef RFL
#undef DMA_K
#undef DMA_V
#undef ROT
#undef EX
#undef RESC
#undef PKW
#undef PAF
#undef VFR
#undef VRD
#undef KRD
#undef ENDW
#undef GAPA
#undef GAPB
#undef STEP
}
#undef SBAR
#undef PIN
#undef WAIT_BAR
#undef WAIT_BAR2
#undef MX3
}
static_assert(at96::LDS_NEED <= LDS_BYTES - 16, "attention LDS");
#ifndef ATTN_SIMPLE
#define ATTN_SIMPLE 0
#endif
DEVI void phase_attn(const P& p, char* lds) {
    for (int v0 = blockIdx.x; v0 < 256; v0 += gridDim.x) {
        const int v = (gridDim.x == 256) ? ((v0 & 7) * 32 + (v0 >> 3)) : v0;
        const int bh = v >> 4, s = v & 15;
#pragma unroll 1
        for (int i = 0; i < 4; ++i) { const int qb = (i == 0) ? s : (i == 1) ? 31 - s : (i == 2) ? 32 + s : 63 - s; if (ATTN_SIMPLE) attn_unit(p, bh >> 3, bh & 7, qb, lds); else at96::attn_unit(p, bh >> 3, bh & 7, qb, lds); }
    }
}
DEVI void phase_merge(const P& p, int l, char* lds) {
    const int lane = tid_() & 63, wid = tid_() >> 6, wm = wid >> 1, wn = wid & 1, fr = lane & 15, fq = lane >> 4;
    const unsigned char* wl = WS(p) + OFF_W + (size_t)l * W_LAYER; const bf16_t* z = (const bf16_t*)(WS(p) + OFF_Z); bf16_t* mg = (bf16_t*)(WS(p) + OFF_H);
    for (int u = blockIdx.x; u < 128 * 8; u += gridDim.x) {
        const int pm = u >> 3, pn = u & 7;
        f32x4 tot[4][4]; acc_zero(tot);
#pragma unroll 1
        for (int seg = 0; seg < 3; ++seg) {
            const int koff = (seg == 0) ? CAT_YA : (seg == 1) ? CAT_YB : CAT_PRE, K = (seg == 1) ? 512 : 256;
            const bf16_t* A = (const bf16_t*)(WS(p) + OFF_CAT) + koff; const bf16_t* Bt = (const bf16_t*)(wl + W_A) + koff;
            f32x4 acc[4][4]; acc_zero(acc);
            gemm_kloop(acc, A + (size_t)pm * 256 * 1024, 1024, Bt + (size_t)pn * 128 * 1024, 1024, K, lds);
#pragma unroll
            for (int m = 0; m < 4; ++m)
#pragma unroll
                for (int n = 0; n < 4; ++n) { const int row = pm * 256 + wm * 64 + m * 16 + fr, col = pn * 128 + wn * 64 + n * 16 + 4 * fq;
                    const f32x4 gt = ld_bf4(z + (size_t)row * ZC + Z_G + seg * 1024 + col); tot[m][n] = tot[m][n] + gt * acc[m][n]; }
        }
#pragma unroll
        for (int m = 0; m < 4; ++m)
#pragma unroll
            for (int n = 0; n < 4; ++n) { const int row = pm * 256 + wm * 64 + m * 16 + fr, col = pn * 128 + wn * 64 + n * 16 + 4 * fq; st_bf4(mg + (size_t)row * DM + col, tot[m][n]); }
    }
}
DEVI int f2key(float f) { const int b = __float_as_int(f); return b ^ ((b >> 31) & 0x7fffffff); }
DEVI float key2f(int k) { return __int_as_float(k ^ ((k >> 31) & 0x7fffffff)); }
DEVI int med3i(int a, int b, int c) { int r; asm("v_med3_i32 %0, %1, %2, %3" : "=v"(r) : "v"(a), "v"(b), "v"(c)); return r; }
#define INS16(L, xin) do { const int x_ = (xin); _Pragma("unroll") for (int i_ = 15; i_ > 0; --i_) L[i_] = med3i(L[i_ - 1], L[i_], x_); L[0] = max(L[0], x_); } while (0)
#define CS(K, i, j) do { const int a_ = K[i], b_ = K[j]; K[i] = max(a_, b_); K[j] = min(a_, b_); } while (0)
#define SORT16(K) do { CS(K,0,1); CS(K,2,3); CS(K,0,2); CS(K,1,3); CS(K,1,2); CS(K,4,5); CS(K,6,7); CS(K,4,6); CS(K,5,7); CS(K,5,6); CS(K,0,4); CS(K,2,6); CS(K,2,4); CS(K,1,5); CS(K,3,7); CS(K,3,5); CS(K,1,2); CS(K,3,4); CS(K,5,6); CS(K,8,9); CS(K,10,11); CS(K,8,10); CS(K,9,11); CS(K,9,10); CS(K,12,13); CS(K,14,15); CS(K,12,14); CS(K,13,15); CS(K,13,14); CS(K,8,12); CS(K,10,14); CS(K,10,12); CS(K,9,13); CS(K,11,15); CS(K,11,13); CS(K,9,10); CS(K,11,12); CS(K,13,14); CS(K,0,8); CS(K,4,12); CS(K,4,8); CS(K,2,10); CS(K,6,14); CS(K,6,10); CS(K,2,4); CS(K,6,8); CS(K,10,12); CS(K,1,9); CS(K,5,13); CS(K,5,9); CS(K,3,11); CS(K,7,15); CS(K,7,11); CS(K,3,5); CS(K,7,9); CS(K,11,13); CS(K,1,2); CS(K,3,4); CS(K,5,6); CS(K,7,8); CS(K,9,10); CS(K,11,12); CS(K,13,14); } while (0)
#define BM16(K) do { CS(K,0,8); CS(K,1,9); CS(K,2,10); CS(K,3,11); CS(K,4,12); CS(K,5,13); CS(K,6,14); CS(K,7,15); CS(K,0,4); CS(K,1,5); CS(K,2,6); CS(K,3,7); CS(K,8,12); CS(K,9,13); CS(K,10,14); CS(K,11,15); CS(K,0,2); CS(K,1,3); CS(K,4,6); CS(K,5,7); CS(K,8,10); CS(K,9,11); CS(K,12,14); CS(K,13,15); CS(K,0,1); CS(K,2,3); CS(K,4,5); CS(K,6,7); CS(K,8,9); CS(K,10,11); CS(K,12,13); CS(K,14,15); } while (0)
#define MERGE16(A, B) do { _Pragma("unroll") for (int i_ = 0; i_ < 16; ++i_) A[i_] = max(A[i_], B[15 - i_]); BM16(A); } while (0)
DEVI void phase_topk(const P& p) {
    const float* sT = (const float*)(WS(p) + OFF_Z); int* eidx = (int*)(WS(p) + OFF_EIDX); float* gw = (float*)(WS(p) + OFF_VN);
    for (int wi = blockIdx.x * NTHR + tid_(); wi < 8 * T_; wi += gridDim.x * NTHR) {
        const int h = wi >> 15, t = wi & (T_ - 1);
        int L1[16], L2[16];
#pragma unroll
        for (int i = 0; i < 16; ++i) { L1[i] = (int)0x80000000; L2[i] = (int)0x80000000; }
        const float* s1 = sT + (size_t)(h * 256) * T_ + t; const float* s2 = s1 + (size_t)128 * T_;
        float ca[16], cb[16];
#pragma unroll
        for (int i = 0; i < 16; ++i) { ca[i] = s1[(size_t)i * T_]; cb[i] = s2[(size_t)i * T_]; }
#pragma unroll 1
        for (int kc = 0; kc < 8; ++kc) {
            float na[16], nb[16]; const int kn = (kc < 7) ? (kc + 1) * 16 : 0;
#pragma unroll
            for (int i = 0; i < 16; ++i) { na[i] = s1[(size_t)(kn + i) * T_]; nb[i] = s2[(size_t)(kn + i) * T_]; }
#pragma unroll
            for (int i = 0; i < 16; ++i) { const int k = kc * 16 + i; const int a = (f2key(ca[i]) & ~127) | (127 - k), b = (f2key(cb[i]) & ~127) | (127 - k); INS16(L1, a); INS16(L2, b); }
#pragma unroll
            for (int i = 0; i < 16; ++i) { ca[i] = na[i]; cb[i] = nb[i]; }
        }
        float v1[16], v2[16];
#pragma unroll
        for (int i = 0; i < 16; ++i) { v1[i] = key2f(L1[i] & ~127); v2[i] = key2f(L2[i] & ~127); }
        int C[16];
#pragma unroll
        for (int i = 0; i < 16; ++i) C[i] = (int)0x80000000;
#pragma unroll
        for (int a = 0; a < 16; ++a)
#pragma unroll
            for (int b = 0; b < 16; ++b) if ((a + 1) * (b + 1) <= 16) { const int kx = (f2key(v1[a] + v2[b]) & ~255) | (255 - (a * 16 + b)); INS16(C, kx); }
        float tv[16]; int te[16];
#pragma unroll
        for (int i = 0; i < 16; ++i) { const int pos = 255 - (C[i] & 255), a = pos >> 4, b = pos & 15; int ka = 0, kb = 0;
#pragma unroll
            for (int j = 0; j < 16; ++j) { ka = (a == j) ? L1[j] : ka; kb = (b == j) ? L2[j] : kb; }
            te[i] = (127 - (ka & 127)) * 128 + (127 - (kb & 127)); tv[i] = key2f(ka & ~127) + key2f(kb & ~127); }
        float sum = 0.f; const float tmax = tv[0];
#pragma unroll
        for (int i = 0; i < 16; ++i) { tv[i] = fexp2((tv[i] - tmax) * 1.4426950408889634f); sum += tv[i]; }
        const float inv = 1.f / sum;
        int* eo = eidx + (size_t)t * 128 + h * 16; float* go = gw + (size_t)t * 128 + h * 16;
#pragma unroll
        for (int i = 0; i < 16; i += 4) { *(int4*)(eo + i) = make_int4(te[i], te[i + 1], te[i + 2], te[i + 3]); *(f32x4*)(go + i) = (f32x4){tv[i] * inv, tv[i + 1] * inv, tv[i + 2] * inv, tv[i + 3] * inv}; }
    }
}
DEVI void topk_finish(const int (&L1)[16], const int (&L2)[16], int t, int h, int* eidx, float* gw, LAS int* sm = nullptr) {
    float v1[16], v2[16];
#pragma unroll
    for (int i = 0; i < 16; ++i) { v1[i] = key2f(L1[i] & ~127); v2[i] = key2f(L2[i] & ~127); }
#define TK_KX(a, b) ((f2key(v1[a] + v2[b]) & ~255) | (255 - ((a) * 16 + (b))))
    int C[16]; float tv[16]; int te[16];
    if (PEERK_NET && sm) {
        int Y1[16], Y2[16];
#pragma unroll
        for (int b = 0; b < 16; ++b) C[b] = TK_KX(0, b);
#pragma unroll
        for (int b = 0; b < 8; ++b) { Y1[b] = TK_KX(1, b); Y1[8 + b] = TK_KX(15 - b, 0); }
        BM16(Y1);
        Y2[0] = TK_KX(2, 0); Y2[1] = TK_KX(2, 1); Y2[2] = TK_KX(2, 2); Y2[3] = TK_KX(2, 3); Y2[4] = TK_KX(2, 4); Y2[5] = TK_KX(3, 0); Y2[6] = TK_KX(3, 1); Y2[7] = TK_KX(3, 2); Y2[8] = TK_KX(3, 3);
        Y2[9] = TK_KX(4, 0); Y2[10] = TK_KX(4, 1); Y2[11] = TK_KX(4, 2); Y2[12] = TK_KX(5, 0); Y2[13] = TK_KX(5, 1); Y2[14] = TK_KX(6, 0); Y2[15] = TK_KX(6, 1);
        SORT16(Y2);
        MERGE16(C, Y1); MERGE16(C, Y2);
        { const int k0 = TK_KX(7, 0), k1 = TK_KX(7, 1); INS16(C, k0); INS16(C, k1); }
#pragma unroll
        for (int j = 0; j < 16; ++j) { sm[j * 64] = L1[j]; sm[(16 + j) * 64] = L2[j]; }
#pragma unroll
        for (int i = 0; i < 16; ++i) { const int pos = 255 - (C[i] & 255), a = pos >> 4, b = pos & 15; const int ka = sm[a * 64], kb = sm[(16 + b) * 64];
            te[i] = (127 - (ka & 127)) * 128 + (127 - (kb & 127)); tv[i] = key2f(ka & ~127) + key2f(kb & ~127); }
    } else {
#pragma unroll
    for (int i = 0; i < 16; ++i) C[i] = (int)0x80000000;
#pragma unroll
    for (int a = 0; a < 16; ++a)
#pragma unroll
        for (int b = 0; b < 16; ++b) if ((a + 1) * (b + 1) <= 16) { const int kx = TK_KX(a, b); INS16(C, kx); }
#pragma unroll
    for (int i = 0; i < 16; ++i) { const int pos = 255 - (C[i] & 255), a = pos >> 4, b = pos & 15; int ka = 0, kb = 0;
#pragma unroll
        for (int j = 0; j < 16; ++j) { ka = (a == j) ? L1[j] : ka; kb = (b == j) ? L2[j] : kb; }
        te[i] = (127 - (ka & 127)) * 128 + (127 - (kb & 127)); tv[i] = key2f(ka & ~127) + key2f(kb & ~127); }
    }
#undef TK_KX
    float sum = 0.f; const float tmax = tv[0];
#pragma unroll
    for (int i = 0; i < 16; ++i) { tv[i] = fexp2((tv[i] - tmax) * 1.4426950408889634f); sum += tv[i]; }
    const float inv = 1.f / sum;
    int* eo = eidx + (size_t)t * 128 + h * 16; float* go = gw + (size_t)t * 128 + h * 16;
#pragma unroll
    for (int i = 0; i < 16; i += 4) { *(int4*)(eo + i) = make_int4(te[i], te[i + 1], te[i + 2], te[i + 3]); *(f32x4*)(go + i) = (f32x4){tv[i] * inv, tv[i + 1] * inv, tv[i + 2] * inv, tv[i + 3] * inv}; }
}
DEVI void phase_peerk(const P& p, int l, char* lds, int v = -1) {
    const int tid = tid_(), lane = tid & 63, wid = tid >> 6, r32 = lane & 31, hi = lane >> 5;
    constexpr int KP = 136;
    const bf16_t* qp = (const bf16_t*)(WS(p) + OFF_Q); const bf16_t* SK = (const bf16_t*)(WS(p) + OFF_W + (size_t)l * W_LAYER + W_SK);
    int* eidx = (int*)(WS(p) + OFF_EIDX); float* gw = (float*)(WS(p) + OFF_VN);
    const int nit = (v >= 0) ? 2 : (8 * (T_ / 512) - (int)blockIdx.x + (int)gridDim.x - 1) / (int)gridDim.x;
    bf16_t* ks = (bf16_t*)lds;
    for (int it_ = 0; it_ < nit; ++it_) {
        int h, jg; if (v >= 0) pg8::PairOrder::item(v, it_, h, jg); else { const int item = (int)blockIdx.x + it_ * (int)gridDim.x; h = item & 7; jg = item >> 3; }
        const int t0 = jg * 512 + wid * 64;
        __syncthreads();
#pragma unroll
        for (int i = 0; i < 8; ++i) { const int id = tid + i * NTHR, row = id >> 4, c8 = (id & 15) * 8; *(u32x4*)(ks + row * KP + c8) = *(const u32x4*)(SK + (size_t)(h * 256 + row) * 128 + c8); }
        __syncthreads();
        int M0[16], M1[16];
#pragma unroll
        for (int i = 0; i < 16; ++i) { M0[i] = (int)0x80000000; M1[i] = (int)0x80000000; }
#pragma unroll 1
        for (int tile = 0; tile < 2; ++tile) {
            int La[16], Lb[16];
#define PK_HALF(LL, pp) do { \
                _Pragma("unroll") for (int i = 0; i < 16; ++i) LL[i] = (int)0x80000000; \
                const bf16_t* qrow = qp + (size_t)(t0 + tile * 32 + r32) * 2048 + (h * 2 + (pp)) * 128 + hi * 8; \
                const bf16_t* krow = ks + ((pp) * 128 + r32) * KP + hi * 8; \
                bf16x8 qf[8]; \
                _Pragma("unroll") for (int ds = 0; ds < 8; ++ds) qf[ds] = *(const bf16x8*)(qrow + ds * 16); \
                _Pragma("unroll") for (int kp = 0; kp < 2; ++kp) { f32x16 acc0, acc1; \
                    _Pragma("unroll") for (int r = 0; r < 16; ++r) { acc0[r] = 0.f; acc1[r] = 0.f; } \
                    _Pragma("unroll") for (int ds = 0; ds < 8; ++ds) { \
                        acc0 = MFMA32(*(const bf16x8*)(krow + (2 * kp) * 32 * KP + ds * 16), qf[ds], acc0); acc1 = MFMA32(*(const bf16x8*)(krow + (2 * kp + 1) * 32 * KP + ds * 16), qf[ds], acc1); } \
                    if (PEERK_NET) { int K0[16], K1[16]; \
                        _Pragma("unroll") for (int r = 0; r < 16; ++r) { const int kc = 127 - kp * 64 - ((r & 3) + 8 * (r >> 2)) - 4 * hi; K0[r] = (f2key(acc0[r]) & ~127) | kc; K1[r] = (f2key(acc1[r]) & ~127) | (kc - 32); } \
                        SORT16(K0); SORT16(K1); MERGE16(K0, K1); \
                        if (kp == 0) { _Pragma("unroll") for (int i = 0; i < 16; ++i) LL[i] = K0[i]; } else { MERGE16(LL, K0); } \
                    } else { \
                    _Pragma("unroll") for (int r = 0; r < 16; ++r) { const int kc = 127 - kp * 64 - ((r & 3) + 8 * (r >> 2)) - 4 * hi; \
                        { const int a = (f2key(acc0[r]) & ~127) | kc; INS16(LL, a); } { const int a = (f2key(acc1[r]) & ~127) | (kc - 32); INS16(LL, a); } } } \
                    __builtin_amdgcn_sched_barrier(0); } } while (0)
            PK_HALF(La, 0);
            PK_HALF(Lb, 1);
#undef PK_HALF
            int R0[16], R1[16];
#pragma unroll
            for (int i = 0; i < 16; ++i) { R0[i] = xchg32(La[i], hi != 0); R1[i] = xchg32(Lb[i], hi != 0); }
            if (PEERK_NET) { MERGE16(La, R0); MERGE16(Lb, R1); }
            else {
#pragma unroll
            for (int i = 0; i < 16; ++i) { INS16(La, R0[i]); INS16(Lb, R1[i]); } }
            const bool mine = (hi == tile);
#pragma unroll
            for (int i = 0; i < 16; ++i) { M0[i] = mine ? La[i] : M0[i]; M1[i] = mine ? Lb[i] : M1[i]; }
        }
        topk_finish(M0, M1, t0 + hi * 32 + r32, h, eidx, gw);
    }
}
DEVI void phase_peerk2(const P& p, int v, char* lds) {
    const int tid = tid_(), lane = tid & 63, wid = tid >> 6, r32 = lane & 31, hi = lane >> 5;
    const bf16_t* qp = (const bf16_t*)(WS(p) + OFF_Q); int* eidx = (int*)(WS(p) + OFF_EIDX); float* gw = (float*)(WS(p) + OFF_VN);
    for (int it_ = 0; it_ < 2; ++it_) {
        int h, jg; pg8::PairOrder::item(v, it_, h, jg);
        const int t0 = jg * 512 + wid * 64;
        int M0[16], M1[16];
#pragma unroll
        for (int i = 0; i < 16; ++i) { M0[i] = (int)0x80000000; M1[i] = (int)0x80000000; }
#pragma unroll 1
        for (int tile = 0; tile < 2; ++tile) {
            int La[16], Lb[16]; u32x4 wa[8], wb[8];
            { const bf16_t* sp = qp + (size_t)(t0 + tile * 32 + r32) * 2048 + (h * 2) * 128 + hi * 64;
#pragma unroll
              for (int i = 0; i < 8; ++i) { wa[i] = *(const u32x4*)(sp + i * 8); wb[i] = *(const u32x4*)(sp + 128 + i * 8); } }
#define PK2_HALF(LL, W) do { \
                _Pragma("unroll") for (int blk = 0; blk < 4; ++blk) { int K_[16]; \
                    _Pragma("unroll") for (int d = 0; d < 8; ++d) { const unsigned x = W[2 * blk + (d >> 2)][d & 3]; const int ki = hi * 64 + blk * 16 + 2 * d; \
                        K_[2 * d] = (f2key(bflo(x)) & ~127) | (127 - ki); K_[2 * d + 1] = (f2key(bfhi(x)) & ~127) | (126 - ki); } \
                    SORT16(K_); \
                    if (blk == 0) { _Pragma("unroll") for (int i = 0; i < 16; ++i) LL[i] = K_[i]; } else { MERGE16(LL, K_); } } } while (0)
            PK2_HALF(La, wa);
            PK2_HALF(Lb, wb);
#undef PK2_HALF
            int R0[16], R1[16];
#pragma unroll
            for (int i = 0; i < 16; ++i) { R0[i] = xchg32(La[i], hi != 0); R1[i] = xchg32(Lb[i], hi != 0); }
            MERGE16(La, R0); MERGE16(Lb, R1);
            const bool mine = (hi == tile);
#pragma unroll
            for (int i = 0; i < 16; ++i) { M0[i] = mine ? La[i] : M0[i]; M1[i] = mine ? Lb[i] : M1[i]; }
        }
        topk_finish(M0, M1, t0 + hi * 32 + r32, h, eidx, gw, (LAS int*)(lds + wid * 8192) + lane);
    }
}
#if TAB_FP4
typedef u32x2 rowreg_t;
DEVI void cvt16(const u32x2 w, f32x2 (&o)[8]) {
#pragma unroll
    for (int d = 0; d < 2; ++d) { o[4 * d] = __builtin_amdgcn_cvt_scalef32_pk_f32_fp4(w[d], 1.0f, 0); o[4 * d + 1] = __builtin_amdgcn_cvt_scalef32_pk_f32_fp4(w[d], 1.0f, 1);
        o[4 * d + 2] = __builtin_amdgcn_cvt_scalef32_pk_f32_fp4(w[d], 1.0f, 2); o[4 * d + 3] = __builtin_amdgcn_cvt_scalef32_pk_f32_fp4(w[d], 1.0f, 3); }
}
#else
typedef u32x4 rowreg_t;
#endif
DEVI void cvt16(const u32x4 w, f32x2 (&o)[8]) {
#pragma unroll
    for (int i = 0; i < 4; ++i) { o[2 * i] = __builtin_amdgcn_cvt_pk_f32_fp8((int)w[i], false); o[2 * i + 1] = __builtin_amdgcn_cvt_pk_f32_fp8((int)w[i], true); }
}
template <bool DRY> DEVI void phase_gather(const P& p, int l) {
    const int lane = tid_() & 63, wid = tid_() >> 6;
    const bf16_t* h2 = (const bf16_t*)(WS(p) + OFF_H); const int* eidx = (const int*)(WS(p) + OFF_EIDX); const float* gw = (const float*)(WS(p) + OFF_VN);
    const unsigned char* U = WS(p) + OFF_U + (size_t)l * 16384 * ROWB; const unsigned char* V = WS(p) + OFF_V + (size_t)l * 16384 * ROWB;
    const float* SU = (const float*)(WS(p) + OFF_SU) + l * 16384; const float* SV = (const float*)(WS(p) + OFF_SV) + l * 16384;
    const float* g2 = (const float*)(WS(p) + OFF_MOD) + (size_t)l * 2 * 6144 + 5120;
    const bool b5 = (lane & 32) != 0, b4 = (lane & 16) != 0, b3 = (lane & 8) != 0; const int grp = lane >> 3;
    for (int t = blockIdx.x * 8 + wid; t < T_; t += gridDim.x * 8) {
        f32x2 xf[8];
        { const u32x4 a = *(const u32x4*)(h2 + (size_t)t * DM + lane * 16), b = *(const u32x4*)(h2 + (size_t)t * DM + lane * 16 + 8);
#pragma unroll
          for (int j = 0; j < 4; ++j) { xf[j] = (f32x2){bflo(a[j]), bfhi(a[j])}; xf[4 + j] = (f32x2){bflo(b[j]), bfhi(b[j])}; } }
        const int ev0 = eidx[(size_t)t * 128 + lane] & (DRY ? DRY_EMASK : 0x3fff), ev1 = eidx[(size_t)t * 128 + 64 + lane] & (DRY ? DRY_EMASK : 0x3fff);
        const float su0 = SU[ev0], su1 = SU[ev1]; const float gs0 = gw[(size_t)t * 128 + lane] * SV[ev0], gs1 = gw[(size_t)t * 128 + 64 + lane] * SV[ev1];
        f32x2 acc[8];
#pragma unroll
        for (int i = 0; i < 8; ++i) acc[i] = (f32x2){0.f, 0.f};
        rowreg_t ru[8], rv[8];
#define GA_ISSUE(RR, TAB, jbn) do { const int evh_ = ((jbn) < 64) ? ev0 : ev1; const int jl_ = (jbn) & 63; \
            _Pragma("unroll") for (int q = 0; q < 8; ++q) { const int e = __builtin_amdgcn_readlane(evh_, jl_ + q); RR[q] = *(const rowreg_t*)(TAB + (size_t)e * ROWB + lane * (ROWB / 64)); } } while (0)
#define GA_BODY(jb, NEXT) do { \
            const int bidx_ = ((((jb) & 63) + grp) << 2); \
            const float su_ = __int_as_float(__builtin_amdgcn_ds_bpermute(bidx_, __float_as_int(((jb) < 64) ? su0 : su1))); \
            const float gs_ = __int_as_float(__builtin_amdgcn_ds_bpermute(bidx_, __float_as_int(((jb) < 64) ? gs0 : gs1))); \
            float d[8]; \
            _Pragma("unroll") for (int q = 0; q < 8; ++q) { f32x2 uf[8]; cvt16(ru[q], uf); f32x2 s2 = uf[0] * xf[0]; \
                _Pragma("unroll") for (int i = 1; i < 8; ++i) s2 = s2 + uf[i] * xf[i]; \
                d[q] = s2[0] + s2[1]; } \
            if (NEXT) GA_ISSUE(ru, U, (jb) + 8); \
              \
            float e4[4], f2[2], gq; \
            _Pragma("unroll") for (int i = 0; i < 4; ++i) e4[i] = swap32_sum(d[i], d[i + 4]); \
            _Pragma("unroll") for (int i = 0; i < 2; ++i) f2[i] = swap16_sum(e4[i], e4[i + 2]); \
            { const float snd = b3 ? f2[0] : f2[1], kp = b3 ? f2[1] : f2[0]; gq = kp + DPPF(snd, DPP_ROR8); } \
            gq += DPPF(gq, DPP_QX1); gq += DPPF(gq, DPP_QX2); gq += DPPF(gq, DPP_HMIR); \
            const float wq = gs_ * gelu_tanh(gq * su_); \
            _Pragma("unroll") for (int q = 0; q < 8; ++q) { const float w = __uint_as_float((unsigned)__builtin_amdgcn_readlane((int)__float_as_uint(wq), q * 8)); const f32x2 w2 = (f32x2){w, w}; f32x2 vf[8]; cvt16(rv[q], vf); \
                _Pragma("unroll") for (int i = 0; i < 8; ++i) acc[i] = acc[i] + w2 * vf[i]; } \
            if (NEXT) GA_ISSUE(rv, V, (jb) + 8); } while (0)
        GA_ISSUE(ru, U, 0); GA_ISSUE(rv, V, 0);
#pragma unroll 1
        for (int jb = 0; jb < 120; jb += 8) GA_BODY(jb, true);
        GA_BODY(120, false);
#undef GA_ISSUE
#undef GA_BODY
        if (DRY) { if (acc[0][0] == 1.2345e30f) XR(p)[0] = acc[1][0]; continue; }
        float* xp = XR(p) + (size_t)t * DM + lane * 16; const float* gp = g2 + ((t >= S_) ? 6144 : 0) + lane * 16;
        f32x4 xn[4]; float ss = 0.f;
#pragma unroll
        for (int q = 0; q < 4; ++q) { f32x4 xv = *(const f32x4*)(xp + q * 4); const f32x4 gv = *(const f32x4*)(gp + q * 4);
            xv[0] += gv[0] * acc[2 * q][0]; xv[1] += gv[1] * acc[2 * q][1]; xv[2] += gv[2] * acc[2 * q + 1][0]; xv[3] += gv[3] * acc[2 * q + 1][1]; xn[q] = xv;
            ss += xv[0] * xv[0] + xv[1] * xv[1] + xv[2] * xv[2] + xv[3] * xv[3]; }
        ss = wave_sum(ss); const float rs = rsqrtf(ss * (1.f / 1024.f) + 1e-6f);
        if (l + 1 < NL) {
            const float* mn = (const float*)(WS(p) + OFF_MOD) + (size_t)(l + 1) * 2 * 6144 + ((t >= S_) ? 6144 : 0) + lane * 16; bf16_t* hp = (bf16_t*)(WS(p) + OFF_H) + (size_t)t * DM + lane * 16;
#pragma unroll
            for (int q = 0; q < 4; ++q) { *(f32x4*)(xp + q * 4) = xn[q]; const f32x4 sh = *(const f32x4*)(mn + q * 4), sc = *(const f32x4*)(mn + 1024 + q * 4); { const f32x4 hv = xn[q] * rs * (sc + 1.f) + sh; st_bf4(hp + q * 4, hv); if (GATES_FP8) *(unsigned*)(WS(p) + OFF_H8 + (size_t)(hp - (bf16_t*)(WS(p) + OFF_H)) + q * 4) = pk4_fp8(hv); } }
        } else {
            const float* fn = p.final_norm + lane * 16;
#if PROBE_ATTN
            const float rsp = rs * (1.f + 10.f * __uint_as_float(((const unsigned*)(WS(p) + OFF_CTL))[4000]));
#else
            const float rsp = rs;
#endif
#pragma unroll
            for (int q = 0; q < 4; ++q) { const f32x4 g = *(const f32x4*)(fn + q * 4); *(f32x4*)(xp + q * 4) = xn[q] * rsp * g; }
        }
    }
}


#if TAB_FMT == 6 || TAB_FMT == 5 || TAB_FMT == 65 || TAB_FMT == 45
#define DPP_SHL4 0x104
#define DPP_SHR4 0x114
struct RowReg6 { u32x2 a, b, c; };
DEVI void row_load(RowReg6& r, const unsigned char* rowp, int l32) { const unsigned char* q = rowp + l32 * 24; r.a = *(const u32x2*)q; r.b = *(const u32x2*)(q + 8); r.c = *(const u32x2*)(q + 16); }
DEVI void row_decode(const RowReg6& r, f32x2 (&w)[16]) { const u32x6 pk = {r.a[0], r.a[1], r.b[0], r.b[1], r.c[0], r.c[1]}; const f32x32 v = __builtin_amdgcn_cvt_scalef32_pk32_f32_fp6(pk, 1.0f);
#pragma unroll
    for (int i = 0; i < 16; ++i) w[i] = (f32x2){v[2 * i], v[2 * i + 1]}; }
DEVI float row_scale(const RowReg6&) { return 1.f; }
struct RowReg4 { u32x4 d; unsigned short s; };
DEVI void row_load(RowReg4& r, const unsigned char* rowp, int l32) { r.d = *(const u32x4*)(rowp + l32 * 16); r.s = *(const unsigned short*)(rowp + 512 + l32 * 2); }
DEVI void row_decode(const RowReg4& r, f32x2 (&w)[16]) {
#pragma unroll
    for (int d = 0; d < 4; ++d) { w[4 * d] = __builtin_amdgcn_cvt_scalef32_pk_f32_fp4(r.d[d], 1.0f, 0); w[4 * d + 1] = __builtin_amdgcn_cvt_scalef32_pk_f32_fp4(r.d[d], 1.0f, 1);
        w[4 * d + 2] = __builtin_amdgcn_cvt_scalef32_pk_f32_fp4(r.d[d], 1.0f, 2); w[4 * d + 3] = __builtin_amdgcn_cvt_scalef32_pk_f32_fp4(r.d[d], 1.0f, 3); } }
DEVI float row_scale(const RowReg4& r) { return bf2f(r.s); }
struct RowReg4p { u32x4 d; };
DEVI void row_load(RowReg4p& r, const unsigned char* rowp, int l32) { r.d = *(const u32x4*)(rowp + l32 * 16); }
DEVI void row_decode(const RowReg4p& r, f32x2 (&w)[16]) { RowReg4 t; t.d = r.d; t.s = 0; row_decode(t, w); }
DEVI float row_scale(const RowReg4p&) { return 1.f; }
#if TAB_FMT == 45
typedef RowReg4p RowRegU; typedef RowReg4p RowRegV;
#elif TAB_FMT == 6
typedef RowReg6 RowRegU; typedef RowReg6 RowRegV;
#elif TAB_FMT == 65
typedef RowReg6 RowRegU; typedef RowReg4 RowRegV;
#else
typedef RowReg4 RowRegU; typedef RowReg4 RowRegV;
#endif
template <bool DRY> DEVI void phase_gather6(const P& p, int l) {
    const int lane = tid_() & 63, wid = tid_() >> 6, l32 = lane & 31; const bool hi = lane >= 32;
    const bf16_t* h2 = (const bf16_t*)(WS(p) + OFF_H); const int* eidx = (const int*)(WS(p) + OFF_EIDX); const float* gw = (const float*)(WS(p) + OFF_VN);
    const unsigned char* U = WS(p) + OFF_U + (size_t)l * 16384 * ROWB; const unsigned char* V = WS(p) + OFF_V + (size_t)l * 16384 * ROWB_V;
    const float* SU = (const float*)(WS(p) + OFF_SU) + l * 16384; const float* SV = (const float*)(WS(p) + OFF_SV) + l * 16384;
    const float* g2 = (const float*)(WS(p) + OFF_MOD) + (size_t)l * 2 * 6144 + 5120;
    const bool b3 = (lane & 8) != 0, b2 = (lane & 4) != 0; const int quad = lane >> 2;
    constexpr int T_STAT = 24576; unsigned* qctr = (unsigned*)(WS(p) + OFF_CTL) + 3600 + 64 * l;
    int t = blockIdx.x * 8 + wid; int tk_next = -1; bool dyn = false;
    if (t >= T_STAT) { dyn = true; unsigned r = 0u; if (lane == 0) r = atomicAdd(qctr, 1u); t = T_STAT + (int)__builtin_amdgcn_readfirstlane((int)r); }
    for (; t < T_; ) {
        if (DRY) { dyn = false; }
        unsigned tkr = 0u; const bool want = !DRY && (dyn || t + (int)gridDim.x * 8 >= T_STAT);
        if (want && lane == 0) tkr = atomicAdd(qctr, 1u);
#if GATHER_UMFMA && TAB_FMT == 45
        u32x4 hb0[8], hb1[8];
        { const unsigned char* hq0 = WS(p) + OFF_H4P + (size_t)t * 512 + (lane >> 4) * 16; const unsigned char* hq1 = hq0 + (size_t)T_ * 512;
#pragma unroll
          for (int kb = 0; kb < 8; ++kb) { hb0[kb] = *(const u32x4*)(hq0 + kb * 64); hb1[kb] = *(const u32x4*)(hq1 + kb * 64); } }
        const int hs_ = ((const int*)(WS(p) + OFF_HSC))[t]; int sa_ = 127, sb0_ = hs_ & 255, sb1_ = (hs_ >> 8) & 255; asm volatile("" : "+v"(sa_), "+v"(sb0_), "+v"(sb1_));
#else
        f32x2 xf[16];
#pragma unroll
        for (int m4 = 0; m4 < 8; ++m4) { const u32x2 a = *(const u32x2*)(h2 + (size_t)t * DM + CHUNK_COL(l32, m4)); xf[2 * m4] = (f32x2){bflo(a.x), bfhi(a.x)}; xf[2 * m4 + 1] = (f32x2){bflo(a.y), bfhi(a.y)}; }
#endif
        const int ev0 = eidx[(size_t)t * 128 + lane] & (DRY ? DRY_EMASK : 0x3fff), ev1 = eidx[(size_t)t * 128 + 64 + lane] & (DRY ? DRY_EMASK : 0x3fff);
        #if TAB_FMT == 6 || TAB_FMT == 45
        const float su0 = SU[ev0], su1 = SU[ev1]; const float gs0 = gw[(size_t)t * 128 + lane] * SV[ev0], gs1 = gw[(size_t)t * 128 + 64 + lane] * SV[ev1];
#elif TAB_FMT == 65
        const float su0 = SU[ev0], su1 = SU[ev1]; const float gs0 = gw[(size_t)t * 128 + lane], gs1 = gw[(size_t)t * 128 + 64 + lane];
#else
        const float su0 = 1.f, su1 = 1.f; const float gs0 = gw[(size_t)t * 128 + lane], gs1 = gw[(size_t)t * 128 + 64 + lane];
#endif
        float pd1 = 0.f, pd2 = 0.f;
        f32x2 acc[16];
#pragma unroll
        for (int i = 0; i < 16; ++i) acc[i] = (f32x2){0.f, 0.f};
#if GATHER_UMFMA && TAB_FMT == 45
        u32x4 ua[8]; RowRegV rv[8];
#define G6_UISSUE(jbn) do { const int er_ = __builtin_amdgcn_ds_bpermute((((jbn) & 63) + (lane & 15)) << 2, ((jbn) < 64) ? ev0 : ev1); const unsigned char* up_ = U + (size_t)er_ * ROWB + (lane >> 4) * 16; \
            _Pragma("unroll") for (int kb = 0; kb < 8; ++kb) ua[kb] = *(const u32x4*)(up_ + kb * 64); } while (0)
#else
        RowRegU ru[8]; RowRegV rv[8];
#endif
#define G6_ISSUE(RR, TAB, PITCH, jbn) do { const int evh_ = ((jbn) < 64) ? ev0 : ev1; const int jl_ = (jbn) & 63; \
            _Pragma("unroll") for (int q = 0; q < 8; ++q) { const int ea = __builtin_amdgcn_readlane(evh_, jl_ + q), eb = __builtin_amdgcn_readlane(evh_, jl_ + 8 + q); \
                row_load(RR[q], TAB + (size_t)(hi ? eb : ea) * PITCH, l32); } } while (0)
#define G6_PROBE(jb, gqv) do { if (PROBE_UM && l < 3) { \
            const int er_ = __builtin_amdgcn_ds_bpermute((((jb) & 63) + (lane & 15)) << 2, ((jb) < 64) ? ev0 : ev1); const unsigned char* up_ = U + (size_t)er_ * ROWB + (lane >> 4) * 16; \
            const unsigned char* hq0 = WS(p) + OFF_H4P + (size_t)t * 512 + (lane >> 4) * 16; const unsigned char* hq1 = hq0 + (size_t)T_ * 512; \
            const int hs_ = ((const int*)(WS(p) + OFF_HSC))[t]; int sa_ = 127, sb0_ = hs_ & 255, sb1_ = (hs_ >> 8) & 255; asm volatile("" : "+v"(sa_), "+v"(sb0_), "+v"(sb1_)); f32x4 a4_ = (f32x4){0.f, 0.f, 0.f, 0.f}; \
            _Pragma("unroll 1") for (int kb = 0; kb < 8; ++kb) { const u32x4 ua_ = *(const u32x4*)(up_ + kb * 64); const u32x4 b0_ = *(const u32x4*)(hq0 + kb * 64), b1_ = *(const u32x4*)(hq1 + kb * 64); \
                asm volatile("s_nop 7\n\tv_mfma_scale_f32_16x16x128_f8f6f4 %0, %1, %2, %0, %3, %4 op_sel_hi:[0,0,0] cbsz:4 blgp:4\n\ts_nop 15\n\ts_nop 15" : "+v"(a4_) : "v"(ua_), "v"(b0_), "v"(sa_), "v"(sb0_)); \
                asm volatile("s_nop 7\n\tv_mfma_scale_f32_16x16x128_f8f6f4 %0, %1, %2, %0, %3, %4 op_sel_hi:[0,0,0] cbsz:4 blgp:4\n\ts_nop 15\n\ts_nop 15" : "+v"(a4_) : "v"(ua_), "v"(b1_), "v"(sa_), "v"(sb1_)); } \
            const int si_ = (lane >> 2) & 3; const float gm_ = (si_ == 0) ? a4_[0] : (si_ == 1) ? a4_[1] : (si_ == 2) ? a4_[2] : a4_[3]; \
            pd1 += (gm_ - (gqv)) * (gm_ - (gqv)); pd2 += (gqv) * (gqv); } } while (0)
#if GATHER_UMFMA && TAB_FMT == 45
#define G6_MF(ACC, A, B, SB) asm volatile("v_mfma_scale_f32_16x16x128_f8f6f4 %0, %1, %2, %0, %3, %4 op_sel_hi:[0,0,0] cbsz:4 blgp:4" : "+v"(ACC) : "v"(A), "v"(B), "v"(sa_), "v"(SB))
#define G6_MF0(ACC, A, B, SB) asm volatile("v_mfma_scale_f32_16x16x128_f8f6f4 %0, %1, %2, 0, %3, %4 op_sel_hi:[0,0,0] cbsz:4 blgp:4" : "=&v"(ACC) : "v"(A), "v"(B), "v"(sa_), "v"(SB))
#define G6_UDOT(jb, NEXT) do { f32x4 aa_, ab_; \
            G6_MF0(aa_, ua[0], hb0[0], sb0_); G6_MF0(ab_, ua[0], hb1[0], sb1_); \
            _Pragma("unroll") for (int kb = 1; kb < 8; ++kb) { G6_MF(aa_, ua[kb], hb0[kb], sb0_); G6_MF(ab_, ua[kb], hb1[kb], sb1_); } \
            asm volatile("s_nop 15\n\ts_nop 15" ::: "memory"); \
            if (NEXT) G6_UISSUE((jb) + 16); \
            const f32x4 as_ = aa_ + ab_; const int si_ = (lane >> 2) & 3; gq = (si_ == 0) ? as_[0] : (si_ == 1) ? as_[1] : (si_ == 2) ? as_[2] : as_[3]; } while (0)
#else
#define G6_UDOT(jb, NEXT) do { float d[8]; \
            _Pragma("unroll") for (int q = 0; q < 8; ++q) { f32x2 w[16]; row_decode(ru[q], w); f32x2 s2 = w[0] * xf[0]; \
                _Pragma("unroll") for (int i = 1; i < 16; ++i) s2 = s2 + w[i] * xf[i]; \
                d[q] = (s2[0] + s2[1]) * row_scale(ru[q]); } \
            if (NEXT) G6_ISSUE(ru, U, ROWB, (jb) + 16); \
            float f4[4], g2_[2]; \
            _Pragma("unroll") for (int i = 0; i < 4; ++i) f4[i] = swap16_sum(d[i], d[i + 4]);                       \
            _Pragma("unroll") for (int i = 0; i < 2; ++i) { const float snd = b3 ? f4[i] : f4[i + 2], kp = b3 ? f4[i + 2] : f4[i]; g2_[i] = kp + DPPF(snd, DPP_ROR8); }     \
            { const float snd = b2 ? g2_[0] : g2_[1], kp = b2 ? g2_[1] : g2_[0]; const float rl = DPPF(snd, DPP_SHL4), rr_ = DPPF(snd, DPP_SHR4); gq = kp + (b2 ? rr_ : rl); }     \
            gq += DPPF(gq, DPP_QX1); gq += DPPF(gq, DPP_QX2);                                                       \
            } while (0)
#endif
#define G6_BODY(jb, NEXT) do { \
            const int bidx_ = ((((jb) & 63) + quad) << 2); \
            const float su_ = __int_as_float(__builtin_amdgcn_ds_bpermute(bidx_, __float_as_int(((jb) < 64) ? su0 : su1))); \
            const float gs_ = __int_as_float(__builtin_amdgcn_ds_bpermute(bidx_, __float_as_int(((jb) < 64) ? gs0 : gs1))); \
            float gq; \
            G6_UDOT(jb, NEXT); \
            G6_PROBE(jb, gq); \
            const float wq = gs_ * gelu_tanh(gq * su_); \
            _Pragma("unroll") for (int q = 0; q < 8; ++q) { \
                const float wa = __uint_as_float((unsigned)__builtin_amdgcn_readlane((int)__float_as_uint(wq), 4 * q)), wb = __uint_as_float((unsigned)__builtin_amdgcn_readlane((int)__float_as_uint(wq), 32 + 4 * q)); \
                const float w1 = (hi ? wb : wa) * row_scale(rv[q]); const f32x2 w2 = (f32x2){w1, w1}; f32x2 vw[16]; row_decode(rv[q], vw); \
                _Pragma("unroll") for (int i = 0; i < 16; ++i) acc[i] = acc[i] + w2 * vw[i]; } \
            if (NEXT) G6_ISSUE(rv, V, ROWB_V, (jb) + 16); } while (0)
#if GATHER_UMFMA && TAB_FMT == 45
        G6_UISSUE(0); G6_ISSUE(rv, V, ROWB_V, 0);
#else
        G6_ISSUE(ru, U, ROWB, 0); G6_ISSUE(rv, V, ROWB_V, 0);
#endif
#pragma unroll 1
        for (int jb = 0; jb < 112; jb += 16) G6_BODY(jb, true);
        G6_BODY(112, false);
        if (PROBE_UM && l < 3) { pd1 = wave_sum(pd1); pd2 = wave_sum(pd2); if (lane == 0) { atomicAdd((float*)(WS(p) + OFF_CTL) + 4001, pd1); atomicAdd((float*)(WS(p) + OFF_CTL) + 4002, pd2); } }
#undef G6_PROBE
#undef G6_ISSUE
#undef G6_BODY
#undef G6_UDOT
#ifdef G6_UISSUE
#undef G6_UISSUE
#undef G6_MF
#undef G6_MF0
#endif
#define G6_NEXT_TOKEN() do { if (want) { t = T_STAT + (int)__builtin_amdgcn_readfirstlane((int)tkr); dyn = true; } else { t += (int)gridDim.x * 8; } } while (0)
        if (DRY) { if (acc[0][0] == 1.2345e30f) XR(p)[0] = acc[1][0]; t += (int)gridDim.x * 8; continue; }
        f32x2 as[8];
#pragma unroll
        for (int i = 0; i < 8; ++i) { f32x2 lo, hh; lo[0] = swap32_sum(acc[i][0], acc[i][0]); lo[1] = swap32_sum(acc[i][1], acc[i][1]); hh[0] = swap32_sum(acc[8 + i][0], acc[8 + i][0]); hh[1] = swap32_sum(acc[8 + i][1], acc[8 + i][1]);
            as[i] = hi ? hh : lo; }
        const int hq = hi ? 4 : 0;
#define GCOL(q) CHUNK_COL(l32, hq + (q))
        float* xp = XR(p) + (size_t)t * DM; const float* gp = g2 + ((t >= S_) ? 6144 : 0); bf16_t* xbp = (bf16_t*)(WS(p) + OFF_XB) + (size_t)t * DM;
        f32x4 xn[4]; float ss = 0.f;
#pragma unroll
        for (int q = 0; q < 4; ++q) { f32x4 xv = XRES_BF16 ? ld_bf4(xbp + GCOL(q)) : *(const f32x4*)(xp + GCOL(q)); const f32x4 gv = *(const f32x4*)(gp + GCOL(q));
            xv[0] += gv[0] * as[2 * q][0]; xv[1] += gv[1] * as[2 * q][1]; xv[2] += gv[2] * as[2 * q + 1][0]; xv[3] += gv[3] * as[2 * q + 1][1]; xn[q] = xv;
            ss += xv[0] * xv[0] + xv[1] * xv[1] + xv[2] * xv[2] + xv[3] * xv[3]; }
        ss = wave_sum(ss); const float rs = rsqrtf(ss * (1.f / 1024.f) + 1e-6f);
        if (l + 1 < NL) {
            const float* mn = (const float*)(WS(p) + OFF_MOD) + (size_t)(l + 1) * 2 * 6144 + ((t >= S_) ? 6144 : 0); bf16_t* hp = (bf16_t*)(WS(p) + OFF_H) + (size_t)t * DM;
#pragma unroll
            for (int q = 0; q < 4; ++q) { if (XRES_BF16) st_bf4(xbp + GCOL(q), xn[q]); else *(f32x4*)(xp + GCOL(q)) = xn[q]; const f32x4 sh = *(const f32x4*)(mn + GCOL(q)), sc = *(const f32x4*)(mn + 1024 + GCOL(q)); { const f32x4 hv = xn[q] * rs * (sc + 1.f) + sh; st_bf4(hp + GCOL(q), hv); if (GATES_FP8) *(unsigned*)(WS(p) + OFF_H8 + (size_t)t * DM + GCOL(q)) = pk4_fp8(hv); } }
        } else {
            const float* fn = p.final_norm;
#if PROBE_UM
            const float s1_ = ((const float*)(WS(p) + OFF_CTL))[4001], s2_ = ((const float*)(WS(p) + OFF_CTL))[4002];
            const float rsp = rs * (1.f + 10.f * floorf(fminf(sqrtf(s1_ / fmaxf(s2_, 1e-30f)), 4.f) * 64.f + 0.5f) * (1.f / 64.f));
#elif PROBE_ATTN
            const float rsp = rs * (1.f + 10.f * __uint_as_float(((const unsigned*)(WS(p) + OFF_CTL))[4000]));
#else
            const float rsp = rs;
#endif
#pragma unroll
            for (int q = 0; q < 4; ++q) { const f32x4 g = *(const f32x4*)(fn + GCOL(q)); *(f32x4*)(xp + GCOL(q)) = xn[q] * rsp * g; }
        }
#undef GCOL
        G6_NEXT_TOKEN();
    }
}
#endif

#if PROBE_ATTN
DEVI void dsincos(double ang, double& s, double& c) {
    const double rev = ang * 0.15915494309189535; const double x = (rev - rint(rev)) * 6.283185307179586; const double x2 = x * x;
    double ts = x, tc = 1.0; s = x; c = 1.0;
    for (int n = 1; n <= 14; ++n) { tc *= -x2 / (double)((2 * n - 1) * (2 * n)); c += tc; ts *= -x2 / (double)((2 * n) * (2 * n + 1)); s += ts; }
}
DEVI void phase_attn_check(const P& p, char* lds) {
    const int lane = tid_() & 63, wid = tid_() >> 6;
    const int TS[24] = {0, 1, 2, 31, 32, 33, 63, 64, 65, 127, 128, 255, 256, 257, 511, 1000, 2047, 4096, 5000, 8191, 8192, 12345, 16382, 16383};
    const bf16_t* z = (const bf16_t*)(WS(p) + OFF_Z); const bf16_t* Qb = (const bf16_t*)(WS(p) + OFF_Q); const bf16_t* Kb = (const bf16_t*)(WS(p) + OFF_K);
    const bf16_t* Vb = (const bf16_t*)(WS(p) + OFF_VV); const bf16_t* Yb = (const bf16_t*)(WS(p) + OFF_CAT) + CAT_YB; unsigned* errw = (unsigned*)(WS(p) + OFF_CTL) + 4000;
    float* qs = (float*)lds + wid * 128;
    for (int v = blockIdx.x * 8 + wid; v < 16 * 24; v += gridDim.x * 8) {
        const int bh = v / 24, b = bh >> 3, h = bh & 7; int t = 0;
#pragma unroll
        for (int i = 0; i < 24; ++i) if (v % 24 == i) t = TS[i];
        const size_t tq = (size_t)b * S_ + t;
        float ss = 0.f; for (int i = lane; i < 384; i += 64) { const float a = bf2f(z[tq * ZC + Z_CQ + i]); ss += a * a; }
        ss = wave_sum(ss); const float rs = 1.0f / sqrtf(ss / 384.f + 1e-6f);
        qs[lane] = bf2f(Qb[tq * 768 + h * 96 + lane]) * rs; if (lane < 32) qs[64 + lane] = bf2f(Qb[tq * 768 + h * 96 + 64 + lane]) * rs;
        asm volatile("s_waitcnt lgkmcnt(0)" ::: "memory");
        if (lane < 16) { const float* rp_ = (const float*)(WS(p) + OFF_ROPE) + tq * 32; const float cs = rp_[lane], sn = rp_[16 + lane]; const float x1 = qs[64 + lane], x2 = qs[80 + lane];
            qs[64 + lane] = x1 * (float)cs - x2 * (float)sn; qs[80 + lane] = x2 * (float)cs + x1 * (float)sn; }
        asm volatile("s_waitcnt lgkmcnt(0)" ::: "memory");
        float mx = -1e30f;
        for (int pass = 0; pass < 2; ++pass) {
            float lsum = 0.f, o[16];
#pragma unroll
            for (int d = 0; d < 16; ++d) o[d] = 0.f;
            const float mglob = mx;
            for (int s = lane; s <= t; s += 64) {
                const size_t ts_ = (size_t)b * S_ + s; float dot = 0.f;
                for (int d = 0; d < 64; ++d) dot += qs[d] * bf2f(Kb[ts_ * 768 + h * 96 + d]);
                for (int i = 0; i < 16; ++i) { const float* rp_ = (const float*)(WS(p) + OFF_ROPE) + ts_ * 32; const float cs = rp_[i], sn = rp_[16 + i];
                    const float x1 = bf2f(z[ts_ * ZC + Z_KR + i]), x2 = bf2f(z[ts_ * ZC + Z_KR + 16 + i]);
                    dot += qs[64 + i] * (x1 * (float)cs - x2 * (float)sn) + qs[80 + i] * (x2 * (float)cs + x1 * (float)sn); }
                dot *= 0.10206207261596577f;
                if (pass == 0) mx = fmaxf(mx, dot);
                else { const float pr = expf(dot - mglob); lsum += pr;
#pragma unroll
                    for (int d = 0; d < 16; ++d) o[d] += pr * bf2f(Vb[ts_ * 512 + h * 64 + 4 * d]); }
            }
            if (pass == 0) {
#pragma unroll
                for (int of = 32; of > 0; of >>= 1) mx = fmaxf(mx, __shfl_xor(mx, of));
            } else {
                lsum = wave_sum(lsum); float emax = 0.f, r2 = 0.f;
#pragma unroll
                for (int d = 0; d < 16; ++d) { const float ref = wave_sum(o[d]) / lsum; const float got = bf2f(Yb[tq * 1024 + h * 64 + 4 * d]); emax = fmaxf(emax, fabsf(got - ref)); r2 += ref * ref; }
                const float rel = emax / (sqrtf(r2 / 16.f) + 1e-20f);
                if (lane == 0) atomicMax(errw, __float_as_uint((rel == rel) ? fminf(fmaxf(rel, 0.f), 4.f) : 3.0f));
            }
        }
    }
}
#endif

#define XB_TMO      128
#define XB_XCNT(j)  (256  + 64 * (j))
#define XB_XSUB(j)  (1280 + 64 * (j))
#define XB_XGEN(j)  (2304 + 64 * (j))
#define XB_TOP      3328
#define XB_TOPGEN   3392
#define XCD_BAR_WORDS 3456
#define XB_SPIN_CAP (1u << 18)

__device__ __forceinline__ unsigned xb_ld(unsigned* p)              { return __hip_atomic_load(p, __ATOMIC_RELAXED, __HIP_MEMORY_SCOPE_AGENT); }
__device__ __forceinline__ unsigned xb_add(unsigned* p, unsigned v) { return __hip_atomic_fetch_add(p, v, __ATOMIC_RELAXED, __HIP_MEMORY_SCOPE_AGENT); }
__device__ __forceinline__ unsigned xb_xcc_id() { return (unsigned)__builtin_amdgcn_s_getreg((3 << 11) | 20) & 0xFu; }
#define XB_SPIN(cond, bar) do { unsigned _sp = 0; while (cond) { __builtin_amdgcn_s_sleep(1); \
    if ((++_sp & 255u) == 0u) { if (xb_ld(&(bar)[XB_TMO])) break; if (_sp > XB_SPIN_CAP) { atomicAdd(&(bar)[XB_TMO], 1u); break; } } } } while (0)

struct XcdBarrier {
    unsigned* bar; unsigned x;
    volatile LAS unsigned* st;
};

__device__ __forceinline__ XcdBarrier xcd_barrier_post(unsigned* bar, volatile LAS unsigned* st) {
    XcdBarrier b; b.bar = bar; b.x = xb_xcc_id(); b.st = st;
    if (threadIdx.x == 0) (void)xb_add(&bar[XB_XCNT(b.x)], 1u);
    return b;
}
__device__ __forceinline__ void xcd_barrier_complete(unsigned* bar, unsigned x, unsigned& nloc, unsigned& nx) {
    const unsigned G = gridDim.x * gridDim.y * gridDim.z;
    unsigned sum, cnt, mine, sp = 0u;
    for (;;) {
        sum = 0u; cnt = 0u; mine = 0u;
#pragma unroll
        for (unsigned j = 0; j < 16; ++j) { const unsigned c = xb_ld(&bar[XB_XCNT(j)]); sum += c; cnt += (c > 0u) ? 1u : 0u; mine = (j == x) ? c : mine; }
        if (sum == G) break;
        __builtin_amdgcn_s_sleep(1);
        if ((++sp & 255u) == 0u) { if (xb_ld(&bar[XB_TMO])) break; if (sp > XB_SPIN_CAP) { atomicAdd(&bar[XB_TMO], 1u); break; } }
    }
    nloc = mine > 0u ? mine : 1u; nx = cnt > 0u ? cnt : 1u;
}

__device__ __forceinline__ void xcd_barrier(const XcdBarrier& b) {
    asm volatile("s_waitcnt vmcnt(0)" ::: "memory");
    __syncthreads();
    if (threadIdx.x == 0) {
        unsigned* bar = b.bar;
        __builtin_amdgcn_s_waitcnt(0);
        unsigned nloc = b.st[0], nx = b.st[1];
        if (nloc == 0u) { xcd_barrier_complete(bar, b.x, nloc, nx); b.st[0] = nloc; b.st[1] = nx; }
        const unsigned old = xb_add(&bar[XB_XSUB(b.x)], 1u);
        const unsigned gen = old / nloc;
        if (old + 1u == (gen + 1u) * nloc) {
            __builtin_amdgcn_fence(__ATOMIC_RELEASE, "agent");
            asm volatile("s_waitcnt vmcnt(0)" ::: "memory");
            const unsigned og = xb_add(&bar[XB_TOP], 1u);
            const unsigned tg = og / nx;
            if (og + 1u == (tg + 1u) * nx) xb_add(&bar[XB_TOPGEN], 1u);
            else XB_SPIN(xb_ld(&bar[XB_TOPGEN]) == tg, bar);
            __builtin_amdgcn_fence(__ATOMIC_ACQUIRE, "agent");
            xb_add(&bar[XB_XGEN(b.x)], 1u);
            asm volatile("s_waitcnt vmcnt(0)" ::: "memory");
        } else {
            XB_SPIN(xb_ld(&bar[XB_XGEN(b.x)]) == gen, bar);
            __builtin_amdgcn_fence(__ATOMIC_ACQUIRE, "agent");
            asm volatile("s_waitcnt vmcnt(0)" ::: "memory");
        }
    }
    __syncthreads();
}

enum { PH_PRO = 0, PH_NORM1, PH_GIN, PH_POST, PH_MIX_QKV, PH_ATTN, PH_MERGE, PH_WO, PH_NORM2, PH_PQ, PH_SC, PH_TOPK, PH_GATHER, PH_FINAL, PH_CHECK, PH_PEERK, PH_PQK };
template <int PH> DEVI void run_phase(const P& p, int l, char* lds) {
    l = opaque_i32(l);
    const unsigned char* wl = WS(p) + OFF_W + (size_t)l * W_LAYER; const float* mod = (const float*)(WS(p) + OFF_MOD) + (size_t)l * 2 * 6144;
    if constexpr (PH == PH_PRO) phase_prologue(p, lds);
    if constexpr (PH == PH_NORM1) phase_norm(p, p.x, mod + 0, mod + 1024, true);
    if constexpr (PH == PH_GIN) {
        if (GATES_FP8) {
            { EpiZ e{(bf16_t*)(WS(p) + OFF_Z)}; gemm256_phase((const bf16_t*)(WS(p) + OFF_H), DM, (const bf16_t*)(wl + W_INT), 1024, T_, Z_G, 1024, lds, e); }
            { EpiZG e{(bf16_t*)(WS(p) + OFF_Z)}; gemm256_phase_f8(WS(p) + OFF_H8, 1024, wl + W_G8, 1024, T_, 3072, 1024, lds, e); }
        } else { EpiZ e{(bf16_t*)(WS(p) + OFF_Z)}; gemm256_phase((const bf16_t*)(WS(p) + OFF_H), DM, (const bf16_t*)(wl + W_INT), 1024, T_, ZC, 1024, lds, e); }
    }
    if constexpr (PH == PH_POST) phase_post(p);
    if constexpr (PH == PH_MIX_QKV) {
        phase_mixa(p, l, lds);
        { EpiBf e{(bf16_t*)(WS(p) + OFF_Q), 768}; gemm256_phase((const bf16_t*)(WS(p) + OFF_Z) + Z_CQ, ZC, (const bf16_t*)(wl + W_UQ), 384, T_, 768, 384, lds, e); }
        { EpiKV e{(bf16_t*)(WS(p) + OFF_K), (bf16_t*)(WS(p) + OFF_VV), (const float*)(WS(p) + OFF_RS) + T_}; gemm256_phase((const bf16_t*)(WS(p) + OFF_Z) + Z_CKV, ZC, (const bf16_t*)(wl + W_UKV), 256, T_, 1024, 256, lds, e); }
    }
    if constexpr (PH == PH_ATTN) phase_attn(p, lds);
#ifndef MERGE_SIMPLE
#define MERGE_SIMPLE 0
#endif
    if constexpr (PH == PH_MERGE) {
        if (MERGE_SIMPLE) phase_merge(p, l, lds);
        else { const bf16_t* zg = (const bf16_t*)(WS(p) + OFF_Z) + Z_G; EpiMergeLast e{(bf16_t*)(WS(p) + OFF_H), zg + (GATES_ST8 ? 1024 : 2048)}; pg8::GateSeg sg{zg, ZC, 1024, 4, 12};
            gemm256_phase_seg((const bf16_t*)(WS(p) + OFF_CAT), 1024, (const bf16_t*)(wl + W_A), 1024, T_, 1024, 1024, lds, e, sg); }
    }
    if constexpr (PH == PH_WO) {
        if (XRES_BF16) { bf16_t* xb = (bf16_t*)(WS(p) + OFF_XB); EpiWoB e{(l == 0) ? p.x : nullptr, xb, xb, mod + 2048}; gemm256_phase((const bf16_t*)(WS(p) + OFF_H), DM, (const bf16_t*)(wl + W_O), 1024, T_, 1024, 1024, lds, e); }
        else { EpiWo e{(l == 0) ? p.x : (const float*)XR(p), XR(p), mod + 2048}; gemm256_phase((const bf16_t*)(WS(p) + OFF_H), DM, (const bf16_t*)(wl + W_O), 1024, T_, 1024, 1024, lds, e); } }
    if constexpr (PH == PH_NORM2) phase_norm(p, XR(p), mod + 3072, mod + 4096, false, XRES_BF16 ? (const bf16_t*)(WS(p) + OFF_XB) : nullptr, (PROBE_UM != 0) || (GATHER_UMFMA != 0));
    if constexpr (PH == PH_PQ) { EpiBf e{(bf16_t*)(WS(p) + OFF_Q), 2048}; gemm256_phase((const bf16_t*)(WS(p) + OFF_H), DM, (const bf16_t*)(wl + W_PQ), 1024, T_, 2048, 1024, lds, e); }
    if constexpr (PH == PH_SC) { EpiScT e{(float*)(WS(p) + OFF_Z)}; gemm_phase((const bf16_t*)(WS(p) + OFF_Q), 2048, 128, (const bf16_t*)(wl + W_SK), 128, T_, 2048, 128, lds, e); }
    if constexpr (PH == PH_TOPK) phase_topk(p);
    if constexpr (PH == PH_PEERK) phase_peerk(p, l, lds);
    if constexpr (PH == PH_PQK) {
        for (int v = (int)blockIdx.x; v < 256; v += (int)gridDim.x) {
            { EpiBf e{(bf16_t*)(WS(p) + OFF_Q), 2048}; gemm256_pair((const bf16_t*)(WS(p) + OFF_H), DM, (const bf16_t*)(wl + W_PQ), 1024, T_, 2048, 1024, lds, e, v); }
            asm volatile("s_waitcnt vmcnt(0)" ::: "memory"); __syncthreads(); __builtin_amdgcn_fence(__ATOMIC_ACQUIRE, "agent");
            if (PQ_FOLD) phase_peerk2(p, v, lds); else phase_peerk(p, l, lds, v);
        }
    }
#if TAB_FMT == 6 || TAB_FMT == 5 || TAB_FMT == 65 || TAB_FMT == 45
    if constexpr (PH == PH_GATHER) phase_gather6<false>(p, l);
    if constexpr (PH == PH_GATHER + 100) phase_gather6<true>(p, l);
#else
    if constexpr (PH == PH_GATHER) phase_gather<false>(p, l);
    if constexpr (PH == PH_GATHER + 100) phase_gather<true>(p, l);
#endif
    if constexpr (PH == PH_FINAL) phase_final(p);
#if PROBE_ATTN
    if constexpr (PH == PH_CHECK) phase_attn_check(p, lds);
#endif
}
#ifndef MEGA
#define MEGA 1
#endif
#if MEGA
__global__ void __launch_bounds__(NTHR, 2) k_mega(P p) {
    extern __shared__ __attribute__((aligned(16))) char lds[];
    if (threadIdx.x == 0) *(u32x4*)(lds + LDS_BYTES - 16) = (u32x4){0u, 0u, 0u, 0u};
    ctx_init(p, lds);
    __syncthreads();
    (void)xcd_barrier_post((unsigned*)(p.ws + OFF_CTL), (volatile LAS unsigned*)(lds + LDS_BYTES - 16));
#define GRID_BARRIER() do { XcdBarrier b_; b_.bar = (unsigned*)(WS(p) + OFF_CTL); b_.x = xb_xcc_id(); b_.st = (volatile LAS unsigned*)(lds + LDS_BYTES - 16); xcd_barrier(b_); } while (0)
    run_phase<PH_PRO>(p, 0, lds); GRID_BARRIER();
    if (DUP_MASK & 1) { run_phase<PH_PRO>(p, 0, lds); GRID_BARRIER(); }
    if (DUP_MASK & 0x10000) { for (int i = 0; i < 48; ++i) GRID_BARRIER(); }
#pragma unroll 1
    for (int l = 0; l < NL; ++l) {
        if (l == 0) { run_phase<PH_NORM1>(p, l, lds); GRID_BARRIER(); }
        run_phase<PH_GIN>(p, l, lds); GRID_BARRIER();
        if (DUP_MASK & (1 << PH_GIN)) { run_phase<PH_GIN>(p, l, lds); GRID_BARRIER(); }
        run_phase<PH_POST>(p, l, lds); GRID_BARRIER();
        if (DUP_MASK & (1 << PH_POST)) { run_phase<PH_POST>(p, l, lds); GRID_BARRIER(); }
        run_phase<PH_MIX_QKV>(p, l, lds); GRID_BARRIER();
        if (DUP_MASK & (1 << PH_MIX_QKV)) { run_phase<PH_MIX_QKV>(p, l, lds); GRID_BARRIER(); }
        run_phase<PH_ATTN>(p, l, lds); GRID_BARRIER();
#if PROBE_ATTN
        if (l == 1) { phase_attn_check(p, lds); GRID_BARRIER(); }
#endif
        if (DUP_MASK & (1 << PH_ATTN)) { run_phase<PH_ATTN>(p, l, lds); GRID_BARRIER(); }
        run_phase<PH_MERGE>(p, l, lds); GRID_BARRIER();
        if (DUP_MASK & (1 << PH_MERGE)) { run_phase<PH_MERGE>(p, l, lds); GRID_BARRIER(); }
        run_phase<PH_WO>(p, l, lds); GRID_BARRIER();
        run_phase<PH_NORM2>(p, l, lds); GRID_BARRIER();
        if (DUP_MASK & (1 << PH_NORM2)) { run_phase<PH_NORM2>(p, l, lds); GRID_BARRIER(); }
#if FUSE_PQK
        run_phase<PH_PQK>(p, l, lds); GRID_BARRIER();
#else
        run_phase<PH_PQ>(p, l, lds); GRID_BARRIER();
        if (DUP_MASK & (1 << PH_PQ)) { run_phase<PH_PQ>(p, l, lds); GRID_BARRIER(); }
        run_phase<PH_PEERK>(p, l, lds); GRID_BARRIER();
#endif
        if (DUP_MASK & (1 << PH_TOPK)) { run_phase<PH_PEERK>(p, l, lds); GRID_BARRIER(); }
        run_phase<PH_GATHER>(p, l, lds); GRID_BARRIER();
        if (DUP_MASK & (1 << PH_GATHER)) { run_phase<PH_GATHER + 100>(p, l, lds); GRID_BARRIER(); }
    }
}
#else
template <int PH> __global__ void __launch_bounds__(NTHR, 2) k_phase(P p, int l) {
    extern __shared__ __attribute__((aligned(16))) char lds[];
    ctx_init(p, lds); __syncthreads();
    run_phase<PH>(p, l, lds);
}
template <int PH> static void launch_phase(const P& p, int l, hipStream_t stream) {
    static bool attr = false;
    if (!attr) { (void)hipFuncSetAttribute((const void*)k_phase<PH>, hipFuncAttributeMaxDynamicSharedMemorySize, LDS_BYTES); attr = true; }
    hipLaunchKernelGGL(k_phase<PH>, dim3(256), dim3(NTHR), LDS_BYTES, stream, p, l);
}
#endif

extern "C" void kernel_launch(void* const* d_in, const int* in_sizes, int n_in, void* d_out, int out_size, void* d_ws, size_t ws_size, hipStream_t stream) {
    P p{};
    p.x = (const float*)d_in[0]; p.c = (const float*)d_in[1]; p.pos = (const int*)d_in[2];
    p.w_mod = (const float*)d_in[3]; p.b_mod = (const float*)d_in[4]; p.w_in = (const float*)d_in[5]; p.w_s = (const float*)d_in[6]; p.b_s = (const float*)d_in[7];
    p.q_norm = (const float*)d_in[8]; p.w_uq = (const float*)d_in[9]; p.kv_norm = (const float*)d_in[10]; p.w_ukv = (const float*)d_in[11]; p.w_pool = (const float*)d_in[12];
    p.pool_scale = (const float*)d_in[13]; p.w_a = (const float*)d_in[14]; p.w_b = (const float*)d_in[15]; p.w_c = (const float*)d_in[16]; p.w_o = (const float*)d_in[17];
    p.w_pq = (const float*)d_in[18]; p.sub_keys = (const float*)d_in[19]; p.u_tab = (const float*)d_in[20]; p.v_tab = (const float*)d_in[21]; p.final_norm = (const float*)d_in[22];
    p.xr = (float*)d_out; p.ws = (unsigned char*)d_ws;
    for (int i = 0; i < 16; ++i) p.invf[i] = (double)(float)(1.0 / pow(10000.0, (double)(2 * i) / 32.0));
#if MEGA
    static int grid = 0;
    if (!grid) {
        (void)hipFuncSetAttribute((const void*)k_mega, hipFuncAttributeMaxDynamicSharedMemorySize, LDS_BYTES);
        int dev = 0, cus = 0, per_cu = 0;
        (void)hipGetDevice(&dev); (void)hipDeviceGetAttribute(&cus, hipDeviceAttributeMultiprocessorCount, dev);
        (void)hipOccupancyMaxActiveBlocksPerMultiprocessor(&per_cu, (const void*)k_mega, NTHR, LDS_BYTES);
        if (cus <= 0) cus = 256;
        grid = cus * (per_cu < 1 ? 1 : 1);
    }
    (void)hipMemsetAsync(p.ws + OFF_CTL, 0, 16384, stream);
    hipLaunchKernelGGL(k_mega, dim3(grid), dim3(NTHR), LDS_BYTES, stream, p);
#else
    (void)hipMemsetAsync(p.ws + OFF_CTL, 0, 16384, stream);
    launch_phase<PH_PRO>(p, 0, stream);
    for (int l = 0; l < NL; ++l) {
        if (l == 0) launch_phase<PH_NORM1>(p, l, stream); launch_phase<PH_GIN>(p, l, stream); launch_phase<PH_POST>(p, l, stream); launch_phase<PH_MIX_QKV>(p, l, stream);
        launch_phase<PH_ATTN>(p, l, stream); if (PROBE_ATTN && l == 1) launch_phase<PH_CHECK>(p, l, stream); launch_phase<PH_MERGE>(p, l, stream); launch_phase<PH_WO>(p, l, stream); launch_phase<PH_NORM2>(p, l, stream);
        launch_phase<PH_PQ>(p, l, stream); launch_phase<PH_PEERK>(p, l, stream); launch_phase<PH_GATHER>(p, l, stream);
    }
#endif
}
```

```cpp
#include <hip/hip_runtime.h>
#include <stdint.h>
#include <math.h>

#ifndef PROBE_ATTN
#define PROBE_ATTN 0
#endif
#ifndef DUP_MASK
#define DUP_MASK 0
#endif
#ifndef FUSE_PQK
#define FUSE_PQK 1
#endif
#ifndef PEERK_NET
#define PEERK_NET 1
#endif
#ifndef PROBE_UM
#define PROBE_UM 0
#endif
#ifndef GATHER_UMFMA
#define GATHER_UMFMA 1
#endif
#ifndef PQ_FOLD
#define PQ_FOLD 1
#endif
#ifndef GATES_ST8
#define GATES_ST8 1
#endif
#ifndef META16
#define META16 1
#endif
#ifndef XRES_BF16
#define XRES_BF16 1
#endif
#ifndef GATES_FP8
#define GATES_FP8 1
#endif
#ifndef DRY_EMASK
#define DRY_EMASK 0x3fff
#endif
#ifndef EPI_PERM
#define EPI_PERM 1
#endif
#define DEVI __device__ __forceinline__
typedef unsigned short bf16_t;
typedef short bf16x8 __attribute__((ext_vector_type(8)));
typedef short s16x4 __attribute__((ext_vector_type(4)));
typedef float f32x4 __attribute__((ext_vector_type(4)));
typedef float f32x2 __attribute__((ext_vector_type(2)));
typedef float f32x16 __attribute__((ext_vector_type(16)));
typedef unsigned u32x4 __attribute__((ext_vector_type(4)));
typedef unsigned u32x2 __attribute__((ext_vector_type(2)));
typedef __bf16 bf16x2_t __attribute__((ext_vector_type(2)));
typedef float f32x32 __attribute__((ext_vector_type(32)));
typedef unsigned u32x6 __attribute__((ext_vector_type(6)));
#define LAS __attribute__((address_space(3)))

constexpr int T_ = 32768, S_ = 16384, DM = 1024, NL = 4;
constexpr int ZC = 4608;
constexpr int Z_U = 0, Z_V = 256, Z_CQ = 512, Z_CKV = 896, Z_P = 1152, Z_KR = 1408, Z_G = 1536;
constexpr int NTHR = 512;
constexpr int LDS_BYTES = 147456;
constexpr float C2F = 0.14724445f;

constexpr size_t al256(size_t x) { return (x + 255) & ~(size_t)255; }
constexpr size_t OFF_CTL = 0;
constexpr size_t OFF_MOD = 16384;
constexpr size_t OFF_ROPE = OFF_MOD + al256((size_t)NL * 2 * 6144 * 4);
constexpr size_t OFF_W = OFF_ROPE + al256((size_t)T_ * 32 * 4);
constexpr size_t W_INT = 0;
constexpr size_t W_UQ = W_INT + (size_t)ZC * 1024 * 2;
constexpr size_t W_UKV = W_UQ + (size_t)768 * 384 * 2;
constexpr size_t W_A = W_UKV + (size_t)1024 * 256 * 2;
constexpr size_t W_B = W_A + (size_t)1024 * 256 * 2;
constexpr size_t W_C = W_B + (size_t)1024 * 512 * 2;
constexpr size_t W_O = W_C + (size_t)1024 * 256 * 2;
constexpr size_t W_PQ = W_O + (size_t)1024 * 1024 * 2;
constexpr size_t W_SK = W_PQ + (size_t)2048 * 1024 * 2;
constexpr size_t W_S = W_SK + (size_t)16 * 128 * 128 * 2;
constexpr size_t W_G8 = W_S + (size_t)4 * 128 * 128 * 2;
constexpr size_t W_LAYER = W_G8 + (size_t)3072 * 1024;
#ifndef TAB_FMT
#define TAB_FMT 45
#endif
#define TAB_FP4 (TAB_FMT == 4)
constexpr int ROWB = (TAB_FMT == 4 || TAB_FMT == 45) ? 512 : TAB_FMT == 5 ? 576 : (TAB_FMT == 6 || TAB_FMT == 65) ? 768 : 1024;
constexpr int ROWB_V = TAB_FMT == 65 ? 576 : ROWB;
#define CHUNK_COL(l32, m4) ((TAB_FMT == 5 || TAB_FMT == 45) ? ((m4) * 128 + 4 * (l32)) : ((l32) * 32 + 4 * (m4)))
constexpr size_t OFF_U = OFF_W + NL * W_LAYER;
constexpr size_t OFF_V = OFF_U + (size_t)NL * 16384 * ROWB;
constexpr size_t OFF_SU = OFF_V + (size_t)NL * 16384 * ROWB;
constexpr size_t OFF_SV = OFF_SU + (size_t)NL * 16384 * 4;
constexpr size_t OFF_H = OFF_SV + (size_t)NL * 16384 * 4;
constexpr size_t OFF_Z = OFF_H + (size_t)T_ * 1024 * 2;
constexpr size_t OFF_VN = OFF_Z + (size_t)T_ * ZC * 2;
constexpr size_t OFF_PRE = OFF_VN + (size_t)T_ * 256 * 2;
constexpr size_t OFF_YA = OFF_PRE + (size_t)T_ * 256 * 2;
constexpr size_t OFF_YB = OFF_YA + (size_t)T_ * 256 * 2;
constexpr size_t OFF_CAT = OFF_PRE;
constexpr int CAT_YA = 0, CAT_YB = 256, CAT_PRE = 768;
constexpr size_t OFF_EIDX = OFF_YA;
constexpr size_t OFF_RS = OFF_YB + (size_t)T_ * 512 * 2;
constexpr size_t OFF_Q = OFF_RS + (size_t)T_ * 2 * 4;
constexpr size_t OFF_K = OFF_Q + (size_t)T_ * 768 * 2;
constexpr size_t OFF_VV = OFF_K + (size_t)T_ * 768 * 2;
constexpr size_t OFF_H8 = OFF_VV + (size_t)T_ * 512 * 2;
constexpr size_t OFF_XB = OFF_H8 + (size_t)T_ * 1024;
constexpr size_t OFF_H4P = OFF_XB + (size_t)T_ * 1024 * 2;
constexpr size_t OFF_HSC = OFF_H4P + (size_t)2 * T_ * 512;
constexpr size_t OFF_END = OFF_HSC + (size_t)T_ * 4;
static_assert(OFF_END <= ((size_t)1 << 30), "workspace map exceeds 1 GiB");

struct P {
    const float *x, *c; const int* pos;
    const float *w_mod, *b_mod, *w_in, *w_s, *b_s, *q_norm, *w_uq, *kv_norm, *w_ukv, *w_pool, *pool_scale, *w_a, *w_b, *w_c, *w_o, *w_pq, *sub_keys, *u_tab, *v_tab, *final_norm;
    float* xr;
    unsigned char* ws;
    double invf[16];
};

DEVI unsigned cvtpk(float lo, float hi) { f32x2 v = {lo, hi}; bf16x2_t b = __builtin_convertvector(v, bf16x2_t); return __builtin_bit_cast(unsigned, b); }
DEVI bf16_t f2bf(float f) { return (bf16_t)(cvtpk(f, 0.f) & 0xffffu); }
DEVI float bf2f(bf16_t b) { return __uint_as_float(((unsigned)b) << 16); }
DEVI float bflo(unsigned w) { return __uint_as_float(w << 16); }
DEVI float bfhi(unsigned w) { return __uint_as_float(w & 0xffff0000u); }
DEVI unsigned pk4_fp8(f32x4 v) { int pk = 0; pk = __builtin_amdgcn_cvt_pk_fp8_f32(v[0], v[1], pk, false); pk = __builtin_amdgcn_cvt_pk_fp8_f32(v[2], v[3], pk, true); return (unsigned)pk; }
DEVI float fexp2(float x) { return __builtin_amdgcn_exp2f(x); }
DEVI float frcp(float x) { return __builtin_amdgcn_rcpf(x); }
DEVI float sigmoidf_(float x) { return frcp(1.f + fexp2(-1.4426950408889634f * x)); }
DEVI float gelu_tanh(float x) { const float u = 0.7978845608028654f * (x + 0.044715f * x * x * x); return x * frcp(1.f + fexp2(-2.8853900817779268f * u)); }
#define DPPF(v, ctrl) __int_as_float(__builtin_amdgcn_update_dpp(0, __float_as_int(v), (ctrl), 0xf, 0xf, true))
#define DPP_QX1 0xB1
#define DPP_QX2 0x4E
#define DPP_HMIR 0x141
#define DPP_MIR 0x140
#define DPP_ROR8 0x128
DEVI float swap16_sum(float a, float b) { auto r = __builtin_amdgcn_permlane16_swap(__float_as_uint(a), __float_as_uint(b), false, false); return __uint_as_float(r[0]) + __uint_as_float(r[1]); }
DEVI float swap32_sum(float a, float b) { auto r = __builtin_amdgcn_permlane32_swap(__float_as_uint(a), __float_as_uint(b), false, false); return __uint_as_float(r[0]) + __uint_as_float(r[1]); }
DEVI float wave_sum(float v) {
    v += DPPF(v, DPP_QX1); v += DPPF(v, DPP_QX2); v += DPPF(v, DPP_HMIR); v += DPPF(v, DPP_MIR);
    v = swap16_sum(v, v); return swap32_sum(v, v);
}
DEVI int xchg32(int v, bool hi) { auto r = __builtin_amdgcn_permlane32_swap((unsigned)v, (unsigned)v, false, false); return (int)(hi ? r[0] : r[1]); }
DEVI int tid_() { int t = threadIdx.x; asm volatile("" : "+v"(t)); return t; }
DEVI unsigned long long opaque_u64(unsigned long long v) { unsigned lo = (unsigned)v, hi = (unsigned)(v >> 32); asm volatile("" : "+v"(lo), "+v"(hi));
    lo = __builtin_amdgcn_readfirstlane(lo); hi = __builtin_amdgcn_readfirstlane(hi); return ((unsigned long long)hi << 32) | lo; }
DEVI int opaque_i32(int v) { asm volatile("" : "+v"(v)); return __builtin_amdgcn_readfirstlane(v); }
DEVI unsigned long long ctx_u64(int slot) { extern __shared__ __attribute__((aligned(16))) char lds_ctx_[]; volatile LAS unsigned* q = (volatile LAS unsigned*)(lds_ctx_ + LDS_BYTES - 48 + slot * 8);
    const unsigned lo = q[0], hi = q[1]; return ((unsigned long long)(unsigned)__builtin_amdgcn_readfirstlane((int)hi) << 32) | (unsigned)__builtin_amdgcn_readfirstlane((int)lo); }
DEVI void ctx_init(const P& p, char* lds) { if (threadIdx.x == 0) { *(unsigned long long*)(lds + LDS_BYTES - 48) = (unsigned long long)p.ws; *(unsigned long long*)(lds + LDS_BYTES - 40) = (unsigned long long)p.xr; } }
typedef __attribute__((address_space(1))) unsigned char* g_u8p;
DEVI unsigned char* WS(const P&) { return (unsigned char*)(g_u8p)ctx_u64(0); }
DEVI float* XR(const P&) { return (float*)(g_u8p)ctx_u64(1); }
#define MFMA16(a, b, c) __builtin_amdgcn_mfma_f32_16x16x32_bf16(a, b, c, 0, 0, 0)
#define MFMA32(a, b, c) __builtin_amdgcn_mfma_f32_32x32x16_bf16(a, b, c, 0, 0, 0)

constexpr int GP = 64;
DEVI void gemm_kloop(f32x4 (&acc)[4][4], const bf16_t* __restrict__ Ap, int lda, const bf16_t* __restrict__ Bp, int ldb, int K, char* lds) {
    const int tid = tid_(), lane = tid & 63, wid = tid >> 6, wm = wid >> 1, wn = wid & 1, fr = lane & 15, fq = lane >> 4;
    bf16_t* const As0 = (bf16_t*)lds; bf16_t* const Bs0 = As0 + 256 * GP; bf16_t* const As1 = Bs0 + 128 * GP; bf16_t* const Bs1 = As1 + 256 * GP;
    const int nt = K >> 6;
    const int sr = tid >> 3, sc = (tid & 7) * 8, scw = ((tid & 7) ^ (sr & 7)) * 8;
    const bf16_t* ag = Ap + (size_t)sr * lda + sc; const bf16_t* bg = Bp + (size_t)sr * ldb + sc;
    const int fx = fr & 7;
    u32x4 ra[4], rb[2];
#define G_LOAD(kt) do { _Pragma("unroll") for (int i_ = 0; i_ < 4; ++i_) ra[i_] = *(const u32x4*)(ag + (size_t)(i_ * 64) * lda + (kt) * 64); \
                        _Pragma("unroll") for (int i_ = 0; i_ < 2; ++i_) rb[i_] = *(const u32x4*)(bg + (size_t)(i_ * 64) * ldb + (kt) * 64); } while (0)
#define G_WRITE(As, Bs) do { _Pragma("unroll") for (int i_ = 0; i_ < 4; ++i_) *(u32x4*)((As) + (sr + i_ * 64) * GP + scw) = ra[i_]; \
                             _Pragma("unroll") for (int i_ = 0; i_ < 2; ++i_) *(u32x4*)((Bs) + (sr + i_ * 64) * GP + scw) = rb[i_]; } while (0)
    __syncthreads();
    G_LOAD(0); G_WRITE(As0, Bs0);
    __syncthreads();
    for (int kt = 0; kt < nt; ++kt) {
        const bf16_t* As = (kt & 1) ? As1 : As0; const bf16_t* Bs = (kt & 1) ? Bs1 : Bs0;
        if (kt + 1 < nt) G_LOAD(kt + 1);
#pragma unroll
        for (int kk = 0; kk < 2; ++kk) {
            bf16x8 af[4], bfr[4]; const int ch = ((kk * 4 + fq) ^ fx) * 8;
#pragma unroll
            for (int m = 0; m < 4; ++m) af[m] = *(const bf16x8*)(As + (wm * 64 + m * 16 + fr) * GP + ch);
#pragma unroll
            for (int n = 0; n < 4; ++n) bfr[n] = *(const bf16x8*)(Bs + (wn * 64 + n * 16 + fr) * GP + ch);
#pragma unroll
            for (int m = 0; m < 4; ++m)
#pragma unroll
                for (int n = 0; n < 4; ++n) acc[m][n] = MFMA16(bfr[n], af[m], acc[m][n]);
        }
        if (kt + 1 < nt) { if (kt & 1) G_WRITE(As0, Bs0); else G_WRITE(As1, Bs1); }
        __syncthreads();
    }
#undef G_LOAD
#undef G_WRITE
}
DEVI void acc_zero(f32x4 (&acc)[4][4]) {
#pragma unroll
    for (int m = 0; m < 4; ++m)
#pragma unroll
        for (int n = 0; n < 4; ++n) acc[m][n] = (f32x4){0.f, 0.f, 0.f, 0.f};
}
template <class Epi>
DEVI void gemm_phase(const bf16_t* A, int lda, int a_pn_stride, const bf16_t* Bt, int ldb, int M, int N, int K, char* lds, const Epi& epi) {
    const int nn = N >> 7, nu = (M >> 8) * nn;
    const int lane = tid_() & 63, wid = tid_() >> 6, wm = wid >> 1, wn = wid & 1, fr = lane & 15, fq = lane >> 4;
    for (int u = blockIdx.x; u < nu; u += gridDim.x) {
        const int pm = u / nn, pn = u - pm * nn;
        f32x4 acc[4][4]; acc_zero(acc);
        gemm_kloop(acc, A + (size_t)pm * 256 * lda + (size_t)pn * a_pn_stride, lda, Bt + (size_t)pn * 128 * ldb, ldb, K, lds);
#pragma unroll
        for (int m = 0; m < 4; ++m)
#pragma unroll
            for (int n = 0; n < 4; ++n) epi(pm * 256 + wm * 64 + m * 16 + fr, pn * 128 + wn * 64 + n * 16 + 4 * fq, acc[m][n]);
    }
}
DEVI void st_bf4(bf16_t* p, f32x4 v) { u32x2 w; w.x = cvtpk(v[0], v[1]); w.y = cvtpk(v[2], v[3]); *(u32x2*)p = w; }
DEVI f32x4 ld_bf4(const bf16_t* p) { const u32x2 w = *(const u32x2*)p; return (f32x4){bflo(w.x), bfhi(w.x), bflo(w.y), bfhi(w.y)}; }
DEVI void st_bf8(bf16_t* p, f32x4 a, f32x4 b) { u32x4 w; w.x = cvtpk(a[0], a[1]); w.y = cvtpk(a[2], a[3]); w.z = cvtpk(b[0], b[1]); w.w = cvtpk(b[2], b[3]); *(u32x4*)p = w; }

struct EpiZ { bf16_t* z;
    DEVI void operator()(int row, int col, f32x4 v) const {
        if (col < Z_CQ) { v[0] = gelu_tanh(v[0]); v[1] = gelu_tanh(v[1]); v[2] = gelu_tanh(v[2]); v[3] = gelu_tanh(v[3]); }
        else if (col >= Z_G) { v[0] = sigmoidf_(v[0]); v[1] = sigmoidf_(v[1]); v[2] = sigmoidf_(v[2]); v[3] = sigmoidf_(v[3]); }
        st_bf4(z + (size_t)row * ZC + col, v); }
    DEVI void v8(int row, int col, f32x4 a, f32x4 b) const {
#pragma unroll
        for (int i = 0; i < 4; ++i) { if (col < Z_CQ) { a[i] = gelu_tanh(a[i]); b[i] = gelu_tanh(b[i]); } else if (col >= Z_G) { a[i] = sigmoidf_(a[i]); b[i] = sigmoidf_(b[i]); } }
        st_bf8(z + (size_t)row * ZC + col, a, b); } };
struct EpiZG { bf16_t* z;
    DEVI void operator()(int row, int col, f32x4 v) const {
#pragma unroll
        for (int i = 0; i < 4; ++i) v[i] = frcp(1.f + fexp2(-0.022542110013889f * v[i]));
        st_bf4(z + (size_t)row * ZC + Z_G + col, v); }
    DEVI void v8(int row, int col, f32x4 a, f32x4 b) const {
#pragma unroll
        for (int i = 0; i < 4; ++i) { a[i] = frcp(1.f + fexp2(-0.022542110013889f * a[i])); b[i] = frcp(1.f + fexp2(-0.022542110013889f * b[i])); }
        if (GATES_ST8) { u32x2 w; w.x = pk4_fp8(a * 256.f); w.y = pk4_fp8(b * 256.f); *(u32x2*)((unsigned char*)(z + (size_t)row * ZC + Z_G) + col) = w; }
        else st_bf8(z + (size_t)row * ZC + Z_G + col, a, b); } };
struct EpiBf { bf16_t* o; int ldo;
    DEVI void operator()(int row, int col, f32x4 v) const { st_bf4(o + (size_t)row * ldo + col, v); }
    DEVI void v8(int row, int col, f32x4 a, f32x4 b) const { st_bf8(o + (size_t)row * ldo + col, a, b); } };
struct EpiKV { bf16_t* k; bf16_t* v_; const float* rs;
    DEVI void operator()(int row, int col, f32x4 v) const {
        const float s = rs[row]; v = v * s; const int h = col >> 7, c = col & 127;
        if (c < 64) st_bf4(k + (size_t)row * 768 + h * 96 + c, v); else st_bf4(v_ + (size_t)row * 512 + h * 64 + (c - 64), v); }
    DEVI void v8(int row, int col, f32x4 a, f32x4 b) const {
        const float s = rs[row]; a = a * s; b = b * s; const int h = col >> 7, c = col & 127;
        if (c < 64) st_bf8(k + (size_t)row * 768 + h * 96 + c, a, b); else st_bf8(v_ + (size_t)row * 512 + h * 64 + (c - 64), a, b); } };
struct EpiWo { const float* xin; float* x; const float* g;
    DEVI void operator()(int row, int col, f32x4 v) const {
        const float* gp = g + (row >= S_ ? 6144 : 0) + col; float* xp = x + (size_t)row * DM + col;
        f32x4 xv = *(const f32x4*)(xin + (size_t)row * DM + col); const f32x4 gv = *(const f32x4*)gp; xv = xv + gv * v; *(f32x4*)xp = xv; }
    DEVI void v8(int row, int col, f32x4 a, f32x4 b) const {
        const float* gp = g + (row >= S_ ? 6144 : 0) + col; float* xp = x + (size_t)row * DM + col; const float* xi = xin + (size_t)row * DM + col;
        f32x4 x0 = *(const f32x4*)xi, x1 = *(const f32x4*)(xi + 4); const f32x4 g0 = *(const f32x4*)gp, g1 = *(const f32x4*)(gp + 4);
        x0 = x0 + g0 * a; x1 = x1 + g1 * b; *(f32x4*)xp = x0; *(f32x4*)(xp + 4) = x1; } };
struct EpiWoB { const float* xin32; const bf16_t* xinb; bf16_t* xo; const float* g;
    DEVI void operator()(int row, int col, f32x4 v) const {
        const float* gp = g + (row >= S_ ? 6144 : 0) + col; const f32x4 gv = *(const f32x4*)gp;
        f32x4 xv = xin32 ? *(const f32x4*)(xin32 + (size_t)row * DM + col) : ld_bf4(xinb + (size_t)row * DM + col); st_bf4(xo + (size_t)row * DM + col, xv + gv * v); }
    DEVI void v8(int row, int col, f32x4 a, f32x4 b) const {
        const float* gp = g + (row >= S_ ? 6144 : 0) + col; const f32x4 g0 = *(const f32x4*)gp, g1 = *(const f32x4*)(gp + 4); f32x4 x0, x1;
        if (xin32) { const float* xi = xin32 + (size_t)row * DM + col; x0 = *(const f32x4*)xi; x1 = *(const f32x4*)(xi + 4); }
        else { const u32x4 w = *(const u32x4*)(xinb + (size_t)row * DM + col); x0 = (f32x4){bflo(w.x), bfhi(w.x), bflo(w.y), bfhi(w.y)}; x1 = (f32x4){bflo(w.z), bfhi(w.z), bflo(w.w), bfhi(w.w)}; }
        st_bf8(xo + (size_t)row * DM + col, x0 + g0 * a, x1 + g1 * b); } };
struct EpiMergeLast { bf16_t* mg; const bf16_t* gate;
    DEVI void operator()(int row, int col, f32x4 v) const { const f32x4 g = ld_bf4(gate + (size_t)row * ZC + col); st_bf4(mg + (size_t)row * DM + col, g * v); }
    DEVI void v8(int row, int col, f32x4 a, f32x4 b) const {
        if (GATES_ST8) { const u32x2 w = *(const u32x2*)((const unsigned char*)(gate + (size_t)row * ZC) + col);
            const f32x2 g01 = __builtin_amdgcn_cvt_pk_f32_fp8((int)w.x, false), g23 = __builtin_amdgcn_cvt_pk_f32_fp8((int)w.x, true), g45 = __builtin_amdgcn_cvt_pk_f32_fp8((int)w.y, false), g67 = __builtin_amdgcn_cvt_pk_f32_fp8((int)w.y, true);
            const f32x4 g0 = (f32x4){g01[0], g01[1], g23[0], g23[1]} * (1.f / 256.f), g1 = (f32x4){g45[0], g45[1], g67[0], g67[1]} * (1.f / 256.f); st_bf8(mg + (size_t)row * DM + col, g0 * a, g1 * b); }
        else { const u32x4 w = *(const u32x4*)(gate + (size_t)row * ZC + col);
        const f32x4 g0 = (f32x4){bflo(w.x), bfhi(w.x), bflo(w.y), bfhi(w.y)}, g1 = (f32x4){bflo(w.z), bfhi(w.z), bflo(w.w), bfhi(w.w)}; st_bf8(mg + (size_t)row * DM + col, g0 * a, g1 * b); } } };
struct EpiScT { float* s;
    DEVI void operator()(int row, int col, f32x4 v) const {
#pragma unroll
        for (int i = 0; i < 4; ++i) s[(size_t)(col + i) * T_ + row] = v[i]; } };

namespace pg8 {
#define PG8_LAS __attribute__((address_space(3)))
constexpr int BM = 256, BK = 64, HALF = 128, HTB = HALF * BK * 2  , STAGE_BYTES = 8 * HTB, NXCD = 8, WGM = 8;

__host__ __device__ __forceinline__ int lds_byte(int r, int c) { const int st = (r >> 4) * 2 + (c >> 5), rr = r & 15, cc = c & 31, ob = rr * 64 + cc * 2; return st * 1024 + (ob ^ (((ob >> 9) & 1) << 5)); }
__host__ __device__ __forceinline__ void stage_rc(int b, int& R, int& C) { const int st = b / 1024, sb = b % 1024, swz = sb ^ (((sb >> 9) & 1) << 5); R = (st >> 1) * 16 + swz / 64; C = (st & 1) * 32 + (swz % 64) / 2; }
__host__ __device__ __forceinline__ int perm32(int rho) { const int n = rho >> 4, i = rho & 15; return 8 * (i >> 2) + 4 * n + (i & 3); }
struct Unit { int pm, pn; };
struct Gemm { const bf16_t* A; const bf16_t* Bt; int M, N, K, lda, ldb; };
struct StaticOrder {
    int nM, nN, nwg, G, c;
    __host__ __device__ void init(int M, int N, int G_, int c_) { nM = M / BM; nN = N / BM; nwg = nM * nN; G = G_; c = c_; }
    __host__ __device__ bool next(int i, Unit& u) const {
        const long L = (long)i * G + c; if (L >= nwg) return false;
        int wgid = (int)L; { const int q = nwg / NXCD, r = nwg % NXCD, xcd = wgid % NXCD, off = wgid / NXCD; wgid = (xcd < r ? xcd * (q + 1) : r * (q + 1) + (xcd - r) * q) + off; }
        const int nig = WGM * nN, gid = wgid / nig, fm = gid * WGM, gsz = (nM - fm) < WGM ? (nM - fm) : WGM;
        u.pm = fm + ((wgid % nig) % gsz); u.pn = (wgid % nig) / gsz; return true;
    }
    __device__ __forceinline__ void a_ready(const Unit&) const {}
    __device__ __forceinline__ void done(const Unit&) const {}
};
struct PairOrder { int v;
    __host__ __device__ static void item(int v, int i, int& h, int& j) { const int idx = (v >> 3) * 2 + i; h = idx & 7; j = (v & 7) + 8 * (idx >> 3); }
    __host__ __device__ bool next(int i, Unit& u) const { if (i >= 4) return false; int h, j; item(v, i >> 1, h, j); u.pm = 2 * j + (i & 1); u.pn = h; return true; }
    __device__ __forceinline__ void a_ready(const Unit&) const {}
    __device__ __forceinline__ void done(const Unit&) const {}
};
template <class F> struct EpiAd { static constexpr bool PERM = (EPI_PERM != 0), AFTER_DRAIN = false; F f;
    __device__ __forceinline__ void operator()(const f32x4 (&acc)[2][2][4][2], const Unit& u, int wr, int wc, int fr, int fq) const {
#pragma unroll
        for (int ai = 0; ai < 2; ++ai)
#pragma unroll
            for (int m = 0; m < 4; ++m)
#pragma unroll
                for (int bj = 0; bj < 2; ++bj) {
                    if constexpr (PERM) f.v8(u.pm * BM + ai * HALF + wr * 64 + m * 16 + fr, u.pn * BM + bj * HALF + wc * 32 + 8 * fq, acc[ai][bj][m][0], acc[ai][bj][m][1]);
                    else {
#pragma unroll
                        for (int n = 0; n < 2; ++n) f(u.pm * BM + ai * HALF + wr * 64 + m * 16 + fr, u.pn * BM + bj * HALF + wc * 32 + n * 16 + 4 * fq, acc[ai][bj][m][n]); }
                }
    } };
struct NoSeg { static constexpr bool ON = false; };
struct GateSeg { static constexpr bool ON = true; const bf16_t* gate; int ldg, gstride, t0, t1;
#if EPI_PERM
    __device__ __forceinline__ void rescale(f32x4 (&acc)[2][2][4][2], const Unit& u, int s, int wr, int wc, int fr, int fq) const {
        const bf16_t* g0 = gate + (size_t)(u.pm * BM + wr * 64 + fr) * ldg + (size_t)s * gstride + u.pn * BM + wc * 32 + 8 * fq;
#if GATES_ST8
        const unsigned char* g8 = (const unsigned char*)(gate + (size_t)(u.pm * BM + wr * 64 + fr) * ldg) + (size_t)s * 1024 + u.pn * BM + wc * 32 + 8 * fq;
        u32x2 ga[2][2][2], gb[2][2][2];
#define PG8_GLOAD(bf, ai, mh) do { _Pragma("unroll") for (int mm = 0; mm < 2; ++mm) _Pragma("unroll") for (int bj = 0; bj < 2; ++bj) { \
            const unsigned char* gp = g8 + (size_t)((ai) * HALF + (2 * (mh) + mm) * 16) * ldg * 2 + bj * HALF; ga[bf][mm][bj] = *(const u32x2*)gp; gb[bf][mm][bj] = *(const u32x2*)(gp + 1024); } } while (0)
#define PG8_GR(x, y) ((x) * __builtin_amdgcn_rcpf(__builtin_fmaxf((y), 1e-20f)))
#define PG8_GMUL(bf, ai, mh) do { _Pragma("unroll") for (int mm = 0; mm < 2; ++mm) _Pragma("unroll") for (int bj = 0; bj < 2; ++bj) { \
            const u32x2 a_ = ga[bf][mm][bj], b_ = gb[bf][mm][bj]; f32x4& c0 = acc[ai][bj][2 * (mh) + mm][0]; f32x4& c1 = acc[ai][bj][2 * (mh) + mm][1]; \
            const f32x2 a01 = __builtin_amdgcn_cvt_pk_f32_fp8((int)a_.x, false), a23 = __builtin_amdgcn_cvt_pk_f32_fp8((int)a_.x, true), a45 = __builtin_amdgcn_cvt_pk_f32_fp8((int)a_.y, false), a67 = __builtin_amdgcn_cvt_pk_f32_fp8((int)a_.y, true); \
            const f32x2 b01 = __builtin_amdgcn_cvt_pk_f32_fp8((int)b_.x, false), b23 = __builtin_amdgcn_cvt_pk_f32_fp8((int)b_.x, true), b45 = __builtin_amdgcn_cvt_pk_f32_fp8((int)b_.y, false), b67 = __builtin_amdgcn_cvt_pk_f32_fp8((int)b_.y, true); \
            c0[0] *= PG8_GR(a01[0], b01[0]); c0[1] *= PG8_GR(a01[1], b01[1]); c0[2] *= PG8_GR(a23[0], b23[0]); c0[3] *= PG8_GR(a23[1], b23[1]); \
            c1[0] *= PG8_GR(a45[0], b45[0]); c1[1] *= PG8_GR(a45[1], b45[1]); c1[2] *= PG8_GR(a67[0], b67[0]); c1[3] *= PG8_GR(a67[1], b67[1]); } } while (0)
#else
        u32x4 ga[2][2][2], gb[2][2][2];
#define PG8_GLOAD(bf, ai, mh) do { _Pragma("unroll") for (int mm = 0; mm < 2; ++mm) _Pragma("unroll") for (int bj = 0; bj < 2; ++bj) { \
            const bf16_t* gp = g0 + (size_t)((ai) * HALF + (2 * (mh) + mm) * 16) * ldg + bj * HALF; ga[bf][mm][bj] = *(const u32x4*)gp; gb[bf][mm][bj] = *(const u32x4*)(gp + gstride); } } while (0)
#define PG8_GR(x, y) ((x) * __builtin_amdgcn_rcpf(__builtin_fmaxf((y), 1e-20f)))
#define PG8_GMUL(bf, ai, mh) do { _Pragma("unroll") for (int mm = 0; mm < 2; ++mm) _Pragma("unroll") for (int bj = 0; bj < 2; ++bj) { \
            const u32x4 a_ = ga[bf][mm][bj], b_ = gb[bf][mm][bj]; f32x4& c0 = acc[ai][bj][2 * (mh) + mm][0]; f32x4& c1 = acc[ai][bj][2 * (mh) + mm][1]; \
            c0[0] *= PG8_GR(bflo(a_.x), bflo(b_.x)); c0[1] *= PG8_GR(bfhi(a_.x), bfhi(b_.x)); c0[2] *= PG8_GR(bflo(a_.y), bflo(b_.y)); c0[3] *= PG8_GR(bfhi(a_.y), bfhi(b_.y)); \
            c1[0] *= PG8_GR(bflo(a_.z), bflo(b_.z)); c1[1] *= PG8_GR(bfhi(a_.z), bfhi(b_.z)); c1[2] *= PG8_GR(bflo(a_.w), bflo(b_.w)); c1[3] *= PG8_GR(bfhi(a_.w), bfhi(b_.w)); } } while (0)
#endif
        PG8_GLOAD(0, 0, 0); __builtin_amdgcn_sched_barrier(0);
        PG8_GLOAD(1, 0, 1); __builtin_amdgcn_sched_barrier(0); PG8_GMUL(0, 0, 0); __builtin_amdgcn_sched_barrier(0);
        PG8_GLOAD(0, 1, 0); __builtin_amdgcn_sched_barrier(0); PG8_GMUL(1, 0, 1); __builtin_amdgcn_sched_barrier(0);
        PG8_GLOAD(1, 1, 1); __builtin_amdgcn_sched_barrier(0); PG8_GMUL(0, 1, 0); __builtin_amdgcn_sched_barrier(0);
        PG8_GMUL(1, 1, 1); __builtin_amdgcn_sched_barrier(0);
#undef PG8_GLOAD
#undef PG8_GR
#undef PG8_GMUL
    }
#else
    __device__ __forceinline__ void rescale(f32x4 (&acc)[2][2][4][2], const Unit& u, int s, int wr, int wc, int fr, int fq) const {
        const bf16_t* g0 = gate + (size_t)(u.pm * BM + wr * 64 + fr) * ldg + (size_t)s * gstride + u.pn * BM + wc * 32 + 4 * fq;
#pragma unroll
        for (int ai = 0; ai < 2; ++ai)
#pragma unroll
            for (int mh = 0; mh < 2; ++mh) {
                u32x2 ga[2][4], gb[2][4];
#pragma unroll
                for (int mm = 0; mm < 2; ++mm)
#pragma unroll
                    for (int q = 0; q < 4; ++q) { const bf16_t* gp = g0 + (size_t)(ai * HALF + (2 * mh + mm) * 16) * ldg + (q >> 1) * HALF + (q & 1) * 16;
                        ga[mm][q] = *(const u32x2*)gp; gb[mm][q] = *(const u32x2*)(gp + gstride); }
                __builtin_amdgcn_sched_barrier(0);
#pragma unroll
                for (int mm = 0; mm < 2; ++mm)
#pragma unroll
                    for (int q = 0; q < 4; ++q) { f32x4& a = acc[ai][q >> 1][2 * mh + mm][q & 1];
                        a[0] *= bflo(ga[mm][q].x) * __builtin_amdgcn_rcpf(__builtin_fmaxf(bflo(gb[mm][q].x), 1e-20f)); a[1] *= bfhi(ga[mm][q].x) * __builtin_amdgcn_rcpf(__builtin_fmaxf(bfhi(gb[mm][q].x), 1e-20f));
                        a[2] *= bflo(ga[mm][q].y) * __builtin_amdgcn_rcpf(__builtin_fmaxf(bflo(gb[mm][q].y), 1e-20f)); a[3] *= bfhi(ga[mm][q].y) * __builtin_amdgcn_rcpf(__builtin_fmaxf(bfhi(gb[mm][q].y), 1e-20f)); }
                __builtin_amdgcn_sched_barrier(0);
            }
    }
#endif
};
template <class Epi, class Sched, bool ALIGN_EPI = false, bool SP2 = false, class Seg = NoSeg, bool F8 = false>
__device__ __forceinline__ void gemm_phase(PG8_LAS unsigned char* lds, const Gemm g, const Sched& S, const Epi& E, const Seg& SG = Seg()) {
    const int tid = tid_(), wid = __builtin_amdgcn_readfirstlane(tid >> 6), lane = tid & 63, wr = wid >> 2, wc = wid & 3, fr = lane & 15, fq = lane >> 4;
    const int K = g.K, nt = K / BK, lda = g.lda, ldb = g.ldb;
    unsigned voffA[2], voffB[2];
#pragma unroll
    for (int i = 0; i < 2; ++i) { int R, C; stage_rc(tid * 16 + i * 8192, R, C); const int Rb = Epi::PERM ? ((R & ~31) + perm32(R & 31)) : R;
        voffA[i] = (unsigned)(R * lda + C) * 2u; voffB[i] = (unsigned)(Rb * ldb + C) * 2u; }
    const size_t kstep = (size_t)(BK * 2);
    const size_t hstepA = (size_t)HALF * lda * 2, hstepB = (size_t)HALF * ldb * 2;
    const size_t tstepA = 2 * hstepA, tstepB = 2 * hstepB;
    const unsigned ldsw = (unsigned)wid * 1024u;
    const int aoff = lds_byte(wr * 64 + fr, fq * 8), boff = lds_byte(wc * 32 + fr, fq * 8);
    const int a8o0 = lds_byte(wr * 64 + fr, (fq & 1) * 16) + (fq >> 1) * 1024, a8o1 = lds_byte(wr * 64 + fr, (fq & 1) * 16 + 8) + (fq >> 1) * 1024;
    const int b8o0 = lds_byte(wc * 32 + fr, (fq & 1) * 16) + (fq >> 1) * 1024, b8o1 = lds_byte(wc * 32 + fr, (fq & 1) * 16 + 8) + (fq >> 1) * 1024;
    typedef int i32x8 __attribute__((ext_vector_type(8))); typedef int i32x4 __attribute__((ext_vector_type(4)));
    int sc1_ = 127; asm volatile("" : "+v"(sc1_));
#define PG8_SA(b, h) (((b) * 2 + (h)) * HTB)
#define PG8_SB(b, h) ((4 + (b) * 2 + (h)) * HTB)
#define PG8_STAGE(bufoff, gbase, voff) do { _Pragma("unroll") for (int _i = 0; _i < 2; ++_i) \
        __builtin_amdgcn_global_load_lds((const unsigned*)((const char*)(gbase) + (voff)[_i]), (PG8_LAS unsigned*)(lds + (bufoff) + ldsw + _i * 8192), 16, 0, 0); } while (0)
#define PG8_LD8(off) (*(const PG8_LAS i32x4*)(lds + (off)))
#define PG8_LDA(dst, b, h) do { if constexpr (F8) { _Pragma("unroll") for (int m = 0; m < 4; ++m) dst##8[m] = __builtin_shufflevector(PG8_LD8(PG8_SA(b, h) + a8o0 + m * 2048), PG8_LD8(PG8_SA(b, h) + a8o1 + m * 2048), 0, 1, 2, 3, 4, 5, 6, 7); } \
        else { _Pragma("unroll") for (int m = 0; m < 4; ++m) _Pragma("unroll") for (int k = 0; k < 2; ++k) dst[m][k] = *(const PG8_LAS bf16x8*)(lds + PG8_SA(b, h) + aoff + m * 2048 + k * 1024); } } while (0)
#define PG8_LDB(dst, b, h) do { if constexpr (F8) { _Pragma("unroll") for (int n = 0; n < 2; ++n) dst##8[n] = __builtin_shufflevector(PG8_LD8(PG8_SB(b, h) + b8o0 + n * 2048), PG8_LD8(PG8_SB(b, h) + b8o1 + n * 2048), 0, 1, 2, 3, 4, 5, 6, 7); } \
        else { _Pragma("unroll") for (int n = 0; n < 2; ++n) _Pragma("unroll") for (int k = 0; k < 2; ++k) dst[n][k] = *(const PG8_LAS bf16x8*)(lds + PG8_SB(b, h) + boff + n * 2048 + k * 1024); } } while (0)
#define PG8_MMA(ai, bj, At, Bt) do { __builtin_amdgcn_s_setprio(1); \
        if constexpr (F8) { _Pragma("unroll") for (int m = 0; m < 4; ++m) _Pragma("unroll") for (int n = 0; n < 2; ++n) \
            asm volatile("v_mfma_scale_f32_16x16x128_f8f6f4 %0, %1, %2, %0, %3, %3 op_sel_hi:[0,0,0]" : "+v"(acc[ai][bj][m][n]) : "v"(Bt##8[n]), "v"(At##8[m]), "v"(sc1_)); } \
        else { _Pragma("unroll") for (int m = 0; m < 4; ++m) _Pragma("unroll") for (int n = 0; n < 2; ++n) _Pragma("unroll") for (int k = 0; k < 2; ++k) \
            acc[ai][bj][m][n] = __builtin_amdgcn_mfma_f32_16x16x32_bf16(Bt[n][k], At[m][k], acc[ai][bj][m][n], 0, 0, 0); } \
        __builtin_amdgcn_s_setprio(0); } while (0)
#define PG8_WAIT_V(n) asm volatile("s_waitcnt vmcnt(" #n ")" ::: "memory")
#define PG8_WAIT_L(n) asm volatile("s_waitcnt lgkmcnt(" #n ")" ::: "memory")
#define PG8_BAR __builtin_amdgcn_s_barrier()
#define PG8_SCHED __builtin_amdgcn_sched_barrier(0)
    Unit cur, nxt; int ui = 0;
    if (!S.next(0, cur)) return;
    f32x4 acc[2][2][4][2];
#pragma unroll
    for (int a = 0; a < 2; ++a)
#pragma unroll
        for (int b = 0; b < 2; ++b)
#pragma unroll
            for (int m = 0; m < 4; ++m)
#pragma unroll
                for (int n = 0; n < 2; ++n) acc[a][b][m][n] = (f32x4){0.f, 0.f, 0.f, 0.f};
    bf16x8 At[4][2], B0[2][2], B1[2][2];
    i32x8 At8[4], B08[2], B18[2];
    const char* cA = (const char*)g.A + (size_t)cur.pm * tstepA; const char* cB = (const char*)g.Bt + (size_t)cur.pn * tstepB;
    S.a_ready(cur);
    if constexpr (SP2) {
        PG8_STAGE(PG8_SB(0, 0), cB, voffB); PG8_STAGE(PG8_SB(0, 1), cB + hstepB, voffB); PG8_STAGE(PG8_SA(0, 0), cA, voffA); PG8_STAGE(PG8_SA(0, 1), cA + hstepA, voffA);
        if (wr == 1) PG8_BAR;
        PG8_WAIT_V(2); PG8_BAR;
        PG8_STAGE(PG8_SB(1, 0), cB + kstep, voffB); PG8_STAGE(PG8_SA(1, 0), cA + kstep, voffA); PG8_STAGE(PG8_SB(1, 1), cB + hstepB + kstep, voffB);
        PG8_WAIT_V(6); PG8_BAR;
    } else {
        PG8_STAGE(PG8_SB(0, 0), cB, voffB); PG8_STAGE(PG8_SA(0, 0), cA, voffA); PG8_STAGE(PG8_SB(0, 1), cB + hstepB, voffB); PG8_STAGE(PG8_SA(0, 1), cA + hstepA, voffA);
        if (wr == 1) PG8_BAR;
        PG8_WAIT_V(4); PG8_BAR;
        PG8_STAGE(PG8_SB(1, 0), cB + kstep, voffB); PG8_STAGE(PG8_SA(1, 0), cA + kstep, voffA); PG8_STAGE(PG8_SB(1, 1), cB + hstepB + kstep, voffB);
        PG8_WAIT_V(6); PG8_BAR;
    }
    for (;;) {
        const bool has_next = S.next(ui + 1, nxt);
        const char* nA = has_next ? (const char*)g.A + (size_t)nxt.pm * tstepA : cA; const char* nB = has_next ? (const char*)g.Bt + (size_t)nxt.pn * tstepB : cB;
#pragma unroll 1
        for (int t = 0; t < nt; t += 2) {
            if constexpr (Seg::ON) { if (t == SG.t0 || t == SG.t1) SG.rescale(acc, cur, (t == SG.t0) ? 0 : 1, wr, wc, fr, fq); }
            const bool last = (t == nt - 2);
            const char* a1 = cA + (size_t)(t + 1) * kstep;
            const char* a2 = last ? nA : cA + (size_t)(t + 2) * kstep; const char* b2 = last ? nB : cB + (size_t)(t + 2) * kstep;
            const char* a3 = a2 + kstep; const char* b3 = b2 + kstep;
            if (last && has_next) S.a_ready(nxt);
            if constexpr (SP2) {
            PG8_LDB(B0, 0, 0); PG8_LDB(B1, 0, 1); PG8_SCHED; PG8_LDA(At, 0, 0); PG8_STAGE(PG8_SA(1, 1), a1 + hstepA, voffA);
            PG8_WAIT_V(8); PG8_WAIT_L(0); PG8_BAR; PG8_MMA(0, 0, At, B0); PG8_MMA(0, 1, At, B1); PG8_BAR; PG8_SCHED;
            PG8_LDA(At, 0, 1); PG8_STAGE(PG8_SB(0, 0), b2, voffB); PG8_STAGE(PG8_SB(0, 1), b2 + hstepB, voffB); PG8_STAGE(PG8_SA(0, 0), a2, voffA);
            PG8_WAIT_V(8); PG8_WAIT_L(0); PG8_BAR; PG8_MMA(1, 0, At, B0); PG8_MMA(1, 1, At, B1); PG8_BAR; PG8_SCHED;
            PG8_LDB(B0, 1, 0); PG8_LDB(B1, 1, 1); PG8_SCHED; PG8_LDA(At, 1, 0); PG8_STAGE(PG8_SA(0, 1), a2 + hstepA, voffA);
            PG8_WAIT_V(8); PG8_WAIT_L(0); PG8_BAR; PG8_MMA(0, 0, At, B0); PG8_MMA(0, 1, At, B1); PG8_BAR; PG8_SCHED;
            PG8_LDA(At, 1, 1); PG8_STAGE(PG8_SB(1, 0), b3, voffB); PG8_STAGE(PG8_SB(1, 1), b3 + hstepB, voffB); PG8_STAGE(PG8_SA(1, 0), a3, voffA);
            PG8_WAIT_V(8); PG8_WAIT_L(0); PG8_BAR; PG8_MMA(1, 0, At, B0); PG8_MMA(1, 1, At, B1); PG8_BAR; PG8_SCHED;
            } else {
            PG8_LDB(B0, 0, 0); PG8_SCHED; PG8_LDA(At, 0, 0); PG8_STAGE(PG8_SA(1, 1), a1 + hstepA, voffA);
            PG8_WAIT_L(8); PG8_BAR; PG8_WAIT_L(0); PG8_MMA(0, 0, At, B0); PG8_BAR; PG8_SCHED;
            PG8_LDB(B1, 0, 1); PG8_STAGE(PG8_SB(0, 0), b2, voffB);
            PG8_BAR; PG8_WAIT_L(0); PG8_MMA(0, 1, At, B1); PG8_BAR;
            PG8_LDA(At, 0, 1); PG8_STAGE(PG8_SA(0, 0), a2, voffA);
            PG8_BAR; PG8_WAIT_L(0); PG8_MMA(1, 0, At, B0); PG8_BAR; PG8_SCHED;
            PG8_STAGE(PG8_SB(0, 1), b2 + hstepB, voffB);
            PG8_WAIT_V(6); PG8_BAR; PG8_MMA(1, 1, At, B1); PG8_BAR;
            PG8_LDB(B0, 1, 0); PG8_SCHED; PG8_LDA(At, 1, 0); PG8_STAGE(PG8_SA(0, 1), a2 + hstepA, voffA);
            PG8_WAIT_L(8); PG8_BAR; PG8_WAIT_L(0); PG8_MMA(0, 0, At, B0); PG8_BAR; PG8_SCHED;
            PG8_LDB(B1, 1, 1); PG8_STAGE(PG8_SB(1, 0), b3, voffB);
            PG8_BAR; PG8_WAIT_L(0); PG8_MMA(0, 1, At, B1); PG8_BAR;
            PG8_LDA(At, 1, 1); PG8_STAGE(PG8_SA(1, 0), a3, voffA);
            PG8_BAR; PG8_WAIT_L(0); PG8_MMA(1, 0, At, B0); PG8_BAR; PG8_SCHED;
            PG8_STAGE(PG8_SB(1, 1), b3 + hstepB, voffB);
            PG8_WAIT_V(6); PG8_BAR; PG8_MMA(1, 1, At, B1); PG8_BAR;
            }
        }
        if constexpr (ALIGN_EPI) { if (wr == 0) PG8_BAR; }
        if constexpr (F8) asm volatile("s_nop 15\n\ts_nop 15" ::: "memory");
        if constexpr (!Epi::AFTER_DRAIN) { E(acc, cur, wr, wc, fr, fq); S.done(cur); }
        if (!has_next) break;
#pragma unroll
        for (int a = 0; a < 2; ++a)
#pragma unroll
            for (int b = 0; b < 2; ++b)
#pragma unroll
                for (int m = 0; m < 4; ++m)
#pragma unroll
                    for (int n = 0; n < 2; ++n) acc[a][b][m][n] = (f32x4){0.f, 0.f, 0.f, 0.f};
        cur = nxt; cA = nA; cB = nB; ++ui;
        if constexpr (ALIGN_EPI) { if (wr == 1) PG8_BAR; }
    }
    PG8_WAIT_V(0);
    if constexpr (!ALIGN_EPI) { if (wr == 0) PG8_BAR; }
    PG8_BAR;
    if constexpr (Epi::AFTER_DRAIN) { E.fused(acc, cur, wr, wc, fr, fq, lds, wid, lane); S.done(cur); }
#undef PG8_SA
#undef PG8_SB
#undef PG8_STAGE
#undef PG8_LDA
#undef PG8_LDB
#undef PG8_MMA
#undef PG8_LD8
#undef PG8_WAIT_V
#undef PG8_WAIT_L
#undef PG8_BAR
#undef PG8_SCHED
}
}
template <class F> DEVI void gemm256_phase_f8(const unsigned char* A, int lda_bytes, const unsigned char* Bt, int ldb_bytes, int M, int N, int K, char* lds, const F& f) {
    pg8::Gemm g{(const bf16_t*)A, (const bf16_t*)Bt, M, N, opaque_i32(K >> 1), opaque_i32(lda_bytes >> 1), opaque_i32(ldb_bytes >> 1)}; pg8::StaticOrder S; S.init(M, N, (int)gridDim.x, (int)blockIdx.x); pg8::EpiAd<F> E{f};
    __syncthreads();
    pg8::gemm_phase<pg8::EpiAd<F>, pg8::StaticOrder, true, true, pg8::NoSeg, true>((PG8_LAS unsigned char*)lds, g, S, E);
}
template <class F> DEVI void gemm256_phase_seg(const bf16_t* A, int lda, const bf16_t* Bt, int ldb, int M, int N, int K, char* lds, const F& f, const pg8::GateSeg& sg) {
    pg8::Gemm g{A, Bt, M, N, opaque_i32(K), opaque_i32(lda), opaque_i32(ldb)}; pg8::StaticOrder S; S.init(M, N, (int)gridDim.x, (int)blockIdx.x); pg8::EpiAd<F> E{f};
    __syncthreads();
    pg8::gemm_phase<pg8::EpiAd<F>, pg8::StaticOrder, true, true, pg8::GateSeg>((PG8_LAS unsigned char*)lds, g, S, E, sg);
}
template <class F> DEVI void gemm256_pair(const bf16_t* A, int lda, const bf16_t* Bt, int ldb, int M, int N, int K, char* lds, const F& f, int v) {
    pg8::Gemm g{A, Bt, M, N, opaque_i32(K), opaque_i32(lda), opaque_i32(ldb)}; pg8::PairOrder S{v}; pg8::EpiAd<F> E{f};
    __syncthreads();
    pg8::gemm_phase<pg8::EpiAd<F>, pg8::PairOrder, true, true>((PG8_LAS unsigned char*)lds, g, S, E);
}
template <class F> DEVI void gemm256_phase(const bf16_t* A, int lda, const bf16_t* Bt, int ldb, int M, int N, int K, char* lds, const F& f) {
    pg8::Gemm g{A, Bt, M, N, opaque_i32(K), opaque_i32(lda), opaque_i32(ldb)}; pg8::StaticOrder S; S.init(M, N, (int)gridDim.x, (int)blockIdx.x); pg8::EpiAd<F> E{f};
    __syncthreads();
    pg8::gemm_phase<pg8::EpiAd<F>, pg8::StaticOrder, true, true>((PG8_LAS unsigned char*)lds, g, S, E);
}

DEVI void job_transpose(const float* __restrict__ src, int K, int N, bf16_t* __restrict__ dst, int mapmode, const float* __restrict__ kscale, char* lds, int& rot, int ldd = 0, int spitch = 0) {
    if (spitch == 0) spitch = N;
    if (ldd == 0) ldd = K;
    float* tile = (float*)lds;
    const int tid = tid_(), nkt = K >> 6, nnt = (N + 127) >> 7, ntile = nkt * nnt;
    const int bfirst = (int)((blockIdx.x + gridDim.x - (unsigned)rot % gridDim.x) % gridDim.x); rot += ntile;
    for (int t = bfirst; t < ntile; t += gridDim.x) {
        const int kt = t / nnt, ntl = t - kt * nnt, k0 = kt * 64, n0 = ntl * 128, ncols = (N - n0 < 128) ? (N - n0) : 128;
        __syncthreads();
#pragma unroll
        for (int i = 0; i < 4; ++i) { const int id = tid + i * NTHR, r = id >> 5, c4 = (id & 31) * 4;
            if (c4 < ncols) { f32x4 v = *(const f32x4*)(src + (size_t)(k0 + r) * spitch + n0 + c4);
                if (kscale) { const float s = kscale[k0 + r]; v = v * s; }
                tile[r * 129 + c4] = v[0]; tile[r * 129 + c4 + 1] = v[1]; tile[r * 129 + c4 + 2] = v[2]; tile[r * 129 + c4 + 3] = v[3]; } }
        __syncthreads();
#pragma unroll
        for (int i = 0; i < 2; ++i) { const int id = tid + i * NTHR, nl = id >> 3, kc = (id & 7) * 8;
            if (nl < ncols) { int n = n0 + nl;
                if (mapmode == 1) { n = (n < 1152) ? n : (n < 1184) ? n + 256 : (n < 1440) ? n - 32 : n + 96; }
                u32x4 w; w.x = cvtpk(tile[(kc + 0) * 129 + nl], tile[(kc + 1) * 129 + nl]); w.y = cvtpk(tile[(kc + 2) * 129 + nl], tile[(kc + 3) * 129 + nl]);
                w.z = cvtpk(tile[(kc + 4) * 129 + nl], tile[(kc + 5) * 129 + nl]); w.w = cvtpk(tile[(kc + 6) * 129 + nl], tile[(kc + 7) * 129 + nl]);
                *(u32x4*)(dst + (size_t)n * ldd + k0 + kc) = w; } }
    }
}
DEVI void job_transpose8(const float* __restrict__ src, int lds_src, int K, int N, unsigned char* __restrict__ dst, float mul, char* lds, int& rot) {
    float* tile = (float*)lds;
    const int tid = tid_(), nkt = K >> 6, nnt = N >> 7, ntile = nkt * nnt;
    const int bfirst = (int)((blockIdx.x + gridDim.x - (unsigned)rot % gridDim.x) % gridDim.x); rot += ntile;
    for (int t = bfirst; t < ntile; t += gridDim.x) {
        const int kt = t / nnt, ntl = t - kt * nnt, k0 = kt * 64, n0 = ntl * 128;
        __syncthreads();
#pragma unroll
        for (int i = 0; i < 4; ++i) { const int id = tid + i * NTHR, r = id >> 5, c4 = (id & 31) * 4; const f32x4 v = *(const f32x4*)(src + (size_t)(k0 + r) * lds_src + n0 + c4) * mul;
            tile[r * 129 + c4] = v[0]; tile[r * 129 + c4 + 1] = v[1]; tile[r * 129 + c4 + 2] = v[2]; tile[r * 129 + c4 + 3] = v[3]; }
        __syncthreads();
#pragma unroll
        for (int i = 0; i < 2; ++i) { const int id = tid + i * NTHR, nl = id >> 3, kc = (id & 7) * 8; u32x2 w;
            w.x = pk4_fp8((f32x4){tile[(kc + 0) * 129 + nl], tile[(kc + 1) * 129 + nl], tile[(kc + 2) * 129 + nl], tile[(kc + 3) * 129 + nl]});
            w.y = pk4_fp8((f32x4){tile[(kc + 4) * 129 + nl], tile[(kc + 5) * 129 + nl], tile[(kc + 6) * 129 + nl], tile[(kc + 7) * 129 + nl]});
            *(u32x2*)(dst + (size_t)(n0 + nl) * K + k0 + kc) = w; }
    }
}
DEVI void job_convert(const float* __restrict__ src, bf16_t* __restrict__ dst, size_t n4, int tril) {
    const size_t stride = (size_t)gridDim.x * NTHR;
    for (size_t i = (size_t)blockIdx.x * NTHR + tid_(); i < n4; i += stride) {
        f32x4 v = *(const f32x4*)(src + i * 4);
        if (tril) { const int e = (int)((i * 4) & 16383), t = e >> 7, s = e & 127;
#pragma unroll
            for (int j = 0; j < 4; ++j) if (s + j > t) v[j] = 0.f; }
        st_bf4(dst + i * 4, v);
    }
}
DEVI void job_quant_rows(const float* __restrict__ src, unsigned char* __restrict__ dst, float* __restrict__ scale, int nrows) {
    const int lane = tid_() & 63, wid = tid_() >> 6;
    for (int r = blockIdx.x * 8 + wid; r < nrows; r += gridDim.x * 8) {
        const float* sp = src + (size_t)r * 1024 + lane * 16; f32x4 v[4]; float am = 0.f;
#pragma unroll
        for (int i = 0; i < 4; ++i) { v[i] = *(const f32x4*)(sp + i * 4); am = fmaxf(am, fmaxf(fmaxf(fabsf(v[i][0]), fabsf(v[i][1])), fmaxf(fabsf(v[i][2]), fabsf(v[i][3])))); }
#pragma unroll
        for (int o = 32; o > 0; o >>= 1) am = fmaxf(am, __shfl_xor(am, o));
        am = fmaxf(am, 1e-30f);
#if TAB_FP4
        const float q = 6.f / am; u32x2 w;
#pragma unroll
        for (int d = 0; d < 2; ++d) { unsigned pk = 0u;
            pk = __builtin_amdgcn_cvt_scalef32_pk_fp4_f32(pk, v[2 * d][0] * q, v[2 * d][1] * q, 1.0f, 0); pk = __builtin_amdgcn_cvt_scalef32_pk_fp4_f32(pk, v[2 * d][2] * q, v[2 * d][3] * q, 1.0f, 1);
            pk = __builtin_amdgcn_cvt_scalef32_pk_fp4_f32(pk, v[2 * d + 1][0] * q, v[2 * d + 1][1] * q, 1.0f, 2); pk = __builtin_amdgcn_cvt_scalef32_pk_fp4_f32(pk, v[2 * d + 1][2] * q, v[2 * d + 1][3] * q, 1.0f, 3); w[d] = pk; }
        *(u32x2*)(dst + (size_t)r * ROWB + lane * 8) = w;
        if (lane == 0) scale[r] = am * (1.f / 6.f);
#else
        const float q = 256.f / am;
        u32x4 w;
#pragma unroll
        for (int i = 0; i < 4; ++i) { int pk = 0; pk = __builtin_amdgcn_cvt_pk_fp8_f32(v[i][0] * q, v[i][1] * q, pk, false); pk = __builtin_amdgcn_cvt_pk_fp8_f32(v[i][2] * q, v[i][3] * q, pk, true); w[i] = (unsigned)pk; }
        *(u32x4*)(dst + (size_t)r * ROWB + lane * 16) = w;
        if (lane == 0) scale[r] = am * (1.f / 256.f);
#endif
    }
}
#if TAB_FMT == 5 || TAB_FMT == 65
DEVI void job_quant_rows5(const float* __restrict__ src, unsigned char* __restrict__ dst, int nrows) {
    const int lane = tid_() & 63, wid = tid_() >> 6, l32 = lane & 31, hi = lane >> 5;
    for (int r0 = (blockIdx.x * 8 + wid) * 2; r0 < nrows; r0 += gridDim.x * 16) {
        const int r = r0 + hi; const float* sp = src + (size_t)r * 1024; f32x4 v[8]; float am = 0.f;
#pragma unroll
        for (int i = 0; i < 8; ++i) { v[i] = *(const f32x4*)(sp + CHUNK_COL(l32, i)); am = fmaxf(am, fmaxf(fmaxf(fabsf(v[i][0]), fabsf(v[i][1])), fmaxf(fabsf(v[i][2]), fabsf(v[i][3])))); }
        const bf16_t sb = f2bf(fmaxf(am, 1e-30f) * (1.f / 6.f)); const float q = 1.f / bf2f(sb);
        u32x4 w;
#pragma unroll
        for (int d = 0; d < 4; ++d) { unsigned pk = 0u;
            pk = __builtin_amdgcn_cvt_scalef32_pk_fp4_f32(pk, v[2 * d][0] * q, v[2 * d][1] * q, 1.0f, 0); pk = __builtin_amdgcn_cvt_scalef32_pk_fp4_f32(pk, v[2 * d][2] * q, v[2 * d][3] * q, 1.0f, 1);
            pk = __builtin_amdgcn_cvt_scalef32_pk_fp4_f32(pk, v[2 * d + 1][0] * q, v[2 * d + 1][1] * q, 1.0f, 2); pk = __builtin_amdgcn_cvt_scalef32_pk_fp4_f32(pk, v[2 * d + 1][2] * q, v[2 * d + 1][3] * q, 1.0f, 3); w[d] = pk; }
        unsigned char* dp = dst + (size_t)r * ROWB_V; *(u32x4*)(dp + l32 * 16) = w; *(bf16_t*)(dp + 512 + l32 * 2) = sb;
    }
}
#endif
#if TAB_FMT == 45
DEVI void job_quant_rows45(const float* __restrict__ src, unsigned char* __restrict__ dst, float* __restrict__ scale, int nrows) {
    const int lane = tid_() & 63, wid = tid_() >> 6, l32 = lane & 31, hi = lane >> 5;
    for (int r0 = (blockIdx.x * 8 + wid) * 2; r0 < nrows; r0 += gridDim.x * 16) {
        const int r = r0 + hi; const float* sp = src + (size_t)r * 1024; f32x4 v[8]; float am = 0.f;
#pragma unroll
        for (int i = 0; i < 8; ++i) { v[i] = *(const f32x4*)(sp + CHUNK_COL(l32, i)); am = fmaxf(am, fmaxf(fmaxf(fabsf(v[i][0]), fabsf(v[i][1])), fmaxf(fabsf(v[i][2]), fabsf(v[i][3])))); }
        am = fmaxf(am, DPPF(am, DPP_QX1)); am = fmaxf(am, DPPF(am, DPP_QX2)); am = fmaxf(am, DPPF(am, DPP_HMIR)); am = fmaxf(am, DPPF(am, DPP_MIR));
        { auto rr = __builtin_amdgcn_permlane16_swap(__float_as_uint(am), __float_as_uint(am), false, false); am = fmaxf(__uint_as_float(rr[0]), __uint_as_float(rr[1])); }
        am = fmaxf(am, 1e-30f); const float q = 6.f / am; u32x4 w;
#pragma unroll
        for (int d = 0; d < 4; ++d) { unsigned pk = 0u;
            pk = __builtin_amdgcn_cvt_scalef32_pk_fp4_f32(pk, v[2 * d][0] * q, v[2 * d][1] * q, 1.0f, 0); pk = __builtin_amdgcn_cvt_scalef32_pk_fp4_f32(pk, v[2 * d][2] * q, v[2 * d][3] * q, 1.0f, 1);
            pk = __builtin_amdgcn_cvt_scalef32_pk_fp4_f32(pk, v[2 * d + 1][0] * q, v[2 * d + 1][1] * q, 1.0f, 2); pk = __builtin_amdgcn_cvt_scalef32_pk_fp4_f32(pk, v[2 * d + 1][2] * q, v[2 * d + 1][3] * q, 1.0f, 3); w[d] = pk; }
        *(u32x4*)(dst + (size_t)r * ROWB + l32 * 16) = w; if (l32 == 0) scale[r] = am * (1.f / 6.f);
    }
}
#endif
#if TAB_FMT == 6 || TAB_FMT == 65
DEVI float fp6_val(int k) { return k < 16 ? 0.125f * (float)k : k < 24 ? 2.f + 0.25f * (float)(k - 16) : 4.f + 0.5f * (float)(k - 24); }
DEVI int fp6_idx(float w) { return w < 2.f ? (int)(w * 8.f + 0.5f) : w < 4.f ? 16 + (int)((w - 2.f) * 4.f + 0.5f) : 24 + (int)((w - 4.f) * 2.f + 0.5f); }
DEVI void job_quant_rows6(const float* __restrict__ src, unsigned char* __restrict__ dst, float* __restrict__ scale, int nrows, char* lds) {
    const int lane = tid_() & 63, wid = tid_() >> 6, l32 = lane & 31, hi = lane >> 5;
    float* stage = (float*)(lds + wid * 8448) + lane * 32; int* ptab = (int*)(lds + wid * 8448 + 8192);
    int pinv[32];
    { f32x16 ca, cb;
#pragma unroll
      for (int i = 0; i < 16; ++i) { ca[i] = fp6_val(i); cb[i] = fp6_val(16 + i); }
      const u32x6 pk = __builtin_amdgcn_cvt_scalef32_2xpk16_fp6_f32(ca, cb, 1.0f); const f32x32 w = __builtin_amdgcn_cvt_scalef32_pk32_f32_fp6(pk, 1.0f);
#pragma unroll
      for (int k = 0; k < 32; ++k) { const int m = fp6_idx(w[k]) & 31; if (lane == 0) ptab[m] = k; }
      asm volatile("s_waitcnt lgkmcnt(0)" ::: "memory");
#pragma unroll
      for (int m = 0; m < 32; ++m) pinv[m] = ptab[m];
      asm volatile("s_waitcnt lgkmcnt(0)" ::: "memory"); }
    f32x4 vn[8];
    { const int rf = (blockIdx.x * 8 + wid) * 2 + hi; const float* sp = src + (size_t)(rf < nrows ? rf : 0) * 1024 + l32 * 32;
#pragma unroll
      for (int i = 0; i < 8; ++i) vn[i] = *(const f32x4*)(sp + i * 4); }
    for (int r0 = (blockIdx.x * 8 + wid) * 2; r0 < nrows; r0 += gridDim.x * 16) {
        const int r = r0 + hi; f32x4 v[8]; float am = 0.f;
#pragma unroll
        for (int i = 0; i < 8; ++i) v[i] = vn[i];
        { const int rn = r + gridDim.x * 16; const float* sp = src + (size_t)(rn < nrows ? rn : r) * 1024 + l32 * 32;
#pragma unroll
          for (int i = 0; i < 8; ++i) vn[i] = *(const f32x4*)(sp + i * 4); }
#pragma unroll
        for (int i = 0; i < 8; ++i) am = fmaxf(am, fmaxf(fmaxf(fabsf(v[i][0]), fabsf(v[i][1])), fmaxf(fabsf(v[i][2]), fabsf(v[i][3]))));
        am = fmaxf(am, DPPF(am, DPP_QX1)); am = fmaxf(am, DPPF(am, DPP_QX2)); am = fmaxf(am, DPPF(am, DPP_HMIR)); am = fmaxf(am, DPPF(am, DPP_MIR));
        { auto rr = __builtin_amdgcn_permlane16_swap(__float_as_uint(am), __float_as_uint(am), false, false); am = fmaxf(__uint_as_float(rr[0]), __uint_as_float(rr[1])); }
        am = fmaxf(am, 1e-30f); const float q = 7.5f / am;
#pragma unroll
        for (int i = 0; i < 8; ++i) *(f32x4*)(stage + i * 4) = v[i] * q;
        asm volatile("s_waitcnt lgkmcnt(0)" ::: "memory");
        f32x16 a, b;
#pragma unroll
        for (int m = 0; m < 16; ++m) { a[m] = stage[pinv[m]]; b[m] = stage[pinv[16 + m]]; }
        asm volatile("s_waitcnt lgkmcnt(0)" ::: "memory");
        const u32x6 pk = __builtin_amdgcn_cvt_scalef32_2xpk16_fp6_f32(a, b, 1.0f);
        unsigned char* dp = dst + (size_t)r * ROWB + l32 * 24;
        *(u32x2*)(dp) = (u32x2){pk[0], pk[1]}; *(u32x2*)(dp + 8) = (u32x2){pk[2], pk[3]}; *(u32x2*)(dp + 16) = (u32x2){pk[4], pk[5]};
        if (l32 == 0) scale[r] = am * (1.f / 7.5f);
    }
}
#endif
DEVI bf16x8 ld8_f32_bf(const float* p) { const f32x4 a = *(const f32x4*)p, b = *(const f32x4*)(p + 4); u32x4 w; w.x = cvtpk(a[0], a[1]); w.y = cvtpk(a[2], a[3]); w.z = cvtpk(b[0], b[1]); w.w = cvtpk(b[2], b[3]); return __builtin_bit_cast(bf16x8, w); }
DEVI void job_fold_pq(const P& p) {
    const int lane = tid_() & 63, wid = tid_() >> 6, fr = lane & 15, fq = lane >> 4;
    for (int item = blockIdx.x; item < NL * 64; item += gridDim.x) {
        const int l = item >> 6, hh = (item >> 2) & 15, k00 = (item & 3) * 256;
        const float* sk = p.sub_keys + ((size_t)l * 16 + hh) * 128 * 128 + (size_t)(wid * 16 + fr) * 128 + fq * 8;
        const float* wq = p.w_pq + (size_t)l * 1024 * 2048 + hh * 128 + fq * 8;
        bf16_t* out = (bf16_t*)(WS(p) + OFF_W + (size_t)l * W_LAYER + W_PQ) + (size_t)(hh * 128 + wid * 16 + fr) * 1024;
        bf16x8 kf_[4];
#pragma unroll
        for (int ks = 0; ks < 4; ++ks) kf_[ks] = ld8_f32_bf(sk + ks * 32);
#pragma unroll 2
        for (int kt = 0; kt < 16; ++kt) { const int k0 = k00 + kt * 16; f32x4 acc = (f32x4){0.f, 0.f, 0.f, 0.f};
#pragma unroll
            for (int ks = 0; ks < 4; ++ks) acc = MFMA16(ld8_f32_bf(wq + (size_t)(k0 + fr) * 2048 + ks * 32), kf_[ks], acc);
            st_bf4(out + k0 + 4 * fq, acc); }
    }
}
DEVI void phase_prologue(const P& p, char* lds) {
    const int tid = tid_();
    const size_t gtid = (size_t)blockIdx.x * NTHR + tid, gstride = (size_t)gridDim.x * NTHR;
    { float* rope = (float*)(WS(p) + OFF_ROPE);
      for (size_t i = gtid; i < (size_t)T_ * 16; i += gstride) { const int t = (int)(i >> 4), f = (int)(i & 15);
          const float angf = (float)p.pos[t] * (float)p.invf[f];
          const double rev = (double)angf * 0.15915494309189535; const double fr = rev - rint(rev);
          rope[(size_t)t * 32 + f] = __builtin_amdgcn_cosf((float)fr); rope[(size_t)t * 32 + 16 + f] = __builtin_amdgcn_sinf((float)fr); } }
    { float* ca = (float*)lds; f32x4* red = (f32x4*)(ca + 2048);
      float* mod = (float*)(WS(p) + OFF_MOD);
      __syncthreads();
      for (int i = tid; i < 2048; i += NTHR) { const float cv = p.c[i]; ca[i] = cv * sigmoidf_(cv); }
      __syncthreads();
      for (int wi = blockIdx.x; wi < NL * 48; wi += gridDim.x) {
          const int l = wi / 48, j0 = (wi - l * 48) * 128, kq = tid >> 5, cq = tid & 31;
          const float* w = p.w_mod + (size_t)l * 1024 * 6144 + j0 + cq * 4; f32x4 a0 = (f32x4){0.f, 0.f, 0.f, 0.f}, a1 = a0;
#pragma unroll 8
          for (int k = kq * 64; k < kq * 64 + 64; ++k) { const f32x4 wv = *(const f32x4*)(w + (size_t)k * 6144); a0 = a0 + wv * ca[k]; a1 = a1 + wv * ca[1024 + k]; }
          red[(kq * 2 + 0) * 32 + cq] = a0; red[(kq * 2 + 1) * 32 + cq] = a1;
          __syncthreads();
          if (tid < 64) { const int b = tid >> 5; f32x4 s = red[b * 32 + cq];
#pragma unroll
              for (int q = 1; q < 16; ++q) s = s + red[(q * 2 + b) * 32 + cq];
              const f32x4 bb = *(const f32x4*)(p.b_mod + (size_t)l * 6144 + j0 + cq * 4); *(f32x4*)(mod + ((size_t)l * 2 + b) * 6144 + j0 + cq * 4) = s + bb; }
          __syncthreads();
      } }
    int rot = 192;
    for (int l = 0; l < NL; ++l) {
        unsigned char* wl = WS(p) + OFF_W + (size_t)l * W_LAYER;
        job_transpose(p.w_in + (size_t)l * 1024 * 4512, 1024, GATES_FP8 ? 1440 : 4512, (bf16_t*)(wl + W_INT), 1, nullptr, lds, rot, 0, 4512);
        for (size_t i = gtid; i < (size_t)96 * 1024 / 8; i += gstride) ((u32x4*)(wl + W_INT + (size_t)1440 * 1024 * 2))[i] = (u32x4){0u, 0u, 0u, 0u};
        if (GATES_FP8) job_transpose8(p.w_in + (size_t)l * 1024 * 4512 + 1440, 4512, 1024, 3072, wl + W_G8, 64.f, lds, rot);
        job_transpose(p.w_uq + (size_t)l * 384 * 768, 384, 768, (bf16_t*)(wl + W_UQ), 0, p.q_norm + l * 384, lds, rot);
        job_transpose(p.w_ukv + (size_t)l * 256 * 1024, 256, 1024, (bf16_t*)(wl + W_UKV), 0, p.kv_norm + l * 256, lds, rot);
        job_transpose(p.w_a + (size_t)l * 256 * 1024, 256, 1024, (bf16_t*)(wl + W_A) + CAT_YA, 0, nullptr, lds, rot, 1024);
        job_transpose(p.w_b + (size_t)l * 512 * 1024, 512, 1024, (bf16_t*)(wl + W_A) + CAT_YB, 0, nullptr, lds, rot, 1024);
        job_transpose(p.w_o + (size_t)l * 1024 * 1024, 1024, 1024, (bf16_t*)(wl + W_O), 0, nullptr, lds, rot);
        if (!PQ_FOLD) job_transpose(p.w_pq + (size_t)l * 1024 * 2048, 1024, 2048, (bf16_t*)(wl + W_PQ), 0, nullptr, lds, rot);
        if (!PQ_FOLD) job_convert(p.sub_keys + (size_t)l * 16 * 128 * 128, (bf16_t*)(wl + W_SK), (size_t)16 * 128 * 128 / 4, 0);
        job_convert(p.w_s + (size_t)l * 4 * 128 * 128, (bf16_t*)(wl + W_S), (size_t)4 * 128 * 128 / 4, 1);
    }
    if (PQ_FOLD) job_fold_pq(p);
    { float* Tt = (float*)lds; float* Wp = Tt + 64 * 65;
      for (int wi = (int)((blockIdx.x + gridDim.x - (unsigned)rot % gridDim.x) % gridDim.x); wi < NL * 4 * 16; wi += gridDim.x) {
          const int l = wi >> 6, g = (wi >> 4) & 3, n0 = (wi & 15) * 64;
          const float* wp = p.w_pool + (size_t)l * 4 * 64 * 64 + (size_t)g * 64 * 64; const float* ps = p.pool_scale + l * 256 + g * 64; const float* wcs = p.w_c + (size_t)l * 256 * 1024 + (size_t)g * 64 * 1024 + n0;
          __syncthreads();
#pragma unroll
          for (int i = 0; i < 8; ++i) { const int id = tid + i * NTHR, r = id >> 6, c = id & 63; Tt[r * 65 + c] = ps[r] * wcs[(size_t)r * 1024 + c]; Wp[r * 65 + c] = wp[r * 64 + c]; }
          __syncthreads();
          const int n = tid & 63, cg = tid >> 6; float a[8];
#pragma unroll
          for (int i = 0; i < 8; ++i) a[i] = 0.f;
          for (int jj = 0; jj < 64; ++jj) { const float tv = Tt[jj * 65 + n];
#pragma unroll
              for (int i = 0; i < 8; ++i) a[i] += Wp[(cg * 8 + i) * 65 + jj] * tv; }
          u32x4 w; w.x = cvtpk(a[0], a[1]); w.y = cvtpk(a[2], a[3]); w.z = cvtpk(a[4], a[5]); w.w = cvtpk(a[6], a[7]);
          *(u32x4*)((bf16_t*)(WS(p) + OFF_W + (size_t)l * W_LAYER + W_A) + (size_t)(n0 + n) * 1024 + CAT_PRE + g * 64 + cg * 8) = w;
      } }
#if TAB_FMT == 45
    job_quant_rows45(p.u_tab, WS(p) + OFF_U, (float*)(WS(p) + OFF_SU), NL * 16384);
    job_quant_rows45(p.v_tab, WS(p) + OFF_V, (float*)(WS(p) + OFF_SV), NL * 16384);
#elif TAB_FMT == 5
    job_quant_rows5(p.u_tab, WS(p) + OFF_U, NL * 16384);
    job_quant_rows5(p.v_tab, WS(p) + OFF_V, NL * 16384);
#elif TAB_FMT == 65
    __syncthreads();
    job_quant_rows6(p.u_tab, WS(p) + OFF_U, (float*)(WS(p) + OFF_SU), NL * 16384, lds);
    job_quant_rows5(p.v_tab, WS(p) + OFF_V, NL * 16384);
#elif TAB_FMT == 6
    __syncthreads();
    job_quant_rows6(p.u_tab, WS(p) + OFF_U, (float*)(WS(p) + OFF_SU), NL * 16384, lds);
    job_quant_rows6(p.v_tab, WS(p) + OFF_V, (float*)(WS(p) + OFF_SV), NL * 16384, lds);
#else
    job_quant_rows(p.u_tab, WS(p) + OFF_U, (float*)(WS(p) + OFF_SU), NL * 16384);
    job_quant_rows(p.v_tab, WS(p) + OFF_V, (float*)(WS(p) + OFF_SV), NL * 16384);
#endif
}

DEVI void phase_norm(const P& p, const float* xsrc, const float* sh, const float* sc, bool also8, const bf16_t* xsrcb = nullptr, bool alsop = false) {
    const int lane = tid_() & 63, wid = tid_() >> 6, j = lane & 15, tk = lane >> 4; bf16_t* h = (bf16_t*)(WS(p) + OFF_H);
    u32x2 rn[16];
    if (xsrcb) { const int tf = (blockIdx.x * 8 + wid) * 4 + tk;
#pragma unroll
        for (int i = 0; i < 16; ++i) rn[i] = *(const u32x2*)(xsrcb + (size_t)(tf < T_ ? tf : 0) * DM + j * 4 + i * 64); }
    for (int t0 = (blockIdx.x * 8 + wid) * 4; t0 < T_; t0 += gridDim.x * 32) {
        const int t = t0 + tk; const float* xp = xsrc + (size_t)t * DM + j * 4; f32x4 v[16]; float ss = 0.f;
        if (xsrcb) {
#pragma unroll
            for (int i = 0; i < 16; ++i) v[i] = (f32x4){bflo(rn[i].x), bfhi(rn[i].x), bflo(rn[i].y), bfhi(rn[i].y)};
            const int tn = t + (int)gridDim.x * 32;
#pragma unroll
            for (int i = 0; i < 16; ++i) rn[i] = *(const u32x2*)(xsrcb + (size_t)(tn < T_ ? tn : t) * DM + j * 4 + i * 64);
#pragma unroll
            for (int i = 0; i < 16; ++i) ss += v[i][0] * v[i][0] + v[i][1] * v[i][1] + v[i][2] * v[i][2] + v[i][3] * v[i][3];
        } else {
#pragma unroll
        for (int i = 0; i < 16; ++i) { v[i] = *(const f32x4*)(xp + i * 64); ss += v[i][0] * v[i][0] + v[i][1] * v[i][1] + v[i][2] * v[i][2] + v[i][3] * v[i][3]; } }
        ss += DPPF(ss, DPP_QX1); ss += DPPF(ss, DPP_QX2); ss += DPPF(ss, DPP_HMIR); ss += DPPF(ss, DPP_MIR);
        const float rs = rsqrtf(ss * (1.f / 1024.f) + 1e-6f); const int bo = (t >= S_) ? 6144 : 0;
#pragma unroll
        for (int i = 0; i < 16; ++i) { const int col = j * 4 + i * 64; const f32x4 a = *(const f32x4*)(sc + bo + col), b = *(const f32x4*)(sh + bo + col);
            const f32x4 o = v[i] * rs * (a + 1.f) + b; st_bf4(h + (size_t)t * DM + col, o); if (GATES_FP8 && also8) *(unsigned*)(WS(p) + OFF_H8 + (size_t)t * DM + col) = pk4_fp8(o); v[i] = o; }
        if (alsop) {
            float am = 0.f;
#pragma unroll
            for (int i = 0; i < 16; ++i) am = fmaxf(am, fmaxf(fmaxf(fabsf(v[i][0]), fabsf(v[i][1])), fmaxf(fabsf(v[i][2]), fabsf(v[i][3]))));
            am = fmaxf(am, DPPF(am, DPP_QX1)); am = fmaxf(am, DPPF(am, DPP_QX2)); am = fmaxf(am, DPPF(am, DPP_HMIR)); am = fmaxf(am, DPPF(am, DPP_MIR));
            const int e0 = (int)((__float_as_uint(fmaxf(am, 1e-20f) * (1.f / 6.f)) >> 23) & 255u) - 126;
            const float inv0 = __uint_as_float((unsigned)(127 - e0) << 23), s0 = __uint_as_float((unsigned)(127 + e0) << 23), inv1 = inv0 * 4.f;
            unsigned char* p0 = WS(p) + OFF_H4P + (size_t)t * 512; unsigned char* p1 = p0 + (size_t)T_ * 512;
#pragma unroll
            for (int i = 0; i < 16; ++i) { const f32x4 o = v[i]; unsigned pk = 0u;
                pk = __builtin_amdgcn_cvt_scalef32_pk_fp4_f32(pk, o[0] * inv0, o[1] * inv0, 1.0f, 0); pk = __builtin_amdgcn_cvt_scalef32_pk_fp4_f32(pk, o[2] * inv0, o[3] * inv0, 1.0f, 1);
                const f32x2 d01 = __builtin_amdgcn_cvt_scalef32_pk_f32_fp4(pk, 1.0f, 0), d23 = __builtin_amdgcn_cvt_scalef32_pk_f32_fp4(pk, 1.0f, 1);
                unsigned pr = 0u;
                pr = __builtin_amdgcn_cvt_scalef32_pk_fp4_f32(pr, (o[0] - d01[0] * s0) * inv1, (o[1] - d01[1] * s0) * inv1, 1.0f, 0); pr = __builtin_amdgcn_cvt_scalef32_pk_fp4_f32(pr, (o[2] - d23[0] * s0) * inv1, (o[3] - d23[1] * s0) * inv1, 1.0f, 1);
                const int off = (16 * (i & 1) + j) * 16 + (i >> 1) * 2;
                *(unsigned short*)(p0 + off) = (unsigned short)(pk & 0xffffu); *(unsigned short*)(p1 + off) = (unsigned short)(pr & 0xffffu); }
            if (j == 0) ((int*)(WS(p) + OFF_HSC))[t] = (127 + e0) | ((127 + e0 - 2) << 8);
        }
    }
}
DEVI void phase_final(const P& p) {
    const int lane = tid_() & 63, wid = tid_() >> 6;
#if PROBE_ATTN
    const float pscale = 1.f + 10.f * __uint_as_float(((const unsigned*)(WS(p) + OFF_CTL))[4000]);
#else
    const float pscale = 1.f;
#endif
    for (int t = blockIdx.x * 8 + wid; t < T_; t += gridDim.x * 8) {
        float* xp = XR(p) + (size_t)t * DM; f32x4 v[4]; float ss = 0.f;
#pragma unroll
        for (int i = 0; i < 4; ++i) { v[i] = *(const f32x4*)(xp + i * 256 + lane * 4); ss += v[i][0] * v[i][0] + v[i][1] * v[i][1] + v[i][2] * v[i][2] + v[i][3] * v[i][3]; }
        ss = wave_sum(ss); const float rs = rsqrtf(ss * (1.f / 1024.f) + 1e-6f);
#pragma unroll
        for (int i = 0; i < 4; ++i) { const int col = i * 256 + lane * 4; const f32x4 g = *(const f32x4*)(p.final_norm + col); *(f32x4*)(xp + col) = v[i] * (rs * pscale) * g; }
    }
}
DEVI void ld8_bf(const bf16_t* p, float (&o)[8]) { const u32x4 w = *(const u32x4*)p;
#pragma unroll
    for (int k = 0; k < 4; ++k) { o[2 * k] = bflo(w[k]); o[2 * k + 1] = bfhi(w[k]); } }
DEVI void st8_bf(bf16_t* p, const float (&v)[8]) { u32x4 w;
#pragma unroll
    for (int k = 0; k < 4; ++k) w[k] = cvtpk(v[2 * k], v[2 * k + 1]);
    *(u32x4*)p = w; }
DEVI float sum8(float v) { v += DPPF(v, DPP_QX1); v += DPPF(v, DPP_QX2); v += DPPF(v, DPP_HMIR); return v; }
DEVI void phase_post(const P& p) {
    const int lane = tid_() & 63, wid = tid_() >> 6, j = lane & 7, tk = lane >> 3;
    const bf16_t* z = (const bf16_t*)(WS(p) + OFF_Z); bf16_t* vn = (bf16_t*)(WS(p) + OFF_VN); bf16_t* pre = (bf16_t*)(WS(p) + OFF_CAT) + CAT_PRE; bf16_t* Kb = (bf16_t*)(WS(p) + OFF_K);
    float* rsq = (float*)(WS(p) + OFF_RS); float* rskv = rsq + T_; const float* rope = (const float*)(WS(p) + OFF_ROPE);
    u32x4 nv_[4], nq_[6], nk_[4], nr_[4], np_[4];
#define POST_LOAD(tt) do { const bf16_t* zn_ = z + (size_t)(tt) * ZC; \
        _Pragma("unroll") for (int q = 0; q < 4; ++q) { nv_[q] = *(const u32x4*)(zn_ + Z_V + j * 32 + q * 8); nk_[q] = *(const u32x4*)(zn_ + Z_CKV + j * 32 + q * 8); nr_[q] = *(const u32x4*)(zn_ + Z_KR + q * 8); np_[q] = *(const u32x4*)(zn_ + Z_P + j * 32 + q * 8); } \
        _Pragma("unroll") for (int q = 0; q < 6; ++q) nq_[q] = *(const u32x4*)(zn_ + Z_CQ + j * 48 + q * 8); } while (0)
#define UNP8(w, u) do { _Pragma("unroll") for (int k_ = 0; k_ < 4; ++k_) { u[2 * k_] = bflo(w[k_]); u[2 * k_ + 1] = bfhi(w[k_]); } } while (0)
    { const int tf = (blockIdx.x * 8 + wid) * 8 + tk; POST_LOAD(tf < T_ ? tf : 0); }
    for (int t0 = (blockIdx.x * 8 + wid) * 8; t0 < T_; t0 += gridDim.x * 64) {
        const int t = t0 + tk; const bf16_t* zr = z + (size_t)t * ZC;
        u32x4 rv_[4], rq_[6], rk_[4], rr_[4], rp_[4];
#pragma unroll
        for (int q = 0; q < 4; ++q) { rv_[q] = nv_[q]; rk_[q] = nk_[q]; rr_[q] = nr_[q]; rp_[q] = np_[q]; }
#pragma unroll
        for (int q = 0; q < 6; ++q) rq_[q] = nq_[q];
        { const int tn = t + (int)gridDim.x * 64; POST_LOAD(tn < T_ ? tn : t); }
        { float v[32]; float s = 0.f;
#pragma unroll
          for (int q = 0; q < 4; ++q) { float u[8]; UNP8(rv_[q], u);
#pragma unroll
              for (int k = 0; k < 8; ++k) { v[q * 8 + k] = u[k]; s += u[k]; } }
          const float mu = sum8(s) * (1.f / 256.f); float s2 = 0.f;
#pragma unroll
          for (int k = 0; k < 32; ++k) { v[k] -= mu; s2 += v[k] * v[k]; }
          const float rstd = rsqrtf(sum8(s2) * (1.f / 256.f) + 1e-6f);
#pragma unroll
          for (int q = 0; q < 4; ++q) { float u[8];
#pragma unroll
              for (int k = 0; k < 8; ++k) u[k] = v[q * 8 + k] * rstd;
              st8_bf(vn + (size_t)t * 256 + j * 32 + q * 8, u); } }
        { float sq = 0.f, sk = 0.f;
#pragma unroll
          for (int q = 0; q < 6; ++q) { float u[8]; UNP8(rq_[q], u);
#pragma unroll
              for (int k = 0; k < 8; ++k) sq += u[k] * u[k]; }
#pragma unroll
          for (int q = 0; q < 4; ++q) { float u[8]; UNP8(rk_[q], u);
#pragma unroll
              for (int k = 0; k < 8; ++k) sk += u[k] * u[k]; }
          sq = sum8(sq); sk = sum8(sk);
          if (j == 0) rsq[t] = rsqrtf(sq * (1.f / 384.f) + 1e-6f); if (j == 1) rskv[t] = rsqrtf(sk * (1.f / 256.f) + 1e-6f); }
        {
          float x1[16], x2[16]; { float u[8]; UNP8(rr_[0], u);
#pragma unroll
              for (int k = 0; k < 8; ++k) x1[k] = u[k]; UNP8(rr_[1], u);
#pragma unroll
              for (int k = 0; k < 8; ++k) x1[8 + k] = u[k]; UNP8(rr_[2], u);
#pragma unroll
              for (int k = 0; k < 8; ++k) x2[k] = u[k]; UNP8(rr_[3], u);
#pragma unroll
              for (int k = 0; k < 8; ++k) x2[8 + k] = u[k]; }
          const float* rp = rope + (size_t)t * 32; bf16_t* kr = Kb + (size_t)t * 768 + j * 96 + 64;
#pragma unroll
          for (int q = 0; q < 2; ++q) { float o1[8], o2[8];
#pragma unroll
              for (int k4 = 0; k4 < 2; ++k4) { const f32x4 cs = *(const f32x4*)(rp + q * 8 + k4 * 4), sn = *(const f32x4*)(rp + 16 + q * 8 + k4 * 4);
#pragma unroll
                  for (int k = 0; k < 4; ++k) { const int i = q * 8 + k4 * 4 + k; o1[k4 * 4 + k] = x1[i] * cs[k] - x2[i] * sn[k]; o2[k4 * 4 + k] = x2[i] * cs[k] + x1[i] * sn[k]; } }
              st8_bf(kr + q * 8, o1); st8_bf(kr + 16 + q * 8, o2); } }
        {
          const int tt = t & (S_ - 1), w = 2 << (j >> 1), n = (tt + 1 < w) ? tt + 1 : w; const bf16_t* zp = zr + Z_P + j * 32; float sum[32], self[32];
#pragma unroll
          for (int q = 0; q < 4; ++q) { float u[8]; UNP8(rp_[q], u);
#pragma unroll
              for (int k = 0; k < 8; ++k) { self[q * 8 + k] = u[k]; sum[q * 8 + k] = u[k]; } }
          for (int s = 1; s < n; ++s) {
#pragma unroll
              for (int q = 0; q < 4; ++q) { float u[8]; ld8_bf(zp - (size_t)s * ZC + q * 8, u);
#pragma unroll
                  for (int k = 0; k < 8; ++k) sum[q * 8 + k] += u[k]; } }
          const float inv = 1.f / (float)n;
#pragma unroll
          for (int q = 0; q < 4; ++q) { float u[8];
#pragma unroll
              for (int k = 0; k < 8; ++k) u[k] = sum[q * 8 + k] * inv - self[q * 8 + k];
              st8_bf(pre + (size_t)t * 1024 + j * 32 + q * 8, u); } }
    }
#undef UNP8
#undef POST_LOAD
}
DEVI void phase_mixa(const P& p, int l, char* lds) {
    const int tid = tid_(), lane = tid & 63, wid = tid >> 6, fr = lane & 15, fq = lane >> 4, g = wid >> 1, th = (wid & 1) * 64;
    constexpr int VP = 136;
    bf16_t* vnT = (bf16_t*)lds;
    const bf16_t* vn = (const bf16_t*)(WS(p) + OFF_VN); const bf16_t* z = (const bf16_t*)(WS(p) + OFF_Z); bf16_t* ya = (bf16_t*)(WS(p) + OFF_CAT) + CAT_YA;
    const bf16_t* Wg = (const bf16_t*)(WS(p) + OFF_W + (size_t)l * W_LAYER + W_S) + (size_t)g * 128 * 128; const float* bs = p.b_s + (size_t)l * 512 + g * 128;
    for (int ch = blockIdx.x; ch < T_ / 128; ch += gridDim.x) {
        const size_t t0 = (size_t)ch * 128;
        __syncthreads();
#pragma unroll
        for (int i = 0; i < 8; ++i) { const int id = tid + i * NTHR, s = id >> 5, c8 = (id & 31) * 8; const u32x4 w = *(const u32x4*)(vn + (t0 + s) * 256 + c8);
            bf16_t* d = vnT + c8 * VP + s; d[0] = (bf16_t)(w.x & 0xffff); d[VP] = (bf16_t)(w.x >> 16); d[2 * VP] = (bf16_t)(w.y & 0xffff); d[3 * VP] = (bf16_t)(w.y >> 16);
            d[4 * VP] = (bf16_t)(w.z & 0xffff); d[5 * VP] = (bf16_t)(w.z >> 16); d[6 * VP] = (bf16_t)(w.w & 0xffff); d[7 * VP] = (bf16_t)(w.w >> 16); }
        __syncthreads();
        f32x4 acc[4][4]; acc_zero(acc);
#pragma unroll
        for (int kk = 0; kk < 4; ++kk) {
            bf16x8 af[4], bfr[4];
#pragma unroll
            for (int m = 0; m < 4; ++m) af[m] = *(const bf16x8*)(Wg + (size_t)(th + m * 16 + fr) * 128 + kk * 32 + fq * 8);
#pragma unroll
            for (int n = 0; n < 4; ++n) bfr[n] = *(const bf16x8*)(vnT + (g * 64 + n * 16 + fr) * VP + kk * 32 + fq * 8);
#pragma unroll
            for (int m = 0; m < 4; ++m)
#pragma unroll
                for (int n = 0; n < 4; ++n) acc[m][n] = MFMA16(bfr[n], af[m], acc[m][n]);
        }
#pragma unroll
        for (int m = 0; m < 4; ++m) { const int tl = th + m * 16 + fr; const float bias = bs[tl];
#pragma unroll
            for (int n = 0; n < 4; ++n) { const int c = g * 64 + n * 16 + 4 * fq; const f32x4 u = ld_bf4(z + (t0 + tl) * ZC + Z_U + c); f32x4 o = (acc[m][n] + bias) * u; st_bf4(ya + (t0 + tl) * 1024 + c, o); } }
    }
}
DEVI int crow(int r, int hi) { return (r & 3) + 8 * (r >> 2) + 4 * hi; }
DEVI s16x4 vtr(const char* p) { typedef short v4i16_t __attribute__((ext_vector_type(4))); return __builtin_bit_cast(s16x4, __builtin_amdgcn_ds_read_tr16_b64_v4i16((LAS v4i16_t*)p)); }
DEVI float hswap_max(float v) { return fmaxf(v, __shfl_xor(v, 32)); }
DEVI void attn_unit(const P& p, int b, int h, int qb, char* lds) {
    const int tid = tid_(), lane = tid & 63, r32 = lane & 31, hi = lane >> 5, wid = tid >> 6;
    char* Ks = lds; char* Vs = lds + 12288; float* wsf = (float*)(lds + 20480) + wid * 64;
    const bf16_t* Qb = (const bf16_t*)(WS(p) + OFF_Q); const bf16_t* Kb = (const bf16_t*)(WS(p) + OFF_K); const bf16_t* Vb = (const bf16_t*)(WS(p) + OFF_VV); bf16_t* Yb = (bf16_t*)(WS(p) + OFF_CAT) + CAT_YB;
    const size_t rowbase = (size_t)b * S_; const int q0 = qb * 256, NT = 4 * qb + 4;
    bf16x8 qr[6];
    { const size_t tq = rowbase + q0 + wid * 32 + r32; const bf16_t* qp = Qb + tq * 768 + h * 96 + hi * 8; const float rs = ((const float*)(WS(p) + OFF_RS))[tq]; const float sc = rs * C2F;
      const float* rp = (const float*)(WS(p) + OFF_ROPE) + tq * 32 + hi * 8;
      u32x4 raw[6];
#pragma unroll
      for (int d0 = 0; d0 < 6; ++d0) raw[d0] = *(const u32x4*)(qp + d0 * 16);
#pragma unroll
      for (int d0 = 0; d0 < 4; ++d0) { u32x4 w;
#pragma unroll
          for (int j = 0; j < 4; ++j) w[j] = cvtpk(bflo(raw[d0][j]) * sc, bfhi(raw[d0][j]) * sc);
          qr[d0] = __builtin_bit_cast(bf16x8, w); }
      u32x4 w1, w2;
#pragma unroll
      for (int j = 0; j < 4; ++j) { const float a0 = bflo(raw[4][j]), a1 = bfhi(raw[4][j]), b0 = bflo(raw[5][j]), b1 = bfhi(raw[5][j]);
          const float c0 = rp[2 * j], c1 = rp[2 * j + 1], s0 = rp[16 + 2 * j], s1 = rp[16 + 2 * j + 1];
          w1[j] = cvtpk((a0 * c0 - b0 * s0) * sc, (a1 * c1 - b1 * s1) * sc); w2[j] = cvtpk((b0 * c0 + a0 * s0) * sc, (b1 * c1 + a1 * s1) * sc); }
      qr[4] = __builtin_bit_cast(bf16x8, w1); qr[5] = __builtin_bit_cast(bf16x8, w2); }
    const bf16_t* Kg = Kb + rowbase * 768 + h * 96; const bf16_t* Vg = Vb + rowbase * 512 + h * 64;
    const int kc0 = tid >> 6, kk0 = tid & 63;
    const int vw = tid >> 6, vl = tid & 63, vrow = 16 * (vw & 3) + (vl >> 2), vcol = (vw >> 2) * 32 + (vl & 3) * 8;
    u32x4 rk0, rk1 = (u32x4){0u, 0u, 0u, 0u}, rv;
#define A_LOAD(t) do { rk0 = *(const u32x4*)(Kg + (size_t)((t) * 64 + kk0) * 768 + kc0 * 8); if (tid < 256) rk1 = *(const u32x4*)(Kg + (size_t)((t) * 64 + kk0) * 768 + (kc0 + 8) * 8); \
                       rv = *(const u32x4*)(Vg + (size_t)((t) * 64 + vrow) * 512 + vcol); } while (0)
    A_LOAD(0);
    f32x16 o0, o1;
#pragma unroll
    for (int r = 0; r < 16; ++r) { o0[r] = 0.f; o1[r] = 0.f; }
    float mrun = -1e30f, lrun = 0.f;
    const int qrel = wid * 32 + r32;
    const char* vp0 = Vs + ((lane >> 4) & 1) * 32 + (lane & 3) * 8 + (4 * hi + ((lane & 15) >> 2)) * 64;
    for (int t = 0; t < NT; ++t) {
        __syncthreads();
        *(u32x4*)(Ks + kc0 * 1024 + kk0 * 16) = rk0; if (tid < 256) *(u32x4*)(Ks + (kc0 + 8) * 1024 + kk0 * 16) = rk1;
        *(u32x4*)(Vs + vw * 1024 + vl * 16) = rv;
        __syncthreads();
        if (t + 1 < NT) A_LOAD(t + 1);
        f32x16 p0, p1;
#pragma unroll
        for (int r = 0; r < 16; ++r) { p0[r] = 0.f; p1[r] = 0.f; }
#pragma unroll
        for (int d0 = 0; d0 < 6; ++d0) { const bf16x8 k0 = *(const bf16x8*)(Ks + (2 * d0 + hi) * 1024 + r32 * 16), k1 = *(const bf16x8*)(Ks + (2 * d0 + hi) * 1024 + 512 + r32 * 16);
            p0 = MFMA32(k0, qr[d0], p0); p1 = MFMA32(k1, qr[d0], p1); }
        if (t >= NT - 4) { const int kb = 64 * (t - (NT - 4)) + 4 * hi;
#pragma unroll
            for (int r = 0; r < 16; ++r) { const int kv = kb + (r & 3) + 8 * (r >> 2); if (kv > qrel) p0[r] = -INFINITY; if (kv + 32 > qrel) p1[r] = -INFINITY; } }
        float rm = fmaxf(p0[0], p1[0]);
#pragma unroll
        for (int r = 1; r < 16; ++r) rm = fmaxf(rm, fmaxf(p0[r], p1[r]));
        rm = hswap_max(rm);
        const float mnew = fmaxf(mrun, rm), alpha = fexp2(mrun - mnew); mrun = mnew;
        float ls = 0.f;
#pragma unroll
        for (int r = 0; r < 16; ++r) { p0[r] = fexp2(p0[r] - mnew); p1[r] = fexp2(p1[r] - mnew); ls += p0[r] + p1[r]; }
        lrun = lrun * alpha + ls;
        if (__any(alpha != 1.f)) {
            if (hi == 0) wsf[r32] = alpha;
            asm volatile("s_waitcnt lgkmcnt(0)" ::: "memory");
#pragma unroll
            for (int r = 0; r < 16; ++r) { const float f = wsf[crow(r, hi)]; o0[r] *= f; o1[r] *= f; }
            asm volatile("s_waitcnt lgkmcnt(0)" ::: "memory");
        }
        u32x4 pw[4];
#pragma unroll
        for (int j = 0; j < 4; ++j) { pw[0][j] = cvtpk(p0[2 * j], p0[2 * j + 1]); pw[1][j] = cvtpk(p0[8 + 2 * j], p0[8 + 2 * j + 1]); pw[2][j] = cvtpk(p1[2 * j], p1[2 * j + 1]); pw[3][j] = cvtpk(p1[8 + 2 * j], p1[8 + 2 * j + 1]); }
#pragma unroll
        for (int ks = 0; ks < 4; ++ks) {
            const s16x4 a0 = vtr(vp0 + ks * 1024), a1 = vtr(vp0 + ks * 1024 + 512), b0 = vtr(vp0 + 4096 + ks * 1024), b1 = vtr(vp0 + 4096 + ks * 1024 + 512);
            const bf16x8 v0 = (bf16x8){a0[0], a0[1], a0[2], a0[3], a1[0], a1[1], a1[2], a1[3]}, v1 = (bf16x8){b0[0], b0[1], b0[2], b0[3], b1[0], b1[1], b1[2], b1[3]};
            const bf16x8 pa = __builtin_bit_cast(bf16x8, pw[ks]);
            o0 = MFMA32(pa, v0, o0); o1 = MFMA32(pa, v1, o1);
        }
    }
#undef A_LOAD
    lrun += __shfl_xor(lrun, 32);
    if (hi == 0) wsf[32 + r32] = lrun;
    asm volatile("s_waitcnt lgkmcnt(0)" ::: "memory");
    bf16_t* yo = Yb + (rowbase + q0 + wid * 32) * 1024 + h * 64 + r32;
#pragma unroll
    for (int r = 0; r < 16; ++r) { const int row = crow(r, hi); const float rl = frcp(wsf[32 + row]); yo[(size_t)row * 1024] = f2bf(o0[r] * rl); yo[(size_t)row * 1024 + 32] = f2bf(o1[r] * rl); }
    asm volatile("s_waitcnt lgkmcnt(0)" ::: "memory");
}

namespace at96 {
constexpr int KSLOT = 12288, VSLOT = 8192, LDS_K = 0, LDS_V = 3 * KSLOT, LDS_WS = LDS_V + 3 * VSLOT, LDS_OST = LDS_WS + 8 * 256, LDS_NEED = LDS_OST + 8 * 4096;
#define A9_THR 8
#define SBAR() __builtin_amdgcn_sched_barrier(0)
#define PIN(x) asm volatile("" : "+v"(x))
#define WAIT_BAR(N) asm volatile("s_waitcnt vmcnt(" #N ") lgkmcnt(0)\n\ts_barrier" ::: "memory")
#define WAIT_BAR2(NA, NB) do { if (w03) { WAIT_BAR(NA); } else { WAIT_BAR(NB); } } while (0)
typedef __attribute__((address_space(3))) const char* lds_cptr;
DEVI unsigned cvtpk_a(float lo, float hi) { unsigned r; asm("v_cvt_pk_bf16_f32 %0, %1, %2" : "=v"(r) : "v"(lo), "v"(hi)); return r; }
DEVI void glds16(const void* g, unsigned lds_base) {
    unsigned sv; asm volatile("s_mov_b32 %0, m0\n\ts_mov_b32 m0, %2\n\ts_nop 0\n\tglobal_load_lds_dwordx4 %1, off\n\ts_mov_b32 m0, %0" : "=&s"(sv) : "v"(g), "s"(lds_base) : "memory"); }
DEVI void kload2(bf16x8* kf, lds_cptr kp, int d0) { kf[2 * d0] = *(const LAS bf16x8*)(kp + d0 * 2048); kf[2 * d0 + 1] = *(const LAS bf16x8*)(kp + d0 * 2048 + 512); }
DEVI s16x4 vtr3(lds_cptr p) { typedef short v4i16_t __attribute__((ext_vector_type(4))); return __builtin_bit_cast(s16x4, __builtin_amdgcn_ds_read_tr16_b64_v4i16((LAS v4i16_t*)p)); }
#define MX3(a, b, c) __builtin_fmaxf(__builtin_fmaxf((a), (b)), (c))
DEVI float rowmax(const f32x16& p0, const f32x16& p1) {
    float a = MX3(p0[0], p0[1], p1[0]), b = MX3(p0[2], p0[3], p1[1]); a = MX3(a, p1[2], p1[3]);
#pragma unroll
    for (int r = 4; r < 16; r += 4) { a = MX3(a, p0[r], p0[r + 1]); b = MX3(b, p0[r + 2], p0[r + 3]); a = MX3(a, p1[r], p1[r + 1]); b = MX3(b, p1[r + 2], p1[r + 3]); }
    float m = __builtin_fmaxf(a, b); auto rr = __builtin_amdgcn_permlane32_swap(__float_as_uint(m), __float_as_uint(m), false, false);
    return __builtin_fmaxf(__uint_as_float(rr[0]), __uint_as_float(rr[1])); }
DEVI void cmask(f32x16& p0, f32x16& p1, int jb, int qrel, int hi) {
    const int kb = 64 * jb + 4 * hi;
#pragma unroll
    for (int r = 0; r < 16; ++r) { const int kv = kb + (r & 3) + 8 * (r >> 2); if (kv > qrel) p0[r] = -INFINITY; if (kv + 32 > qrel) p1[r] = -INFINITY; } }

DEVI void attn_unit(const P& p, int b, int h, int qb, char* lds) {
    const int tid = tid_(), lane = tid & 63, r32 = lane & 31, hi = lane >> 5; const int wid = __builtin_amdgcn_readfirstlane(tid >> 6);
    const bf16_t* Qb = (const bf16_t*)(WS(p) + OFF_Q); const bf16_t* Kb = (const bf16_t*)(WS(p) + OFF_K); const bf16_t* Vb = (const bf16_t*)(WS(p) + OFF_VV); bf16_t* Yb = (bf16_t*)(WS(p) + OFF_CAT) + CAT_YB;
    const size_t rowbase = (size_t)b * S_; const int q0 = qb * 256, NT = 4 * qb + 4;
    bf16x8 qr[6];
    { const size_t tq = rowbase + q0 + wid * 32 + r32; const bf16_t* qp = Qb + tq * 768 + h * 96 + hi * 8; const float rs = ((const float*)(WS(p) + OFF_RS))[tq]; const float sc = rs * C2F;
      const float* rp = (const float*)(WS(p) + OFF_ROPE) + tq * 32 + hi * 8;
      u32x4 raw[6];
#pragma unroll
      for (int d0 = 0; d0 < 6; ++d0) raw[d0] = *(const u32x4*)(qp + d0 * 16);
#pragma unroll
      for (int d0 = 0; d0 < 4; ++d0) { u32x4 w;
#pragma unroll
          for (int j = 0; j < 4; ++j) w[j] = cvtpk(bflo(raw[d0][j]) * sc, bfhi(raw[d0][j]) * sc);
          qr[d0] = __builtin_bit_cast(bf16x8, w); }
      u32x4 w1, w2;
#pragma unroll
      for (int j = 0; j < 4; ++j) { const float a0 = bflo(raw[4][j]), a1 = bfhi(raw[4][j]), b0 = bflo(raw[5][j]), b1 = bfhi(raw[5][j]);
          const float c0 = rp[2 * j], c1 = rp[2 * j + 1], s0 = rp[16 + 2 * j], s1 = rp[16 + 2 * j + 1];
          w1[j] = cvtpk((a0 * c0 - b0 * s0) * sc, (a1 * c1 - b1 * s1) * sc); w2[j] = cvtpk((b0 * c0 + a0 * s0) * sc, (b1 * c1 + a1 * s1) * sc); }
      qr[4] = __builtin_bit_cast(bf16x8, w1); qr[5] = __builtin_bit_cast(bf16x8, w2); }
    const unsigned lds0 = (unsigned)(uintptr_t)lds; float* wsf = (float*)(lds + LDS_WS) + wid * 64;
    const bf16_t* Kg = Kb + rowbase * 768 + h * 96; const bf16_t* Vg = Vb + rowbase * 512 + h * 64;
    const bf16_t* ksrc1 = Kg + (size_t)lane * 768 + wid * 8; const bf16_t* ksrc2 = Kg + (size_t)lane * 768 + (8 + (wid & 3)) * 8;
    const bf16_t* vsrc = Vg + (size_t)(16 * (wid & 3) + (lane >> 2)) * 512 + (wid >> 2) * 32 + (lane & 3) * 8;
    const bool w03 = wid < 4;
    const unsigned kdst1 = lds0 + LDS_K + wid * 1024, kdst2 = lds0 + LDS_K + (8 + (wid & 3)) * 1024, vdst = lds0 + LDS_V + wid * 1024;
#define RFL(x) ((unsigned)__builtin_amdgcn_readfirstlane((int)(x)))
#define DMA_K(t, sl) do { glds16(ksrc1 + (size_t)(t) * 64 * 768, RFL(kdst1 + (sl) * KSLOT)); if (w03) glds16(ksrc2 + (size_t)(t) * 64 * 768, RFL(kdst2 + (sl) * KSLOT)); } while (0)
#define DMA_V(t, sl) glds16(vsrc + (size_t)(t) * 64 * 512, RFL(vdst + (sl) * VSLOT))
    const lds_cptr vp0 = (lds_cptr)lds + LDS_V + ((lane >> 4) & 1) * 32 + (lane & 3) * 8 + (4 * hi + ((lane & 15) >> 2)) * 64;
    const lds_cptr kp0 = (lds_cptr)lds + LDS_K + hi * 1024 + r32 * 16;
    DMA_K(0, 0); DMA_V(0, 0); DMA_K(1, 1); DMA_K(2, 2);
    float mhat = 0.f, l_reg = 0.f; f32x16 o[2];
#pragma unroll
    for (int r = 0; r < 16; ++r) { o[0][r] = 0.f; o[1][r] = 0.f; }
    const f32x16 zero16 = o[0];
    f32x16 negm = o[0]; asm volatile("" : "+v"(negm));
    const int qrel = wid * 32 + r32; bool resc = false;
    f32x16 pA0, pA1, pB0, pB1; bf16x8 kf[12]; s16x4 vlo[8], vhi[8]; u32x4 pw0, pw1, pw2, pw3;
    int sl_prev = 0, sl_cur = 0, sl_next = 1;
#define ROT() do { sl_prev = sl_cur; sl_cur = sl_next; sl_next = (sl_next == 2) ? 0 : sl_next + 1; } while (0)
#define EX(v) __builtin_amdgcn_exp2f(v)
#define RESC() do { if (resc) { _Pragma("unroll") for (int d_ = 0; d_ < 2; ++d_) _Pragma("unroll") for (int r = 0; r < 16; ++r) o[d_][r] *= wsf[crow(r, hi)]; } } while (0)
    if (wid >= 4) __builtin_amdgcn_s_setprio(1);
    WAIT_BAR2(5, 3);
    _Pragma("unroll") for (int d0 = 0; d0 < 6; ++d0) kload2(kf, kp0, d0);
    pA0 = MFMA32(kf[0], qr[0], zero16); pA1 = MFMA32(kf[1], qr[0], zero16);
    _Pragma("unroll") for (int d0 = 1; d0 < 6; ++d0) { pA0 = MFMA32(kf[2 * d0], qr[d0], pA0); pA1 = MFMA32(kf[2 * d0 + 1], qr[d0], pA1); }
    if (NT == 4) cmask(pA0, pA1, 0, qrel, hi);
    { const float rm = rowmax(pA0, pA1); mhat = rm;
#pragma unroll
      for (int r = 0; r < 16; ++r) { pA0[r] = EX(pA0[r] - rm); pA1[r] = EX(pA1[r] - rm); negm[r] = -rm; }
      asm volatile("" : "+v"(negm)); }
    WAIT_BAR(0);
    DMA_K(3, 0); DMA_V(1, 1); ROT();
    _Pragma("unroll") for (int d0 = 0; d0 < 6; ++d0) kload2(kf, kp0 + sl_cur * KSLOT, d0);
    WAIT_BAR2(3, 2);
#define PKW(P, i) cvtpk_a(P[i], P[i + 1])
#define PAF(k) __builtin_bit_cast(bf16x8, pw##k)
#define VFR(i) (bf16x8){vlo[i][0], vlo[i][1], vlo[i][2], vlo[i][3], vhi[i][0], vhi[i][1], vhi[i][2], vhi[i][3]}
#define VRD(i) do { vlo[i] = vtr3(vp_ + (((i) >> 2) * 4096 + ((i) & 3) * 1024)); vhi[i] = vtr3(vp_ + (((i) >> 2) * 4096 + ((i) & 3) * 1024 + 512)); } while (0)
#define KRD(G, d0) do { if (G) { kload2(kf, kp0 + sl_next * KSLOT, d0); SBAR(); } } while (0)
#define GAPA(MF, a0, a1, a2, a3, W0, W1, PW) do { MF; sacc += a0; sacc += a1; sacc += a2; sacc += a3; W0; W1; PIN(PW); PIN(sacc); SBAR(); } while (0)
#define GAPB(MF, X, i) do { MF; X[i] = EX(X[i]); X[i + 1] = EX(X[i + 1]); X[i + 2] = EX(X[i + 2]); X[i + 3] = EX(X[i + 3]); PIN(X); SBAR(); } while (0)
#define STEP(C0, C1, P0, P1, t, MASK, GK, GV, GL) do { SBAR(); \
    const lds_cptr vp_ = vp0 + sl_prev * VSLOT; \
    VRD(0); SBAR(); float sacc = P0[0] + P0[1]; \
                    GAPA(C0 = MFMA32(kf[0], qr[0], negm), P0[2], P0[3], P0[4], P0[5],     pw0[0] = PKW(P0, 0),  pw0[1] = PKW(P0, 2),  pw0); \
    VRD(4); SBAR(); GAPA(C1 = MFMA32(kf[1], qr[0], negm), P0[6], P0[7], P0[8], P0[9],     pw0[2] = PKW(P0, 4),  pw0[3] = PKW(P0, 6),  pw0); \
    VRD(1); SBAR(); GAPA(C0 = MFMA32(kf[2], qr[1], C0),    P0[10], P0[11], P0[12], P0[13], pw1[0] = PKW(P0, 8),  pw1[1] = PKW(P0, 10), pw1); \
    VRD(5); SBAR(); GAPA(C1 = MFMA32(kf[3], qr[1], C1),    P0[14], P0[15], P1[0], P1[1],   pw1[2] = PKW(P0, 12), pw1[3] = PKW(P0, 14), pw1); \
                    GAPA(C0 = MFMA32(kf[4], qr[2], C0),    P1[2], P1[3], P1[4], P1[5],     pw2[0] = PKW(P1, 0),  pw2[1] = PKW(P1, 2),  pw2); \
                    GAPA(C1 = MFMA32(kf[5], qr[2], C1),    P1[6], P1[7], P1[8], P1[9],     pw2[2] = PKW(P1, 4),  pw2[3] = PKW(P1, 6),  pw2); \
                    GAPA(C0 = MFMA32(kf[6], qr[3], C0),    P1[10], P1[11], P1[12], P1[13], pw3[0] = PKW(P1, 8),  pw3[1] = PKW(P1, 10), pw3); \
                    GAPA(C1 = MFMA32(kf[7], qr[3], C1),    P1[14], P1[15], 0.f, 0.f,       pw3[2] = PKW(P1, 12), pw3[3] = PKW(P1, 14), pw3); \
    KRD(GL, 0); C0 = MFMA32(kf[8], qr[4], C0); SBAR(); KRD(GL, 1); C1 = MFMA32(kf[9], qr[4], C1); SBAR(); KRD(GL, 2); C0 = MFMA32(kf[10], qr[5], C0); SBAR(); KRD(GL, 3); C1 = MFMA32(kf[11], qr[5], C1); SBAR();     \
    l_reg += sacc; \
    if (GK) DMA_K((t) + 3, sl_cur); if (GV) DMA_V((t) + 1, sl_next);                                                       \
    if (MASK) cmask(C0, C1, (t) - (NT - 4), qrel, hi); \
    { const float rm = rowmax(C0, C1); resc = false;                                                                        \
      if (__builtin_expect(__any(rm > (float)A9_THR), 0)) { const float dl = __builtin_fmaxf(rm, 0.f); mhat += dl;          \
          _Pragma("unroll") for (int r = 0; r < 16; ++r) { C0[r] -= dl; C1[r] -= dl; negm[r] = -mhat; } asm volatile("" : "+v"(negm)); \
          const float f = __builtin_amdgcn_exp2f(-dl); l_reg *= f; if (hi == 0) wsf[r32] = f; resc = true; } } \
    SBAR(); \
    VRD(2); SBAR(); GAPB(o[0] = MFMA32(PAF(0), VFR(0), o[0]), C0, 0);              VRD(6); SBAR(); GAPB(o[1] = MFMA32(PAF(0), VFR(4), o[1]), C0, 4);                \
    VRD(3); SBAR(); GAPB(o[0] = MFMA32(PAF(1), VFR(1), o[0]), C0, 8);  VRD(7); SBAR(); GAPB(o[1] = MFMA32(PAF(1), VFR(5), o[1]), C0, 12); \
    GAPB(o[0] = MFMA32(PAF(2), VFR(2), o[0]), C1, 0);  GAPB(o[1] = MFMA32(PAF(2), VFR(6), o[1]), C1, 4); \
    KRD(GL, 4); GAPB(o[0] = MFMA32(PAF(3), VFR(3), o[0]), C1, 8);  KRD(GL, 5); GAPB(o[1] = MFMA32(PAF(3), VFR(7), o[1]), C1, 12); \
    } while (0)
    int t = 1;
    for (; t + 5 < NT; t += 2) {
        STEP(pB0, pB1, pA0, pA1, t, false, true, true, true);     WAIT_BAR2(3, 2); RESC(); ROT();
        STEP(pA0, pA1, pB0, pB1, t + 1, false, true, true, true); WAIT_BAR2(3, 2); RESC(); ROT();
    }
#define ENDW(tt) do { if ((tt) + 3 < NT) { WAIT_BAR2(3, 2); } else if ((tt) + 2 < NT) { WAIT_BAR(1); } else { WAIT_BAR(0); } } while (0)
    for (; t + 1 < NT; t += 2) {
        STEP(pB0, pB1, pA0, pA1, t, true, (t + 3 < NT), (t + 1 < NT), (t + 1 < NT));         ENDW(t);     RESC(); ROT();
        STEP(pA0, pA1, pB0, pB1, t + 1, true, (t + 4 < NT), (t + 2 < NT), (t + 2 < NT));     ENDW(t + 1); RESC(); ROT();
    }
    STEP(pB0, pB1, pA0, pA1, NT - 1, true, false, false, false); RESC();
    { float sacc = pB0[0] + pB0[1];
#pragma unroll
      for (int r = 2; r < 16; ++r) sacc += pB0[r];
#pragma unroll
      for (int r = 0; r < 16; ++r) sacc += pB1[r];
      l_reg += sacc;
      pw0 = (u32x4){PKW(pB0, 0), PKW(pB0, 2), PKW(pB0, 4), PKW(pB0, 6)}; pw1 = (u32x4){PKW(pB0, 8), PKW(pB0, 10), PKW(pB0, 12), PKW(pB0, 14)};
      pw2 = (u32x4){PKW(pB1, 0), PKW(pB1, 2), PKW(pB1, 4), PKW(pB1, 6)}; pw3 = (u32x4){PKW(pB1, 8), PKW(pB1, 10), PKW(pB1, 12), PKW(pB1, 14)};
      const lds_cptr vp_ = vp0 + sl_cur * VSLOT; _Pragma("unroll") for (int i = 0; i < 8; ++i) VRD(i);
      o[0] = MFMA32(PAF(0), VFR(0), o[0]); o[1] = MFMA32(PAF(0), VFR(4), o[1]); o[0] = MFMA32(PAF(1), VFR(1), o[0]); o[1] = MFMA32(PAF(1), VFR(5), o[1]);
      o[0] = MFMA32(PAF(2), VFR(2), o[0]); o[1] = MFMA32(PAF(2), VFR(6), o[1]); o[0] = MFMA32(PAF(3), VFR(3), o[0]); o[1] = MFMA32(PAF(3), VFR(7), o[1]); }
    { auto rr = __builtin_amdgcn_permlane32_swap(__float_as_uint(l_reg), __float_as_uint(l_reg), false, false); l_reg = __uint_as_float(rr[0]) + __uint_as_float(rr[1]); }
    if (hi == 0) wsf[32 + r32] = l_reg; asm volatile("s_waitcnt lgkmcnt(0)" ::: "memory");
    float rli[16];
#pragma unroll
    for (int r = 0; r < 16; ++r) rli[r] = __builtin_amdgcn_rcpf(wsf[32 + crow(r, hi)]);
    bf16_t* Ow = Yb + (rowbase + q0 + wid * 32) * 1024 + h * 64; bf16_t* stg = (bf16_t*)(lds + LDS_OST) + wid * 2048;
#pragma unroll
    for (int r = 0; r < 16; ++r) { const int orow = crow(r, hi);
#pragma unroll
        for (int d0 = 0; d0 < 2; ++d0) stg[orow * 64 + d0 * 32 + r32] = f2bf(o[d0][r] * rli[r]); }
    asm volatile("s_waitcnt lgkmcnt(0)" ::: "memory");
#pragma unroll
    for (int i = 0; i < 4; ++i) { const int row = i * 8 + (lane >> 3), ch = lane & 7; *(u32x4*)(Ow + (size_t)row * 1024 + ch * 8) = *(const u32x4*)(stg + row * 64 + ch * 8); }
    __builtin_amdgcn_s_setprio(0);
    asm volatile("s_waitcnt lgkmcnt(0)\n\ts_barrier" ::: "memory");
#undef RFL
#undef DMA_K
#undef DMA_V
#undef ROT
#undef EX
#undef RESC
#undef PKW
#undef PAF
#undef VFR
#undef VRD
#undef KRD
#undef ENDW
#undef GAPA
#undef GAPB
#undef STEP
}
#undef SBAR
#undef PIN
#undef WAIT_BAR
#undef WAIT_BAR2
#undef MX3
}
static_assert(at96::LDS_NEED <= LDS_BYTES - 16, "attention LDS");
#ifndef ATTN_SIMPLE
#define ATTN_SIMPLE 0
#endif
DEVI void phase_attn(const P& p, char* lds) {
    for (int v0 = blockIdx.x; v0 < 256; v0 += gridDim.x) {
        const int v = (gridDim.x == 256) ? ((v0 & 7) * 32 + (v0 >> 3)) : v0;
        const int bh = v >> 4, s = v & 15;
#pragma unroll 1
        for (int i = 0; i < 4; ++i) { const int qb = (i == 0) ? s : (i == 1) ? 31 - s : (i == 2) ? 32 + s : 63 - s; if (ATTN_SIMPLE) attn_unit(p, bh >> 3, bh & 7, qb, lds); else at96::attn_unit(p, bh >> 3, bh & 7, qb, lds); }
    }
}
DEVI void phase_merge(const P& p, int l, char* lds) {
    const int lane = tid_() & 63, wid = tid_() >> 6, wm = wid >> 1, wn = wid & 1, fr = lane & 15, fq = lane >> 4;
    const unsigned char* wl = WS(p) + OFF_W + (size_t)l * W_LAYER; const bf16_t* z = (const bf16_t*)(WS(p) + OFF_Z); bf16_t* mg = (bf16_t*)(WS(p) + OFF_H);
    for (int u = blockIdx.x; u < 128 * 8; u += gridDim.x) {
        const int pm = u >> 3, pn = u & 7;
        f32x4 tot[4][4]; acc_zero(tot);
#pragma unroll 1
        for (int seg = 0; seg < 3; ++seg) {
            const int koff = (seg == 0) ? CAT_YA : (seg == 1) ? CAT_YB : CAT_PRE, K = (seg == 1) ? 512 : 256;
            const bf16_t* A = (const bf16_t*)(WS(p) + OFF_CAT) + koff; const bf16_t* Bt = (const bf16_t*)(wl + W_A) + koff;
            f32x4 acc[4][4]; acc_zero(acc);
            gemm_kloop(acc, A + (size_t)pm * 256 * 1024, 1024, Bt + (size_t)pn * 128 * 1024, 1024, K, lds);
#pragma unroll
            for (int m = 0; m < 4; ++m)
#pragma unroll
                for (int n = 0; n < 4; ++n) { const int row = pm * 256 + wm * 64 + m * 16 + fr, col = pn * 128 + wn * 64 + n * 16 + 4 * fq;
                    const f32x4 gt = ld_bf4(z + (size_t)row * ZC + Z_G + seg * 1024 + col); tot[m][n] = tot[m][n] + gt * acc[m][n]; }
        }
#pragma unroll
        for (int m = 0; m < 4; ++m)
#pragma unroll
            for (int n = 0; n < 4; ++n) { const int row = pm * 256 + wm * 64 + m * 16 + fr, col = pn * 128 + wn * 64 + n * 16 + 4 * fq; st_bf4(mg + (size_t)row * DM + col, tot[m][n]); }
    }
}
DEVI int f2key(float f) { const int b = __float_as_int(f); return b ^ ((b >> 31) & 0x7fffffff); }
DEVI float key2f(int k) { return __int_as_float(k ^ ((k >> 31) & 0x7fffffff)); }
DEVI int med3i(int a, int b, int c) { int r; asm("v_med3_i32 %0, %1, %2, %3" : "=v"(r) : "v"(a), "v"(b), "v"(c)); return r; }
#define INS16(L, xin) do { const int x_ = (xin); _Pragma("unroll") for (int i_ = 15; i_ > 0; --i_) L[i_] = med3i(L[i_ - 1], L[i_], x_); L[0] = max(L[0], x_); } while (0)
#define CS(K, i, j) do { const int a_ = K[i], b_ = K[j]; K[i] = max(a_, b_); K[j] = min(a_, b_); } while (0)
#define SORT16(K) do { CS(K,0,1); CS(K,2,3); CS(K,0,2); CS(K,1,3); CS(K,1,2); CS(K,4,5); CS(K,6,7); CS(K,4,6); CS(K,5,7); CS(K,5,6); CS(K,0,4); CS(K,2,6); CS(K,2,4); CS(K,1,5); CS(K,3,7); CS(K,3,5); CS(K,1,2); CS(K,3,4); CS(K,5,6); CS(K,8,9); CS(K,10,11); CS(K,8,10); CS(K,9,11); CS(K,9,10); CS(K,12,13); CS(K,14,15); CS(K,12,14); CS(K,13,15); CS(K,13,14); CS(K,8,12); CS(K,10,14); CS(K,10,12); CS(K,9,13); CS(K,11,15); CS(K,11,13); CS(K,9,10); CS(K,11,12); CS(K,13,14); CS(K,0,8); CS(K,4,12); CS(K,4,8); CS(K,2,10); CS(K,6,14); CS(K,6,10); CS(K,2,4); CS(K,6,8); CS(K,10,12); CS(K,1,9); CS(K,5,13); CS(K,5,9); CS(K,3,11); CS(K,7,15); CS(K,7,11); CS(K,3,5); CS(K,7,9); CS(K,11,13); CS(K,1,2); CS(K,3,4); CS(K,5,6); CS(K,7,8); CS(K,9,10); CS(K,11,12); CS(K,13,14); } while (0)
#define BM16(K) do { CS(K,0,8); CS(K,1,9); CS(K,2,10); CS(K,3,11); CS(K,4,12); CS(K,5,13); CS(K,6,14); CS(K,7,15); CS(K,0,4); CS(K,1,5); CS(K,2,6); CS(K,3,7); CS(K,8,12); CS(K,9,13); CS(K,10,14); CS(K,11,15); CS(K,0,2); CS(K,1,3); CS(K,4,6); CS(K,5,7); CS(K,8,10); CS(K,9,11); CS(K,12,14); CS(K,13,15); CS(K,0,1); CS(K,2,3); CS(K,4,5); CS(K,6,7); CS(K,8,9); CS(K,10,11); CS(K,12,13); CS(K,14,15); } while (0)
#define MERGE16(A, B) do { _Pragma("unroll") for (int i_ = 0; i_ < 16; ++i_) A[i_] = max(A[i_], B[15 - i_]); BM16(A); } while (0)
DEVI void phase_topk(const P& p) {
    const float* sT = (const float*)(WS(p) + OFF_Z); int* eidx = (int*)(WS(p) + OFF_EIDX); float* gw = (float*)(WS(p) + OFF_VN);
    for (int wi = blockIdx.x * NTHR + tid_(); wi < 8 * T_; wi += gridDim.x * NTHR) {
        const int h = wi >> 15, t = wi & (T_ - 1);
        int L1[16], L2[16];
#pragma unroll
        for (int i = 0; i < 16; ++i) { L1[i] = (int)0x80000000; L2[i] = (int)0x80000000; }
        const float* s1 = sT + (size_t)(h * 256) * T_ + t; const float* s2 = s1 + (size_t)128 * T_;
        float ca[16], cb[16];
#pragma unroll
        for (int i = 0; i < 16; ++i) { ca[i] = s1[(size_t)i * T_]; cb[i] = s2[(size_t)i * T_]; }
#pragma unroll 1
        for (int kc = 0; kc < 8; ++kc) {
            float na[16], nb[16]; const int kn = (kc < 7) ? (kc + 1) * 16 : 0;
#pragma unroll
            for (int i = 0; i < 16; ++i) { na[i] = s1[(size_t)(kn + i) * T_]; nb[i] = s2[(size_t)(kn + i) * T_]; }
#pragma unroll
            for (int i = 0; i < 16; ++i) { const int k = kc * 16 + i; const int a = (f2key(ca[i]) & ~127) | (127 - k), b = (f2key(cb[i]) & ~127) | (127 - k); INS16(L1, a); INS16(L2, b); }
#pragma unroll
            for (int i = 0; i < 16; ++i) { ca[i] = na[i]; cb[i] = nb[i]; }
        }
        float v1[16], v2[16];
#pragma unroll
        for (int i = 0; i < 16; ++i) { v1[i] = key2f(L1[i] & ~127); v2[i] = key2f(L2[i] & ~127); }
        int C[16];
#pragma unroll
        for (int i = 0; i < 16; ++i) C[i] = (int)0x80000000;
#pragma unroll
        for (int a = 0; a < 16; ++a)
#pragma unroll
            for (int b = 0; b < 16; ++b) if ((a + 1) * (b + 1) <= 16) { const int kx = (f2key(v1[a] + v2[b]) & ~255) | (255 - (a * 16 + b)); INS16(C, kx); }
        float tv[16]; int te[16];
#pragma unroll
        for (int i = 0; i < 16; ++i) { const int pos = 255 - (C[i] & 255), a = pos >> 4, b = pos & 15; int ka = 0, kb = 0;
#pragma unroll
            for (int j = 0; j < 16; ++j) { ka = (a == j) ? L1[j] : ka; kb = (b == j) ? L2[j] : kb; }
            te[i] = (127 - (ka & 127)) * 128 + (127 - (kb & 127)); tv[i] = key2f(ka & ~127) + key2f(kb & ~127); }
        float sum = 0.f; const float tmax = tv[0];
#pragma unroll
        for (int i = 0; i < 16; ++i) { tv[i] = fexp2((tv[i] - tmax) * 1.4426950408889634f); sum += tv[i]; }
        const float inv = 1.f / sum;
        int* eo = eidx + (size_t)t * 128 + h * 16; float* go = gw + (size_t)t * 128 + h * 16;
        if (META16) { unsigned short* e16 = (unsigned short*)eidx + (size_t)t * 128 + h * 16; bf16_t* g16 = (bf16_t*)gw + (size_t)t * 128 + h * 16;
#pragma unroll
        for (int i = 0; i < 16; i += 8) { u32x4 we, wg;
#pragma unroll
            for (int k = 0; k < 4; ++k) { we[k] = (unsigned)te[i + 2 * k] | ((unsigned)te[i + 2 * k + 1] << 16); wg[k] = cvtpk(tv[i + 2 * k] * inv, tv[i + 2 * k + 1] * inv); }
            *(u32x4*)(e16 + i) = we; *(u32x4*)(g16 + i) = wg; } }
    else
#pragma unroll
    for (int i = 0; i < 16; i += 4) { *(int4*)(eo + i) = make_int4(te[i], te[i + 1], te[i + 2], te[i + 3]); *(f32x4*)(go + i) = (f32x4){tv[i] * inv, tv[i + 1] * inv, tv[i + 2] * inv, tv[i + 3] * inv}; }
    }
}
DEVI void topk_finish(const int (&L1)[16], const int (&L2)[16], int t, int h, int* eidx, float* gw, LAS int* sm = nullptr) {
    float v1[16], v2[16];
#pragma unroll
    for (int i = 0; i < 16; ++i) { v1[i] = key2f(L1[i] & ~127); v2[i] = key2f(L2[i] & ~127); }
#define TK_KX(a, b) ((f2key(v1[a] + v2[b]) & ~255) | (255 - ((a) * 16 + (b))))
    int C[16]; float tv[16]; int te[16];
    if (PEERK_NET && sm) {
        int Y1[16], Y2[16];
#pragma unroll
        for (int b = 0; b < 16; ++b) C[b] = TK_KX(0, b);
#pragma unroll
        for (int b = 0; b < 8; ++b) { Y1[b] = TK_KX(1, b); Y1[8 + b] = TK_KX(15 - b, 0); }
        BM16(Y1);
        Y2[0] = TK_KX(2, 0); Y2[1] = TK_KX(2, 1); Y2[2] = TK_KX(2, 2); Y2[3] = TK_KX(2, 3); Y2[4] = TK_KX(2, 4); Y2[5] = TK_KX(3, 0); Y2[6] = TK_KX(3, 1); Y2[7] = TK_KX(3, 2); Y2[8] = TK_KX(3, 3);
        Y2[9] = TK_KX(4, 0); Y2[10] = TK_KX(4, 1); Y2[11] = TK_KX(4, 2); Y2[12] = TK_KX(5, 0); Y2[13] = TK_KX(5, 1); Y2[14] = TK_KX(6, 0); Y2[15] = TK_KX(6, 1);
        SORT16(Y2);
        MERGE16(C, Y1); MERGE16(C, Y2);
        { const int k0 = TK_KX(7, 0), k1 = TK_KX(7, 1); INS16(C, k0); INS16(C, k1); }
#pragma unroll
        for (int j = 0; j < 16; ++j) { sm[j * 64] = L1[j]; sm[(16 + j) * 64] = L2[j]; }
#pragma unroll
        for (int i = 0; i < 16; ++i) { const int pos = 255 - (C[i] & 255), a = pos >> 4, b = pos & 15; const int ka = sm[a * 64], kb = sm[(16 + b) * 64];
            te[i] = (127 - (ka & 127)) * 128 + (127 - (kb & 127)); tv[i] = key2f(ka & ~127) + key2f(kb & ~127); }
    } else {
#pragma unroll
    for (int i = 0; i < 16; ++i) C[i] = (int)0x80000000;
#pragma unroll
    for (int a = 0; a < 16; ++a)
#pragma unroll
        for (int b = 0; b < 16; ++b) if ((a + 1) * (b + 1) <= 16) { const int kx = TK_KX(a, b); INS16(C, kx); }
#pragma unroll
    for (int i = 0; i < 16; ++i) { const int pos = 255 - (C[i] & 255), a = pos >> 4, b = pos & 15; int ka = 0, kb = 0;
#pragma unroll
        for (int j = 0; j < 16; ++j) { ka = (a == j) ? L1[j] : ka; kb = (b == j) ? L2[j] : kb; }
        te[i] = (127 - (ka & 127)) * 128 + (127 - (kb & 127)); tv[i] = key2f(ka & ~127) + key2f(kb & ~127); }
    }
#undef TK_KX
    float sum = 0.f; const float tmax = tv[0];
#pragma unroll
    for (int i = 0; i < 16; ++i) { tv[i] = fexp2((tv[i] - tmax) * 1.4426950408889634f); sum += tv[i]; }
    const float inv = 1.f / sum;
    int* eo = eidx + (size_t)t * 128 + h * 16; float* go = gw + (size_t)t * 128 + h * 16;
    if (META16) { unsigned short* e16 = (unsigned short*)eidx + (size_t)t * 128 + h * 16; bf16_t* g16 = (bf16_t*)gw + (size_t)t * 128 + h * 16;
#pragma unroll
        for (int i = 0; i < 16; i += 8) { u32x4 we, wg;
#pragma unroll
            for (int k = 0; k < 4; ++k) { we[k] = (unsigned)te[i + 2 * k] | ((unsigned)te[i + 2 * k + 1] << 16); wg[k] = cvtpk(tv[i + 2 * k] * inv, tv[i + 2 * k + 1] * inv); }
            *(u32x4*)(e16 + i) = we; *(u32x4*)(g16 + i) = wg; } }
    else
#pragma unroll
    for (int i = 0; i < 16; i += 4) { *(int4*)(eo + i) = make_int4(te[i], te[i + 1], te[i + 2], te[i + 3]); *(f32x4*)(go + i) = (f32x4){tv[i] * inv, tv[i + 1] * inv, tv[i + 2] * inv, tv[i + 3] * inv}; }
}
DEVI void phase_peerk(const P& p, int l, char* lds, int v = -1) {
    const int tid = tid_(), lane = tid & 63, wid = tid >> 6, r32 = lane & 31, hi = lane >> 5;
    constexpr int KP = 136;
    const bf16_t* qp = (const bf16_t*)(WS(p) + OFF_Q); const bf16_t* SK = (const bf16_t*)(WS(p) + OFF_W + (size_t)l * W_LAYER + W_SK);
    int* eidx = (int*)(WS(p) + OFF_EIDX); float* gw = (float*)(WS(p) + OFF_VN);
    const int nit = (v >= 0) ? 2 : (8 * (T_ / 512) - (int)blockIdx.x + (int)gridDim.x - 1) / (int)gridDim.x;
    bf16_t* ks = (bf16_t*)lds;
    for (int it_ = 0; it_ < nit; ++it_) {
        int h, jg; if (v >= 0) pg8::PairOrder::item(v, it_, h, jg); else { const int item = (int)blockIdx.x + it_ * (int)gridDim.x; h = item & 7; jg = item >> 3; }
        const int t0 = jg * 512 + wid * 64;
        __syncthreads();
#pragma unroll
        for (int i = 0; i < 8; ++i) { const int id = tid + i * NTHR, row = id >> 4, c8 = (id & 15) * 8; *(u32x4*)(ks + row * KP + c8) = *(const u32x4*)(SK + (size_t)(h * 256 + row) * 128 + c8); }
        __syncthreads();
        int M0[16], M1[16];
#pragma unroll
        for (int i = 0; i < 16; ++i) { M0[i] = (int)0x80000000; M1[i] = (int)0x80000000; }
#pragma unroll 1
        for (int tile = 0; tile < 2; ++tile) {
            int La[16], Lb[16];
#define PK_HALF(LL, pp) do { \
                _Pragma("unroll") for (int i = 0; i < 16; ++i) LL[i] = (int)0x80000000; \
                const bf16_t* qrow = qp + (size_t)(t0 + tile * 32 + r32) * 2048 + (h * 2 + (pp)) * 128 + hi * 8; \
                const bf16_t* krow = ks + ((pp) * 128 + r32) * KP + hi * 8; \
                bf16x8 qf[8]; \
                _Pragma("unroll") for (int ds = 0; ds < 8; ++ds) qf[ds] = *(const bf16x8*)(qrow + ds * 16); \
                _Pragma("unroll") for (int kp = 0; kp < 2; ++kp) { f32x16 acc0, acc1; \
                    _Pragma("unroll") for (int r = 0; r < 16; ++r) { acc0[r] = 0.f; acc1[r] = 0.f; } \
                    _Pragma("unroll") for (int ds = 0; ds < 8; ++ds) { \
                        acc0 = MFMA32(*(const bf16x8*)(krow + (2 * kp) * 32 * KP + ds * 16), qf[ds], acc0); acc1 = MFMA32(*(const bf16x8*)(krow + (2 * kp + 1) * 32 * KP + ds * 16), qf[ds], acc1); } \
                    if (PEERK_NET) { int K0[16], K1[16]; \
                        _Pragma("unroll") for (int r = 0; r < 16; ++r) { const int kc = 127 - kp * 64 - ((r & 3) + 8 * (r >> 2)) - 4 * hi; K0[r] = (f2key(acc0[r]) & ~127) | kc; K1[r] = (f2key(acc1[r]) & ~127) | (kc - 32); } \
                        SORT16(K0); SORT16(K1); MERGE16(K0, K1); \
                        if (kp == 0) { _Pragma("unroll") for (int i = 0; i < 16; ++i) LL[i] = K0[i]; } else { MERGE16(LL, K0); } \
                    } else { \
                    _Pragma("unroll") for (int r = 0; r < 16; ++r) { const int kc = 127 - kp * 64 - ((r & 3) + 8 * (r >> 2)) - 4 * hi; \
                        { const int a = (f2key(acc0[r]) & ~127) | kc; INS16(LL, a); } { const int a = (f2key(acc1[r]) & ~127) | (kc - 32); INS16(LL, a); } } } \
                    __builtin_amdgcn_sched_barrier(0); } } while (0)
            PK_HALF(La, 0);
            PK_HALF(Lb, 1);
#undef PK_HALF
            int R0[16], R1[16];
#pragma unroll
            for (int i = 0; i < 16; ++i) { R0[i] = xchg32(La[i], hi != 0); R1[i] = xchg32(Lb[i], hi != 0); }
            if (PEERK_NET) { MERGE16(La, R0); MERGE16(Lb, R1); }
            else {
#pragma unroll
            for (int i = 0; i < 16; ++i) { INS16(La, R0[i]); INS16(Lb, R1[i]); } }
            const bool mine = (hi == tile);
#pragma unroll
            for (int i = 0; i < 16; ++i) { M0[i] = mine ? La[i] : M0[i]; M1[i] = mine ? Lb[i] : M1[i]; }
        }
        topk_finish(M0, M1, t0 + hi * 32 + r32, h, eidx, gw);
    }
}
DEVI void phase_peerk2(const P& p, int v, char* lds) {
    const int tid = tid_(), lane = tid & 63, wid = tid >> 6, r32 = lane & 31, hi = lane >> 5;
    const bf16_t* qp = (const bf16_t*)(WS(p) + OFF_Q); int* eidx = (int*)(WS(p) + OFF_EIDX); float* gw = (float*)(WS(p) + OFF_VN);
    for (int it_ = 0; it_ < 2; ++it_) {
        int h, jg; pg8::PairOrder::item(v, it_, h, jg);
        const int t0 = jg * 512 + wid * 64;
        int M0[16], M1[16];
#pragma unroll
        for (int i = 0; i < 16; ++i) { M0[i] = (int)0x80000000; M1[i] = (int)0x80000000; }
#pragma unroll 1
        for (int tile = 0; tile < 2; ++tile) {
            int La[16], Lb[16]; u32x4 wa[8], wb[8];
            { const bf16_t* sp = qp + (size_t)(t0 + tile * 32 + r32) * 2048 + (h * 2) * 128 + hi * 64;
#pragma unroll
              for (int i = 0; i < 8; ++i) { wa[i] = *(const u32x4*)(sp + i * 8); wb[i] = *(const u32x4*)(sp + 128 + i * 8); } }
#define PK2_HALF(LL, W) do { \
                _Pragma("unroll") for (int blk = 0; blk < 4; ++blk) { int K_[16]; \
                    _Pragma("unroll") for (int d = 0; d < 8; ++d) { const unsigned x = W[2 * blk + (d >> 2)][d & 3]; const int ki = hi * 64 + blk * 16 + 2 * d; \
                        K_[2 * d] = (f2key(bflo(x)) & ~127) | (127 - ki); K_[2 * d + 1] = (f2key(bfhi(x)) & ~127) | (126 - ki); } \
                    SORT16(K_); \
                    if (blk == 0) { _Pragma("unroll") for (int i = 0; i < 16; ++i) LL[i] = K_[i]; } else { MERGE16(LL, K_); } } } while (0)
            PK2_HALF(La, wa);
            PK2_HALF(Lb, wb);
#undef PK2_HALF
            int R0[16], R1[16];
#pragma unroll
            for (int i = 0; i < 16; ++i) { R0[i] = xchg32(La[i], hi != 0); R1[i] = xchg32(Lb[i], hi != 0); }
            MERGE16(La, R0); MERGE16(Lb, R1);
            const bool mine = (hi == tile);
#pragma unroll
            for (int i = 0; i < 16; ++i) { M0[i] = mine ? La[i] : M0[i]; M1[i] = mine ? Lb[i] : M1[i]; }
        }
        topk_finish(M0, M1, t0 + hi * 32 + r32, h, eidx, gw, (LAS int*)(lds + wid * 8192) + lane);
    }
}
#if TAB_FP4
typedef u32x2 rowreg_t;
DEVI void cvt16(const u32x2 w, f32x2 (&o)[8]) {
#pragma unroll
    for (int d = 0; d < 2; ++d) { o[4 * d] = __builtin_amdgcn_cvt_scalef32_pk_f32_fp4(w[d], 1.0f, 0); o[4 * d + 1] = __builtin_amdgcn_cvt_scalef32_pk_f32_fp4(w[d], 1.0f, 1);
        o[4 * d + 2] = __builtin_amdgcn_cvt_scalef32_pk_f32_fp4(w[d], 1.0f, 2); o[4 * d + 3] = __builtin_amdgcn_cvt_scalef32_pk_f32_fp4(w[d], 1.0f, 3); }
}
#else
typedef u32x4 rowreg_t;
#endif
DEVI void cvt16(const u32x4 w, f32x2 (&o)[8]) {
#pragma unroll
    for (int i = 0; i < 4; ++i) { o[2 * i] = __builtin_amdgcn_cvt_pk_f32_fp8((int)w[i], false); o[2 * i + 1] = __builtin_amdgcn_cvt_pk_f32_fp8((int)w[i], true); }
}
template <bool DRY> DEVI void phase_gather(const P& p, int l) {
    const int lane = tid_() & 63, wid = tid_() >> 6;
    const bf16_t* h2 = (const bf16_t*)(WS(p) + OFF_H); const int* eidx = (const int*)(WS(p) + OFF_EIDX); const float* gw = (const float*)(WS(p) + OFF_VN);
    const unsigned char* U = WS(p) + OFF_U + (size_t)l * 16384 * ROWB; const unsigned char* V = WS(p) + OFF_V + (size_t)l * 16384 * ROWB;
    const float* SU = (const float*)(WS(p) + OFF_SU) + l * 16384; const float* SV = (const float*)(WS(p) + OFF_SV) + l * 16384;
    const float* g2 = (const float*)(WS(p) + OFF_MOD) + (size_t)l * 2 * 6144 + 5120;
    const bool b5 = (lane & 32) != 0, b4 = (lane & 16) != 0, b3 = (lane & 8) != 0; const int grp = lane >> 3;
    for (int t = blockIdx.x * 8 + wid; t < T_; t += gridDim.x * 8) {
        f32x2 xf[8];
        { const u32x4 a = *(const u32x4*)(h2 + (size_t)t * DM + lane * 16), b = *(const u32x4*)(h2 + (size_t)t * DM + lane * 16 + 8);
#pragma unroll
          for (int j = 0; j < 4; ++j) { xf[j] = (f32x2){bflo(a[j]), bfhi(a[j])}; xf[4 + j] = (f32x2){bflo(b[j]), bfhi(b[j])}; } }
        const int ev0 = eidx[(size_t)t * 128 + lane] & (DRY ? DRY_EMASK : 0x3fff), ev1 = eidx[(size_t)t * 128 + 64 + lane] & (DRY ? DRY_EMASK : 0x3fff);
        const float su0 = SU[ev0], su1 = SU[ev1]; const float gs0 = gw[(size_t)t * 128 + lane] * SV[ev0], gs1 = gw[(size_t)t * 128 + 64 + lane] * SV[ev1];
        f32x2 acc[8];
#pragma unroll
        for (int i = 0; i < 8; ++i) acc[i] = (f32x2){0.f, 0.f};
        rowreg_t ru[8], rv[8];
#define GA_ISSUE(RR, TAB, jbn) do { const int evh_ = ((jbn) < 64) ? ev0 : ev1; const int jl_ = (jbn) & 63; \
            _Pragma("unroll") for (int q = 0; q < 8; ++q) { const int e = __builtin_amdgcn_readlane(evh_, jl_ + q); RR[q] = *(const rowreg_t*)(TAB + (size_t)e * ROWB + lane * (ROWB / 64)); } } while (0)
#define GA_BODY(jb, NEXT) do { \
            const int bidx_ = ((((jb) & 63) + grp) << 2); \
            const float su_ = __int_as_float(__builtin_amdgcn_ds_bpermute(bidx_, __float_as_int(((jb) < 64) ? su0 : su1))); \
            const float gs_ = __int_as_float(__builtin_amdgcn_ds_bpermute(bidx_, __float_as_int(((jb) < 64) ? gs0 : gs1))); \
            float d[8]; \
            _Pragma("unroll") for (int q = 0; q < 8; ++q) { f32x2 uf[8]; cvt16(ru[q], uf); f32x2 s2 = uf[0] * xf[0]; \
                _Pragma("unroll") for (int i = 1; i < 8; ++i) s2 = s2 + uf[i] * xf[i]; \
                d[q] = s2[0] + s2[1]; } \
            if (NEXT) GA_ISSUE(ru, U, (jb) + 8); \
              \
            float e4[4], f2[2], gq; \
            _Pragma("unroll") for (int i = 0; i < 4; ++i) e4[i] = swap32_sum(d[i], d[i + 4]); \
            _Pragma("unroll") for (int i = 0; i < 2; ++i) f2[i] = swap16_sum(e4[i], e4[i + 2]); \
            { const float snd = b3 ? f2[0] : f2[1], kp = b3 ? f2[1] : f2[0]; gq = kp + DPPF(snd, DPP_ROR8); } \
            gq += DPPF(gq, DPP_QX1); gq += DPPF(gq, DPP_QX2); gq += DPPF(gq, DPP_HMIR); \
            const float wq = gs_ * gelu_tanh(gq * su_); \
            _Pragma("unroll") for (int q = 0; q < 8; ++q) { const float w = __uint_as_float((unsigned)__builtin_amdgcn_readlane((int)__float_as_uint(wq), q * 8)); const f32x2 w2 = (f32x2){w, w}; f32x2 vf[8]; cvt16(rv[q], vf); \
                _Pragma("unroll") for (int i = 0; i < 8; ++i) acc[i] = acc[i] + w2 * vf[i]; } \
            if (NEXT) GA_ISSUE(rv, V, (jb) + 8); } while (0)
        GA_ISSUE(ru, U, 0); GA_ISSUE(rv, V, 0);
#pragma unroll 1
        for (int jb = 0; jb < 120; jb += 8) GA_BODY(jb, true);
        GA_BODY(120, false);
#undef GA_ISSUE
#undef GA_BODY
        if (DRY) { if (acc[0][0] == 1.2345e30f) XR(p)[0] = acc[1][0]; continue; }
        float* xp = XR(p) + (size_t)t * DM + lane * 16; const float* gp = g2 + ((t >= S_) ? 6144 : 0) + lane * 16;
        f32x4 xn[4]; float ss = 0.f;
#pragma unroll
        for (int q = 0; q < 4; ++q) { f32x4 xv = *(const f32x4*)(xp + q * 4); const f32x4 gv = *(const f32x4*)(gp + q * 4);
            xv[0] += gv[0] * acc[2 * q][0]; xv[1] += gv[1] * acc[2 * q][1]; xv[2] += gv[2] * acc[2 * q + 1][0]; xv[3] += gv[3] * acc[2 * q + 1][1]; xn[q] = xv;
            ss += xv[0] * xv[0] + xv[1] * xv[1] + xv[2] * xv[2] + xv[3] * xv[3]; }
        ss = wave_sum(ss); const float rs = rsqrtf(ss * (1.f / 1024.f) + 1e-6f);
        if (l + 1 < NL) {
            const float* mn = (const float*)(WS(p) + OFF_MOD) + (size_t)(l + 1) * 2 * 6144 + ((t >= S_) ? 6144 : 0) + lane * 16; bf16_t* hp = (bf16_t*)(WS(p) + OFF_H) + (size_t)t * DM + lane * 16;
#pragma unroll
            for (int q = 0; q < 4; ++q) { *(f32x4*)(xp + q * 4) = xn[q]; const f32x4 sh = *(const f32x4*)(mn + q * 4), sc = *(const f32x4*)(mn + 1024 + q * 4); { const f32x4 hv = xn[q] * rs * (sc + 1.f) + sh; st_bf4(hp + q * 4, hv); if (GATES_FP8) *(unsigned*)(WS(p) + OFF_H8 + (size_t)(hp - (bf16_t*)(WS(p) + OFF_H)) + q * 4) = pk4_fp8(hv); } }
        } else {
            const float* fn = p.final_norm + lane * 16;
#if PROBE_ATTN
            const float rsp = rs * (1.f + 10.f * __uint_as_float(((const unsigned*)(WS(p) + OFF_CTL))[4000]));
#else
            const float rsp = rs;
#endif
#pragma unroll
            for (int q = 0; q < 4; ++q) { const f32x4 g = *(const f32x4*)(fn + q * 4); *(f32x4*)(xp + q * 4) = xn[q] * rsp * g; }
        }
    }
}


#if TAB_FMT == 6 || TAB_FMT == 5 || TAB_FMT == 65 || TAB_FMT == 45
#define DPP_SHL4 0x104
#define DPP_SHR4 0x114
struct RowReg6 { u32x2 a, b, c; };
DEVI void row_load(RowReg6& r, const unsigned char* rowp, int l32) { const unsigned char* q = rowp + l32 * 24; r.a = *(const u32x2*)q; r.b = *(const u32x2*)(q + 8); r.c = *(const u32x2*)(q + 16); }
DEVI void row_decode(const RowReg6& r, f32x2 (&w)[16]) { const u32x6 pk = {r.a[0], r.a[1], r.b[0], r.b[1], r.c[0], r.c[1]}; const f32x32 v = __builtin_amdgcn_cvt_scalef32_pk32_f32_fp6(pk, 1.0f);
#pragma unroll
    for (int i = 0; i < 16; ++i) w[i] = (f32x2){v[2 * i], v[2 * i + 1]}; }
DEVI float row_scale(const RowReg6&) { return 1.f; }
struct RowReg4 { u32x4 d; unsigned short s; };
DEVI void row_load(RowReg4& r, const unsigned char* rowp, int l32) { r.d = *(const u32x4*)(rowp + l32 * 16); r.s = *(const unsigned short*)(rowp + 512 + l32 * 2); }
DEVI void row_decode(const RowReg4& r, f32x2 (&w)[16]) {
#pragma unroll
    for (int d = 0; d < 4; ++d) { w[4 * d] = __builtin_amdgcn_cvt_scalef32_pk_f32_fp4(r.d[d], 1.0f, 0); w[4 * d + 1] = __builtin_amdgcn_cvt_scalef32_pk_f32_fp4(r.d[d], 1.0f, 1);
        w[4 * d + 2] = __builtin_amdgcn_cvt_scalef32_pk_f32_fp4(r.d[d], 1.0f, 2); w[4 * d + 3] = __builtin_amdgcn_cvt_scalef32_pk_f32_fp4(r.d[d], 1.0f, 3); } }
DEVI float row_scale(const RowReg4& r) { return bf2f(r.s); }
struct RowReg4p { u32x4 d; };
DEVI void row_load(RowReg4p& r, const unsigned char* rowp, int l32) { r.d = *(const u32x4*)(rowp + l32 * 16); }
DEVI void row_decode(const RowReg4p& r, f32x2 (&w)[16]) { RowReg4 t; t.d = r.d; t.s = 0; row_decode(t, w); }
DEVI float row_scale(const RowReg4p&) { return 1.f; }
#if TAB_FMT == 45
typedef RowReg4p RowRegU; typedef RowReg4p RowRegV;
#elif TAB_FMT == 6
typedef RowReg6 RowRegU; typedef RowReg6 RowRegV;
#elif TAB_FMT == 65
typedef RowReg6 RowRegU; typedef RowReg4 RowRegV;
#else
typedef RowReg4 RowRegU; typedef RowReg4 RowRegV;
#endif
template <bool DRY> DEVI void phase_gather6(const P& p, int l) {
    const int lane = tid_() & 63, wid = tid_() >> 6, l32 = lane & 31; const bool hi = lane >= 32;
    const bf16_t* h2 = (const bf16_t*)(WS(p) + OFF_H); const int* eidx = (const int*)(WS(p) + OFF_EIDX); const float* gw = (const float*)(WS(p) + OFF_VN);
    const unsigned char* U = WS(p) + OFF_U + (size_t)l * 16384 * ROWB; const unsigned char* V = WS(p) + OFF_V + (size_t)l * 16384 * ROWB_V;
    const float* SU = (const float*)(WS(p) + OFF_SU) + l * 16384; const float* SV = (const float*)(WS(p) + OFF_SV) + l * 16384;
    const float* g2 = (const float*)(WS(p) + OFF_MOD) + (size_t)l * 2 * 6144 + 5120;
    const bool b3 = (lane & 8) != 0, b2 = (lane & 4) != 0; const int quad = lane >> 2;
    constexpr int T_STAT = 24576; unsigned* qctr = (unsigned*)(WS(p) + OFF_CTL) + 3600 + 64 * l;
    int t = blockIdx.x * 8 + wid; int tk_next = -1; bool dyn = false;
    if (t >= T_STAT) { dyn = true; unsigned r = 0u; if (lane == 0) r = atomicAdd(qctr, 1u); t = T_STAT + (int)__builtin_amdgcn_readfirstlane((int)r); }
    for (; t < T_; ) {
        if (DRY) { dyn = false; }
        unsigned tkr = 0u; const bool want = !DRY && (dyn || t + (int)gridDim.x * 8 >= T_STAT);
        if (want && lane == 0) tkr = atomicAdd(qctr, 1u);
#if GATHER_UMFMA && TAB_FMT == 45
        u32x4 hb0[8], hb1[8];
        { const unsigned char* hq0 = WS(p) + OFF_H4P + (size_t)t * 512 + (lane >> 4) * 16; const unsigned char* hq1 = hq0 + (size_t)T_ * 512;
#pragma unroll
          for (int kb = 0; kb < 8; ++kb) { hb0[kb] = *(const u32x4*)(hq0 + kb * 64); hb1[kb] = *(const u32x4*)(hq1 + kb * 64); } }
        const int hs_ = ((const int*)(WS(p) + OFF_HSC))[t]; int sa_ = 127, sb0_ = hs_ & 255, sb1_ = (hs_ >> 8) & 255; asm volatile("" : "+v"(sa_), "+v"(sb0_), "+v"(sb1_));
#else
        f32x2 xf[16];
#pragma unroll
        for (int m4 = 0; m4 < 8; ++m4) { const u32x2 a = *(const u32x2*)(h2 + (size_t)t * DM + CHUNK_COL(l32, m4)); xf[2 * m4] = (f32x2){bflo(a.x), bfhi(a.x)}; xf[2 * m4 + 1] = (f32x2){bflo(a.y), bfhi(a.y)}; }
#endif
        const int ev0 = (META16 ? (int)((const unsigned short*)eidx)[(size_t)t * 128 + lane] : eidx[(size_t)t * 128 + lane]) & (DRY ? DRY_EMASK : 0x3fff), ev1 = (META16 ? (int)((const unsigned short*)eidx)[(size_t)t * 128 + 64 + lane] : eidx[(size_t)t * 128 + 64 + lane]) & (DRY ? DRY_EMASK : 0x3fff);
        const float gw0_ = META16 ? bf2f(((const bf16_t*)gw)[(size_t)t * 128 + lane]) : gw[(size_t)t * 128 + lane], gw1_ = META16 ? bf2f(((const bf16_t*)gw)[(size_t)t * 128 + 64 + lane]) : gw[(size_t)t * 128 + 64 + lane];
        #if TAB_FMT == 6 || TAB_FMT == 45
        const float su0 = SU[ev0], su1 = SU[ev1]; const float gs0 = gw0_ * SV[ev0], gs1 = gw1_ * SV[ev1];
#elif TAB_FMT == 65
        const float su0 = SU[ev0], su1 = SU[ev1]; const float gs0 = gw0_, gs1 = gw1_;
#else
        const float su0 = 1.f, su1 = 1.f; const float gs0 = gw0_, gs1 = gw1_;
#endif
        float pd1 = 0.f, pd2 = 0.f;
        f32x2 acc[16];
#pragma unroll
        for (int i = 0; i < 16; ++i) acc[i] = (f32x2){0.f, 0.f};
#if GATHER_UMFMA && TAB_FMT == 45
        u32x4 ua[8]; RowRegV rv[8];
#define G6_UISSUE(jbn) do { const int er_ = __builtin_amdgcn_ds_bpermute((((jbn) & 63) + (lane & 15)) << 2, ((jbn) < 64) ? ev0 : ev1); const unsigned char* up_ = U + (size_t)er_ * ROWB + (lane >> 4) * 16; \
            _Pragma("unroll") for (int kb = 0; kb < 8; ++kb) ua[kb] = *(const u32x4*)(up_ + kb * 64); } while (0)
#else
        RowRegU ru[8]; RowRegV rv[8];
#endif
#define G6_ISSUE(RR, TAB, PITCH, jbn) do { const int evh_ = ((jbn) < 64) ? ev0 : ev1; const int jl_ = (jbn) & 63; \
            _Pragma("unroll") for (int q = 0; q < 8; ++q) { const int ea = __builtin_amdgcn_readlane(evh_, jl_ + q), eb = __builtin_amdgcn_readlane(evh_, jl_ + 8 + q); \
                row_load(RR[q], TAB + (size_t)(hi ? eb : ea) * PITCH, l32); } } while (0)
#define G6_PROBE(jb, gqv) do { if (PROBE_UM && l < 3) { \
            const int er_ = __builtin_amdgcn_ds_bpermute((((jb) & 63) + (lane & 15)) << 2, ((jb) < 64) ? ev0 : ev1); const unsigned char* up_ = U + (size_t)er_ * ROWB + (lane >> 4) * 16; \
            const unsigned char* hq0 = WS(p) + OFF_H4P + (size_t)t * 512 + (lane >> 4) * 16; const unsigned char* hq1 = hq0 + (size_t)T_ * 512; \
            const int hs_ = ((const int*)(WS(p) + OFF_HSC))[t]; int sa_ = 127, sb0_ = hs_ & 255, sb1_ = (hs_ >> 8) & 255; asm volatile("" : "+v"(sa_), "+v"(sb0_), "+v"(sb1_)); f32x4 a4_ = (f32x4){0.f, 0.f, 0.f, 0.f}; \
            _Pragma("unroll 1") for (int kb = 0; kb < 8; ++kb) { const u32x4 ua_ = *(const u32x4*)(up_ + kb * 64); const u32x4 b0_ = *(const u32x4*)(hq0 + kb * 64), b1_ = *(const u32x4*)(hq1 + kb * 64); \
                asm volatile("s_nop 7\n\tv_mfma_scale_f32_16x16x128_f8f6f4 %0, %1, %2, %0, %3, %4 op_sel_hi:[0,0,0] cbsz:4 blgp:4\n\ts_nop 15\n\ts_nop 15" : "+v"(a4_) : "v"(ua_), "v"(b0_), "v"(sa_), "v"(sb0_)); \
                asm volatile("s_nop 7\n\tv_mfma_scale_f32_16x16x128_f8f6f4 %0, %1, %2, %0, %3, %4 op_sel_hi:[0,0,0] cbsz:4 blgp:4\n\ts_nop 15\n\ts_nop 15" : "+v"(a4_) : "v"(ua_), "v"(b1_), "v"(sa_), "v"(sb1_)); } \
            const int si_ = (lane >> 2) & 3; const float gm_ = (si_ == 0) ? a4_[0] : (si_ == 1) ? a4_[1] : (si_ == 2) ? a4_[2] : a4_[3]; \
            pd1 += (gm_ - (gqv)) * (gm_ - (gqv)); pd2 += (gqv) * (gqv); } } while (0)
#if GATHER_UMFMA && TAB_FMT == 45
#define G6_MF(ACC, A, B, SB) asm volatile("v_mfma_scale_f32_16x16x128_f8f6f4 %0, %1, %2, %0, %3, %4 op_sel_hi:[0,0,0] cbsz:4 blgp:4" : "+v"(ACC) : "v"(A), "v"(B), "v"(sa_), "v"(SB))
#define G6_MF0(ACC, A, B, SB) asm volatile("v_mfma_scale_f32_16x16x128_f8f6f4 %0, %1, %2, 0, %3, %4 op_sel_hi:[0,0,0] cbsz:4 blgp:4" : "=&v"(ACC) : "v"(A), "v"(B), "v"(sa_), "v"(SB))
#define G6_UDOT(jb, NEXT) do { f32x4 aa_, ab_; \
            G6_MF0(aa_, ua[0], hb0[0], sb0_); G6_MF0(ab_, ua[0], hb1[0], sb1_); \
            _Pragma("unroll") for (int kb = 1; kb < 8; ++kb) { G6_MF(aa_, ua[kb], hb0[kb], sb0_); G6_MF(ab_, ua[kb], hb1[kb], sb1_); } \
            asm volatile("s_nop 15\n\ts_nop 15" ::: "memory"); \
            if (NEXT) G6_UISSUE((jb) + 16); \
            const f32x4 as_ = aa_ + ab_; const int si_ = (lane >> 2) & 3; gq = (si_ == 0) ? as_[0] : (si_ == 1) ? as_[1] : (si_ == 2) ? as_[2] : as_[3]; } while (0)
#else
#define G6_UDOT(jb, NEXT) do { float d[8]; \
            _Pragma("unroll") for (int q = 0; q < 8; ++q) { f32x2 w[16]; row_decode(ru[q], w); f32x2 s2 = w[0] * xf[0]; \
                _Pragma("unroll") for (int i = 1; i < 16; ++i) s2 = s2 + w[i] * xf[i]; \
                d[q] = (s2[0] + s2[1]) * row_scale(ru[q]); } \
            if (NEXT) G6_ISSUE(ru, U, ROWB, (jb) + 16); \
            float f4[4], g2_[2]; \
            _Pragma("unroll") for (int i = 0; i < 4; ++i) f4[i] = swap16_sum(d[i], d[i + 4]);                       \
            _Pragma("unroll") for (int i = 0; i < 2; ++i) { const float snd = b3 ? f4[i] : f4[i + 2], kp = b3 ? f4[i + 2] : f4[i]; g2_[i] = kp + DPPF(snd, DPP_ROR8); }     \
            { const float snd = b2 ? g2_[0] : g2_[1], kp = b2 ? g2_[1] : g2_[0]; const float rl = DPPF(snd, DPP_SHL4), rr_ = DPPF(snd, DPP_SHR4); gq = kp + (b2 ? rr_ : rl); }     \
            gq += DPPF(gq, DPP_QX1); gq += DPPF(gq, DPP_QX2);                                                       \
            } while (0)
#endif
#define G6_BODY(jb, NEXT) do { \
            const int bidx_ = ((((jb) & 63) + quad) << 2); \
            const float su_ = __int_as_float(__builtin_amdgcn_ds_bpermute(bidx_, __float_as_int(((jb) < 64) ? su0 : su1))); \
            const float gs_ = __int_as_float(__builtin_amdgcn_ds_bpermute(bidx_, __float_as_int(((jb) < 64) ? gs0 : gs1))); \
            float gq; \
            G6_UDOT(jb, NEXT); \
            G6_PROBE(jb, gq); \
            const float wq = gs_ * gelu_tanh(gq * su_); \
            _Pragma("unroll") for (int q = 0; q < 8; ++q) { \
                const float wa = __uint_as_float((unsigned)__builtin_amdgcn_readlane((int)__float_as_uint(wq), 4 * q)), wb = __uint_as_float((unsigned)__builtin_amdgcn_readlane((int)__float_as_uint(wq), 32 + 4 * q)); \
                const float w1 = (hi ? wb : wa) * row_scale(rv[q]); const f32x2 w2 = (f32x2){w1, w1}; f32x2 vw[16]; row_decode(rv[q], vw); \
                _Pragma("unroll") for (int i = 0; i < 16; ++i) acc[i] = acc[i] + w2 * vw[i]; } \
            if (NEXT) G6_ISSUE(rv, V, ROWB_V, (jb) + 16); } while (0)
#if GATHER_UMFMA && TAB_FMT == 45
        G6_UISSUE(0); G6_ISSUE(rv, V, ROWB_V, 0);
#else
        G6_ISSUE(ru, U, ROWB, 0); G6_ISSUE(rv, V, ROWB_V, 0);
#endif
#pragma unroll 1
        for (int jb = 0; jb < 112; jb += 16) G6_BODY(jb, true);
        G6_BODY(112, false);
        if (PROBE_UM && l < 3) { pd1 = wave_sum(pd1); pd2 = wave_sum(pd2); if (lane == 0) { atomicAdd((float*)(WS(p) + OFF_CTL) + 4001, pd1); atomicAdd((float*)(WS(p) + OFF_CTL) + 4002, pd2); } }
#undef G6_PROBE
#undef G6_ISSUE
#undef G6_BODY
#undef G6_UDOT
#ifdef G6_UISSUE
#undef G6_UISSUE
#undef G6_MF
#undef G6_MF0
#endif
#define G6_NEXT_TOKEN() do { if (want) { t = T_STAT + (int)__builtin_amdgcn_readfirstlane((int)tkr); dyn = true; } else { t += (int)gridDim.x * 8; } } while (0)
        if (DRY) { if (acc[0][0] == 1.2345e30f) XR(p)[0] = acc[1][0]; t += (int)gridDim.x * 8; continue; }
        f32x2 as[8];
#pragma unroll
        for (int i = 0; i < 8; ++i) { f32x2 lo, hh; lo[0] = swap32_sum(acc[i][0], acc[i][0]); lo[1] = swap32_sum(acc[i][1], acc[i][1]); hh[0] = swap32_sum(acc[8 + i][0], acc[8 + i][0]); hh[1] = swap32_sum(acc[8 + i][1], acc[8 + i][1]);
            as[i] = hi ? hh : lo; }
        const int hq = hi ? 4 : 0;
#define GCOL(q) CHUNK_COL(l32, hq + (q))
        float* xp = XR(p) + (size_t)t * DM; const float* gp = g2 + ((t >= S_) ? 6144 : 0); bf16_t* xbp = (bf16_t*)(WS(p) + OFF_XB) + (size_t)t * DM;
        f32x4 xn[4]; float ss = 0.f;
#pragma unroll
        for (int q = 0; q < 4; ++q) { f32x4 xv = XRES_BF16 ? ld_bf4(xbp + GCOL(q)) : *(const f32x4*)(xp + GCOL(q)); const f32x4 gv = *(const f32x4*)(gp + GCOL(q));
            xv[0] += gv[0] * as[2 * q][0]; xv[1] += gv[1] * as[2 * q][1]; xv[2] += gv[2] * as[2 * q + 1][0]; xv[3] += gv[3] * as[2 * q + 1][1]; xn[q] = xv;
            ss += xv[0] * xv[0] + xv[1] * xv[1] + xv[2] * xv[2] + xv[3] * xv[3]; }
        ss = wave_sum(ss); const float rs = rsqrtf(ss * (1.f / 1024.f) + 1e-6f);
        if (l + 1 < NL) {
            const float* mn = (const float*)(WS(p) + OFF_MOD) + (size_t)(l + 1) * 2 * 6144 + ((t >= S_) ? 6144 : 0); bf16_t* hp = (bf16_t*)(WS(p) + OFF_H) + (size_t)t * DM;
#pragma unroll
            for (int q = 0; q < 4; ++q) { if (XRES_BF16) st_bf4(xbp + GCOL(q), xn[q]); else *(f32x4*)(xp + GCOL(q)) = xn[q]; const f32x4 sh = *(const f32x4*)(mn + GCOL(q)), sc = *(const f32x4*)(mn + 1024 + GCOL(q)); { const f32x4 hv = xn[q] * rs * (sc + 1.f) + sh; st_bf4(hp + GCOL(q), hv); if (GATES_FP8) *(unsigned*)(WS(p) + OFF_H8 + (size_t)t * DM + GCOL(q)) = pk4_fp8(hv); } }
        } else {
            const float* fn = p.final_norm;
#if PROBE_UM
            const float s1_ = ((const float*)(WS(p) + OFF_CTL))[4001], s2_ = ((const float*)(WS(p) + OFF_CTL))[4002];
            const float rsp = rs * (1.f + 10.f * floorf(fminf(sqrtf(s1_ / fmaxf(s2_, 1e-30f)), 4.f) * 64.f + 0.5f) * (1.f / 64.f));
#elif PROBE_ATTN
            const float rsp = rs * (1.f + 10.f * __uint_as_float(((const unsigned*)(WS(p) + OFF_CTL))[4000]));
#else
            const float rsp = rs;
#endif
#pragma unroll
            for (int q = 0; q < 4; ++q) { const f32x4 g = *(const f32x4*)(fn + GCOL(q)); *(f32x4*)(xp + GCOL(q)) = xn[q] * rsp * g; }
        }
#undef GCOL
        G6_NEXT_TOKEN();
    }
}
#endif

#if PROBE_ATTN
DEVI void dsincos(double ang, double& s, double& c) {
    const double rev = ang * 0.15915494309189535; const double x = (rev - rint(rev)) * 6.283185307179586; const double x2 = x * x;
    double ts = x, tc = 1.0; s = x; c = 1.0;
    for (int n = 1; n <= 14; ++n) { tc *= -x2 / (double)((2 * n - 1) * (2 * n)); c += tc; ts *= -x2 / (double)((2 * n) * (2 * n + 1)); s += ts; }
}
DEVI void phase_attn_check(const P& p, char* lds) {
    const int lane = tid_() & 63, wid = tid_() >> 6;
    const int TS[24] = {0, 1, 2, 31, 32, 33, 63, 64, 65, 127, 128, 255, 256, 257, 511, 1000, 2047, 4096, 5000, 8191, 8192, 12345, 16382, 16383};
    const bf16_t* z = (const bf16_t*)(WS(p) + OFF_Z); const bf16_t* Qb = (const bf16_t*)(WS(p) + OFF_Q); const bf16_t* Kb = (const bf16_t*)(WS(p) + OFF_K);
    const bf16_t* Vb = (const bf16_t*)(WS(p) + OFF_VV); const bf16_t* Yb = (const bf16_t*)(WS(p) + OFF_CAT) + CAT_YB; unsigned* errw = (unsigned*)(WS(p) + OFF_CTL) + 4000;
    float* qs = (float*)lds + wid * 128;
    for (int v = blockIdx.x * 8 + wid; v < 16 * 24; v += gridDim.x * 8) {
        const int bh = v / 24, b = bh >> 3, h = bh & 7; int t = 0;
#pragma unroll
        for (int i = 0; i < 24; ++i) if (v % 24 == i) t = TS[i];
        const size_t tq = (size_t)b * S_ + t;
        float ss = 0.f; for (int i = lane; i < 384; i += 64) { const float a = bf2f(z[tq * ZC + Z_CQ + i]); ss += a * a; }
        ss = wave_sum(ss); const float rs = 1.0f / sqrtf(ss / 384.f + 1e-6f);
        qs[lane] = bf2f(Qb[tq * 768 + h * 96 + lane]) * rs; if (lane < 32) qs[64 + lane] = bf2f(Qb[tq * 768 + h * 96 + 64 + lane]) * rs;
        asm volatile("s_waitcnt lgkmcnt(0)" ::: "memory");
        if (lane < 16) { const float* rp_ = (const float*)(WS(p) + OFF_ROPE) + tq * 32; const float cs = rp_[lane], sn = rp_[16 + lane]; const float x1 = qs[64 + lane], x2 = qs[80 + lane];
            qs[64 + lane] = x1 * (float)cs - x2 * (float)sn; qs[80 + lane] = x2 * (float)cs + x1 * (float)sn; }
        asm volatile("s_waitcnt lgkmcnt(0)" ::: "memory");
        float mx = -1e30f;
        for (int pass = 0; pass < 2; ++pass) {
            float lsum = 0.f, o[16];
#pragma unroll
            for (int d = 0; d < 16; ++d) o[d] = 0.f;
            const float mglob = mx;
            for (int s = lane; s <= t; s += 64) {
                const size_t ts_ = (size_t)b * S_ + s; float dot = 0.f;
                for (int d = 0; d < 64; ++d) dot += qs[d] * bf2f(Kb[ts_ * 768 + h * 96 + d]);
                for (int i = 0; i < 16; ++i) { const float* rp_ = (const float*)(WS(p) + OFF_ROPE) + ts_ * 32; const float cs = rp_[i], sn = rp_[16 + i];
                    const float x1 = bf2f(z[ts_ * ZC + Z_KR + i]), x2 = bf2f(z[ts_ * ZC + Z_KR + 16 + i]);
                    dot += qs[64 + i] * (x1 * (float)cs - x2 * (float)sn) + qs[80 + i] * (x2 * (float)cs + x1 * (float)sn); }
                dot *= 0.10206207261596577f;
                if (pass == 0) mx = fmaxf(mx, dot);
                else { const float pr = expf(dot - mglob); lsum += pr;
#pragma unroll
                    for (int d = 0; d < 16; ++d) o[d] += pr * bf2f(Vb[ts_ * 512 + h * 64 + 4 * d]); }
            }
            if (pass == 0) {
#pragma unroll
                for (int of = 32; of > 0; of >>= 1) mx = fmaxf(mx, __shfl_xor(mx, of));
            } else {
                lsum = wave_sum(lsum); float emax = 0.f, r2 = 0.f;
#pragma unroll
                for (int d = 0; d < 16; ++d) { const float ref = wave_sum(o[d]) / lsum; const float got = bf2f(Yb[tq * 1024 + h * 64 + 4 * d]); emax = fmaxf(emax, fabsf(got - ref)); r2 += ref * ref; }
                const float rel = emax / (sqrtf(r2 / 16.f) + 1e-20f);
                if (lane == 0) atomicMax(errw, __float_as_uint((rel == rel) ? fminf(fmaxf(rel, 0.f), 4.f) : 3.0f));
            }
        }
    }
}
#endif

#define XB_TMO      128
#define XB_XCNT(j)  (256  + 64 * (j))
#define XB_XSUB(j)  (1280 + 64 * (j))
#define XB_XGEN(j)  (2304 + 64 * (j))
#define XB_TOP      3328
#define XB_TOPGEN   3392
#define XCD_BAR_WORDS 3456
#define XB_SPIN_CAP (1u << 18)

__device__ __forceinline__ unsigned xb_ld(unsigned* p)              { return __hip_atomic_load(p, __ATOMIC_RELAXED, __HIP_MEMORY_SCOPE_AGENT); }
__device__ __forceinline__ unsigned xb_add(unsigned* p, unsigned v) { return __hip_atomic_fetch_add(p, v, __ATOMIC_RELAXED, __HIP_MEMORY_SCOPE_AGENT); }
__device__ __forceinline__ unsigned xb_xcc_id() { return (unsigned)__builtin_amdgcn_s_getreg((3 << 11) | 20) & 0xFu; }
#define XB_SPIN(cond, bar) do { unsigned _sp = 0; while (cond) { __builtin_amdgcn_s_sleep(1); \
    if ((++_sp & 255u) == 0u) { if (xb_ld(&(bar)[XB_TMO])) break; if (_sp > XB_SPIN_CAP) { atomicAdd(&(bar)[XB_TMO], 1u); break; } } } } while (0)

struct XcdBarrier {
    unsigned* bar; unsigned x;
    volatile LAS unsigned* st;
};

__device__ __forceinline__ XcdBarrier xcd_barrier_post(unsigned* bar, volatile LAS unsigned* st) {
    XcdBarrier b; b.bar = bar; b.x = xb_xcc_id(); b.st = st;
    if (threadIdx.x == 0) (void)xb_add(&bar[XB_XCNT(b.x)], 1u);
    return b;
}
__device__ __forceinline__ void xcd_barrier_complete(unsigned* bar, unsigned x, unsigned& nloc, unsigned& nx) {
    const unsigned G = gridDim.x * gridDim.y * gridDim.z;
    unsigned sum, cnt, mine, sp = 0u;
    for (;;) {
        sum = 0u; cnt = 0u; mine = 0u;
#pragma unroll
        for (unsigned j = 0; j < 16; ++j) { const unsigned c = xb_ld(&bar[XB_XCNT(j)]); sum += c; cnt += (c > 0u) ? 1u : 0u; mine = (j == x) ? c : mine; }
        if (sum == G) break;
        __builtin_amdgcn_s_sleep(1);
        if ((++sp & 255u) == 0u) { if (xb_ld(&bar[XB_TMO])) break; if (sp > XB_SPIN_CAP) { atomicAdd(&bar[XB_TMO], 1u); break; } }
    }
    nloc = mine > 0u ? mine : 1u; nx = cnt > 0u ? cnt : 1u;
}

__device__ __forceinline__ void xcd_barrier(const XcdBarrier& b) {
    asm volatile("s_waitcnt vmcnt(0)" ::: "memory");
    __syncthreads();
    if (threadIdx.x == 0) {
        unsigned* bar = b.bar;
        __builtin_amdgcn_s_waitcnt(0);
        unsigned nloc = b.st[0], nx = b.st[1];
        if (nloc == 0u) { xcd_barrier_complete(bar, b.x, nloc, nx); b.st[0] = nloc; b.st[1] = nx; }
        const unsigned old = xb_add(&bar[XB_XSUB(b.x)], 1u);
        const unsigned gen = old / nloc;
        if (old + 1u == (gen + 1u) * nloc) {
            __builtin_amdgcn_fence(__ATOMIC_RELEASE, "agent");
            asm volatile("s_waitcnt vmcnt(0)" ::: "memory");
            const unsigned og = xb_add(&bar[XB_TOP], 1u);
            const unsigned tg = og / nx;
            if (og + 1u == (tg + 1u) * nx) xb_add(&bar[XB_TOPGEN], 1u);
            else XB_SPIN(xb_ld(&bar[XB_TOPGEN]) == tg, bar);
            __builtin_amdgcn_fence(__ATOMIC_ACQUIRE, "agent");
            xb_add(&bar[XB_XGEN(b.x)], 1u);
            asm volatile("s_waitcnt vmcnt(0)" ::: "memory");
        } else {
            XB_SPIN(xb_ld(&bar[XB_XGEN(b.x)]) == gen, bar);
            __builtin_amdgcn_fence(__ATOMIC_ACQUIRE, "agent");
            asm volatile("s_waitcnt vmcnt(0)" ::: "memory");
        }
    }
    __syncthreads();
}

enum { PH_PRO = 0, PH_NORM1, PH_GIN, PH_POST, PH_MIX_QKV, PH_ATTN, PH_MERGE, PH_WO, PH_NORM2, PH_PQ, PH_SC, PH_TOPK, PH_GATHER, PH_FINAL, PH_CHECK, PH_PEERK, PH_PQK };
template <int PH> DEVI void run_phase(const P& p, int l, char* lds) {
    l = opaque_i32(l);
    const unsigned char* wl = WS(p) + OFF_W + (size_t)l * W_LAYER; const float* mod = (const float*)(WS(p) + OFF_MOD) + (size_t)l * 2 * 6144;
    if constexpr (PH == PH_PRO) phase_prologue(p, lds);
    if constexpr (PH == PH_NORM1) phase_norm(p, p.x, mod + 0, mod + 1024, true);
    if constexpr (PH == PH_GIN) {
        if (GATES_FP8) {
            { EpiZ e{(bf16_t*)(WS(p) + OFF_Z)}; gemm256_phase((const bf16_t*)(WS(p) + OFF_H), DM, (const bf16_t*)(wl + W_INT), 1024, T_, Z_G, 1024, lds, e); }
            { EpiZG e{(bf16_t*)(WS(p) + OFF_Z)}; gemm256_phase_f8(WS(p) + OFF_H8, 1024, wl + W_G8, 1024, T_, 3072, 1024, lds, e); }
        } else { EpiZ e{(bf16_t*)(WS(p) + OFF_Z)}; gemm256_phase((const bf16_t*)(WS(p) + OFF_H), DM, (const bf16_t*)(wl + W_INT), 1024, T_, ZC, 1024, lds, e); }
    }
    if constexpr (PH == PH_POST) phase_post(p);
    if constexpr (PH == PH_MIX_QKV) {
        phase_mixa(p, l, lds);
        { EpiBf e{(bf16_t*)(WS(p) + OFF_Q), 768}; gemm256_phase((const bf16_t*)(WS(p) + OFF_Z) + Z_CQ, ZC, (const bf16_t*)(wl + W_UQ), 384, T_, 768, 384, lds, e); }
        { EpiKV e{(bf16_t*)(WS(p) + OFF_K), (bf16_t*)(WS(p) + OFF_VV), (const float*)(WS(p) + OFF_RS) + T_}; gemm256_phase((const bf16_t*)(WS(p) + OFF_Z) + Z_CKV, ZC, (const bf16_t*)(wl + W_UKV), 256, T_, 1024, 256, lds, e); }
    }
    if constexpr (PH == PH_ATTN) phase_attn(p, lds);
#ifndef MERGE_SIMPLE
#define MERGE_SIMPLE 0
#endif
    if constexpr (PH == PH_MERGE) {
        if (MERGE_SIMPLE) phase_merge(p, l, lds);
        else { const bf16_t* zg = (const bf16_t*)(WS(p) + OFF_Z) + Z_G; EpiMergeLast e{(bf16_t*)(WS(p) + OFF_H), zg + (GATES_ST8 ? 1024 : 2048)}; pg8::GateSeg sg{zg, ZC, 1024, 4, 12};
            gemm256_phase_seg((const bf16_t*)(WS(p) + OFF_CAT), 1024, (const bf16_t*)(wl + W_A), 1024, T_, 1024, 1024, lds, e, sg); }
    }
    if constexpr (PH == PH_WO) {
        if (XRES_BF16) { bf16_t* xb = (bf16_t*)(WS(p) + OFF_XB); EpiWoB e{(l == 0) ? p.x : nullptr, xb, xb, mod + 2048}; gemm256_phase((const bf16_t*)(WS(p) + OFF_H), DM, (const bf16_t*)(wl + W_O), 1024, T_, 1024, 1024, lds, e); }
        else { EpiWo e{(l == 0) ? p.x : (const float*)XR(p), XR(p), mod + 2048}; gemm256_phase((const bf16_t*)(WS(p) + OFF_H), DM, (const bf16_t*)(wl + W_O), 1024, T_, 1024, 1024, lds, e); } }
    if constexpr (PH == PH_NORM2) phase_norm(p, XR(p), mod + 3072, mod + 4096, false, XRES_BF16 ? (const bf16_t*)(WS(p) + OFF_XB) : nullptr, (PROBE_UM != 0) || (GATHER_UMFMA != 0));
    if constexpr (PH == PH_PQ) { EpiBf e{(bf16_t*)(WS(p) + OFF_Q), 2048}; gemm256_phase((const bf16_t*)(WS(p) + OFF_H), DM, (const bf16_t*)(wl + W_PQ), 1024, T_, 2048, 1024, lds, e); }
    if constexpr (PH == PH_SC) { EpiScT e{(float*)(WS(p) + OFF_Z)}; gemm_phase((const bf16_t*)(WS(p) + OFF_Q), 2048, 128, (const bf16_t*)(wl + W_SK), 128, T_, 2048, 128, lds, e); }
    if constexpr (PH == PH_TOPK) phase_topk(p);
    if constexpr (PH == PH_PEERK) phase_peerk(p, l, lds);
    if constexpr (PH == PH_PQK) {
        for (int v = (int)blockIdx.x; v < 256; v += (int)gridDim.x) {
            { EpiBf e{(bf16_t*)(WS(p) + OFF_Q), 2048}; gemm256_pair((const bf16_t*)(WS(p) + OFF_H), DM, (const bf16_t*)(wl + W_PQ), 1024, T_, 2048, 1024, lds, e, v); }
            asm volatile("s_waitcnt vmcnt(0)" ::: "memory"); __syncthreads(); __builtin_amdgcn_fence(__ATOMIC_ACQUIRE, "agent");
            if (PQ_FOLD) phase_peerk2(p, v, lds); else phase_peerk(p, l, lds, v);
        }
    }
#if TAB_FMT == 6 || TAB_FMT == 5 || TAB_FMT == 65 || TAB_FMT == 45
    if constexpr (PH == PH_GATHER) phase_gather6<false>(p, l);
    if constexpr (PH == PH_GATHER + 100) phase_gather6<true>(p, l);
#else
    if constexpr (PH == PH_GATHER) phase_gather<false>(p, l);
    if constexpr (PH == PH_GATHER + 100) phase_gather<true>(p, l);
#endif
    if constexpr (PH == PH_FINAL) phase_final(p);
#if PROBE_ATTN
    if constexpr (PH == PH_CHECK) phase_attn_check(p, lds);
#endif
}
#ifndef MEGA
#define MEGA 1
#endif
#if MEGA
__global__ void __launch_bounds__(NTHR, 2) k_mega(P p) {
    extern __shared__ __attribute__((aligned(16))) char lds[];
    if (threadIdx.x == 0) *(u32x4*)(lds + LDS_BYTES - 16) = (u32x4){0u, 0u, 0u, 0u};
    ctx_init(p, lds);
    __syncthreads();
    (void)xcd_barrier_post((unsigned*)(p.ws + OFF_CTL), (volatile LAS unsigned*)(lds + LDS_BYTES - 16));
#define GRID_BARRIER() do { XcdBarrier b_; b_.bar = (unsigned*)(WS(p) + OFF_CTL); b_.x = xb_xcc_id(); b_.st = (volatile LAS unsigned*)(lds + LDS_BYTES - 16); xcd_barrier(b_); } while (0)
    run_phase<PH_PRO>(p, 0, lds); GRID_BARRIER();
    if (DUP_MASK & 1) { run_phase<PH_PRO>(p, 0, lds); GRID_BARRIER(); }
    if (DUP_MASK & 0x10000) { for (int i = 0; i < 48; ++i) GRID_BARRIER(); }
#pragma unroll 1
    for (int l = 0; l < NL; ++l) {
        if (l == 0) { run_phase<PH_NORM1>(p, l, lds); GRID_BARRIER(); }
        run_phase<PH_GIN>(p, l, lds); GRID_BARRIER();
        if (DUP_MASK & (1 << PH_GIN)) { run_phase<PH_GIN>(p, l, lds); GRID_BARRIER(); }
        run_phase<PH_POST>(p, l, lds); GRID_BARRIER();
        if (DUP_MASK & (1 << PH_POST)) { run_phase<PH_POST>(p, l, lds); GRID_BARRIER(); }
        run_phase<PH_MIX_QKV>(p, l, lds); GRID_BARRIER();
        if (DUP_MASK & (1 << PH_MIX_QKV)) { run_phase<PH_MIX_QKV>(p, l, lds); GRID_BARRIER(); }
        run_phase<PH_ATTN>(p, l, lds); GRID_BARRIER();
#if PROBE_ATTN
        if (l == 1) { phase_attn_check(p, lds); GRID_BARRIER(); }
#endif
        if (DUP_MASK & (1 << PH_ATTN)) { run_phase<PH_ATTN>(p, l, lds); GRID_BARRIER(); }
        run_phase<PH_MERGE>(p, l, lds); GRID_BARRIER();
        if (DUP_MASK & (1 << PH_MERGE)) { run_phase<PH_MERGE>(p, l, lds); GRID_BARRIER(); }
        run_phase<PH_WO>(p, l, lds); GRID_BARRIER();
        run_phase<PH_NORM2>(p, l, lds); GRID_BARRIER();
        if (DUP_MASK & (1 << PH_NORM2)) { run_phase<PH_NORM2>(p, l, lds); GRID_BARRIER(); }
#if FUSE_PQK
        run_phase<PH_PQK>(p, l, lds); GRID_BARRIER();
#else
        run_phase<PH_PQ>(p, l, lds); GRID_BARRIER();
        if (DUP_MASK & (1 << PH_PQ)) { run_phase<PH_PQ>(p, l, lds); GRID_BARRIER(); }
        run_phase<PH_PEERK>(p, l, lds); GRID_BARRIER();
#endif
        if (DUP_MASK & (1 << PH_TOPK)) { run_phase<PH_PEERK>(p, l, lds); GRID_BARRIER(); }
        run_phase<PH_GATHER>(p, l, lds); GRID_BARRIER();
        if (DUP_MASK & (1 << PH_GATHER)) { run_phase<PH_GATHER + 100>(p, l, lds); GRID_BARRIER(); }
    }
}
#else
template <int PH> __global__ void __launch_bounds__(NTHR, 2) k_phase(P p, int l) {
    extern __shared__ __attribute__((aligned(16))) char lds[];
    ctx_init(p, lds); __syncthreads();
    run_phase<PH>(p, l, lds);
}
template <int PH> static void launch_phase(const P& p, int l, hipStream_t stream) {
    static bool attr = false;
    if (!attr) { (void)hipFuncSetAttribute((const void*)k_phase<PH>, hipFuncAttributeMaxDynamicSharedMemorySize, LDS_BYTES); attr = true; }
    hipLaunchKernelGGL(k_phase<PH>, dim3(256), dim3(NTHR), LDS_BYTES, stream, p, l);
}
#endif

extern "C" void kernel_launch(void* const* d_in, const int* in_sizes, int n_in, void* d_out, int out_size, void* d_ws, size_t ws_size, hipStream_t stream) {
    P p{};
    p.x = (const float*)d_in[0]; p.c = (const float*)d_in[1]; p.pos = (const int*)d_in[2];
    p.w_mod = (const float*)d_in[3]; p.b_mod = (const float*)d_in[4]; p.w_in = (const float*)d_in[5]; p.w_s = (const float*)d_in[6]; p.b_s = (const float*)d_in[7];
    p.q_norm = (const float*)d_in[8]; p.w_uq = (const float*)d_in[9]; p.kv_norm = (const float*)d_in[10]; p.w_ukv = (const float*)d_in[11]; p.w_pool = (const float*)d_in[12];
    p.pool_scale = (const float*)d_in[13]; p.w_a = (const float*)d_in[14]; p.w_b = (const float*)d_in[15]; p.w_c = (const float*)d_in[16]; p.w_o = (const float*)d_in[17];
    p.w_pq = (const float*)d_in[18]; p.sub_keys = (const float*)d_in[19]; p.u_tab = (const float*)d_in[20]; p.v_tab = (const float*)d_in[21]; p.final_norm = (const float*)d_in[22];
    p.xr = (float*)d_out; p.ws = (unsigned char*)d_ws;
    for (int i = 0; i < 16; ++i) p.invf[i] = (double)(float)(1.0 / pow(10000.0, (double)(2 * i) / 32.0));
#if MEGA
    static int grid = 0;
    if (!grid) {
        (void)hipFuncSetAttribute((const void*)k_mega, hipFuncAttributeMaxDynamicSharedMemorySize, LDS_BYTES);
        int dev = 0, cus = 0, per_cu = 0;
        (void)hipGetDevice(&dev); (void)hipDeviceGetAttribute(&cus, hipDeviceAttributeMultiprocessorCount, dev);
        (void)hipOccupancyMaxActiveBlocksPerMultiprocessor(&per_cu, (const void*)k_mega, NTHR, LDS_BYTES);
        if (cus <= 0) cus = 256;
        grid = cus * (per_cu < 1 ? 1 : 1);
    }
    (void)hipMemsetAsync(p.ws + OFF_CTL, 0, 16384, stream);
    hipLaunchKernelGGL(k_mega, dim3(grid), dim3(NTHR), LDS_BYTES, stream, p);
#else
    (void)hipMemsetAsync(p.ws + OFF_CTL, 0, 16384, stream);
    launch_phase<PH_PRO>(p, 0, stream);
    for (int l = 0; l < NL; ++l) {
        if (l == 0) launch_phase<PH_NORM1>(p, l, stream); launch_phase<PH_GIN>(p, l, stream); launch_phase<PH_POST>(p, l, stream); launch_phase<PH_MIX_QKV>(p, l, stream);
        launch_phase<PH_ATTN>(p, l, stream); if (PROBE_ATTN && l == 1) launch_phase<PH_CHECK>(p, l, stream); launch_phase<PH_MERGE>(p, l, stream); launch_phase<PH_WO>(p, l, stream); launch_phase<PH_NORM2>(p, l, stream);
        launch_phase<PH_PQ>(p, l, stream); launch_phase<PH_PEERK>(p, l, stream); launch_phase<PH_GATHER>(p, l, stream);
    }
#endif
}
```
